# Optimizing an MI355X kernel written in HIP

```python
import math
import jax, jax.numpy as jnp
from jax import lax
import numpy as np

D_MODEL = 2048
BATCH = 1
SEQ = 8192
DEPTH = 1

MLA_HEADS = 8
MLA_Q_RANK = 768
MLA_KV_RANK = 512
MLA_NOPE = 128
MLA_ROPE = 64
MLA_V = 128
ROPE_THETA = 10000.0
Q_BLOCK = 128
NSA_HEADS = 8
NSA_GROUPS = 2
NSA_HPG = NSA_HEADS // NSA_GROUPS
NSA_DK = 192
NSA_DV = 128
CMP_LEN = 32
CMP_STRIDE = 16
CMP_HIDDEN = 256
SLC_LEN = 64
SLC_TOPN = 16
WINDOW = 512
N_BRANCH = 3
NSA_Q_BLOCK = 64
REL_BUCKETS = 32
REL_MAX_DIST = 128
D_FF = 5632
EPS = 1e-6

MIX_WIDTH = MLA_HEADS * MLA_V + NSA_HEADS * NSA_DV
IN_SPLITS = (
    MLA_Q_RANK,
    MLA_KV_RANK,
    MLA_ROPE,
    NSA_HEADS * NSA_DK,
    N_BRANCH * NSA_GROUPS * NSA_DK,
    N_BRANCH * NSA_GROUPS * NSA_DV,
    NSA_HEADS * N_BRANCH,
)
D_IN = sum(IN_SPLITS)

kernel_name = 'hybrid_mla_nsa_macaron_adaln'


def rms_norm(x, g):
    x32 = x.astype(jnp.float32)
    y = x32 * lax.rsqrt(jnp.mean(x32 * x32, axis=-1, keepdims=True) + EPS)
    return (y * g.astype(jnp.float32)).astype(x.dtype)


def modulate(h, shift, scale):
    return h * (1.0 + scale[:, None, :]) + shift[:, None, :]


def swiglu(h, w_gate, w_up, w_down):
    return (jax.nn.silu(h @ w_gate) * (h @ w_up)) @ w_down


def split_cols(h, sizes):
    return jnp.split(h, np.cumsum(sizes)[:-1].tolist(), axis=-1)


def rope(t, pos):
    d = t.shape[-1]
    inv = ROPE_THETA ** (-jnp.arange(0, d, 2, dtype=jnp.float32) / d)
    ang = pos.astype(jnp.float32)[:, None] * inv[None, :]
    cos = jnp.cos(ang)[None, :, None, :].astype(t.dtype)
    sin = jnp.sin(ang)[None, :, None, :].astype(t.dtype)
    t1, t2 = t[..., : d // 2], t[..., d // 2:]
    return jnp.concatenate([t1 * cos - t2 * sin, t1 * sin + t2 * cos], axis=-1)


def masked_softmax(logits, mask):
    logits = jnp.where(mask, logits.astype(jnp.float32), -jnp.inf)
    m = jnp.max(logits, axis=-1, keepdims=True)
    m = jnp.where(jnp.isfinite(m), m, 0.0)
    p = jnp.exp(logits - m)
    return p / jnp.maximum(jnp.sum(p, axis=-1, keepdims=True), 1e-30)


def t5_bucket(dist):
    n = jnp.maximum(dist, 0)
    max_exact = REL_BUCKETS // 2
    nf = jnp.maximum(n, 1).astype(jnp.float32)
    large = max_exact + (jnp.log(nf / max_exact) / math.log(REL_MAX_DIST / max_exact)
                         * (REL_BUCKETS - max_exact)).astype(jnp.int32)
    large = jnp.minimum(large, REL_BUCKETS - 1)
    return jnp.where(n < max_exact, n, large)


def mla_group(cq, ckv, kr, pos, q_norm, w_uq, kv_norm, w_ukv):
    B, S, _ = cq.shape
    dqk = MLA_NOPE + MLA_ROPE
    q = (rms_norm(cq, q_norm) @ w_uq).reshape(B, S, MLA_HEADS, dqk)
    q = jnp.concatenate([q[..., :MLA_NOPE], rope(q[..., MLA_NOPE:], pos)], axis=-1)
    kv = (rms_norm(ckv, kv_norm) @ w_ukv).reshape(B, S, MLA_HEADS, MLA_NOPE + MLA_V)
    k_nope, v = kv[..., :MLA_NOPE], kv[..., MLA_NOPE:]
    k_rope = rope(kr[:, :, None, :], pos)
    k = jnp.concatenate([k_nope, jnp.broadcast_to(k_rope, (B, S, MLA_HEADS, MLA_ROPE))], axis=-1)
    scale = dqk ** -0.5
    nb = S // Q_BLOCK
    qb = q.reshape(B, nb, Q_BLOCK, MLA_HEADS, dqk).transpose(1, 0, 2, 3, 4)

    def block(args):
        qi, i = args
        tq = i * Q_BLOCK + jnp.arange(Q_BLOCK)
        s = jnp.einsum('bqhd,bkhd->bhqk', qi, k) * scale
        p = masked_softmax(s, pos[None, :] <= tq[:, None])
        return jnp.einsum('bhqk,bkhd->bqhd', p.astype(v.dtype), v)

    o = lax.map(block, (qb, jnp.arange(nb)))
    return o.transpose(1, 0, 2, 3, 4).reshape(B, S, MLA_HEADS * MLA_V)


def compress(t, pe, w1, w2):
    B, S, G, d = t.shape
    n_cmp = (S - CMP_LEN) // CMP_STRIDE + 1
    idx = jnp.arange(n_cmp)[:, None] * CMP_STRIDE + jnp.arange(CMP_LEN)[None, :]
    blocks = t[:, idx] + pe[None, None, :, None, :]
    flat = blocks.transpose(0, 1, 3, 2, 4).reshape(B, n_cmp, G, CMP_LEN * d)
    return jax.nn.silu(flat @ w1) @ w2


def nsa_group(q, k3, v3, gates, pe_cmp_k, w_cmp_k1, w_cmp_k2, pe_cmp_v, w_cmp_v1, w_cmp_v2, rel_bias):
    B, S = q.shape[:2]
    G, HPG, NQ = NSA_GROUPS, NSA_HPG, NSA_Q_BLOCK
    kc = compress(k3[:, :, 0], pe_cmp_k, w_cmp_k1, w_cmp_k2)
    vc = compress(v3[:, :, 0], pe_cmp_v, w_cmp_v1, w_cmp_v2)
    n_cmp = kc.shape[1]
    n_slc = S // SLC_LEN
    n_top = min(SLC_TOPN, n_slc)
    c_start = jnp.arange(n_cmp) * CMP_STRIDE
    cmp_end = c_start + CMP_LEN - 1
    s_start = jnp.arange(n_slc) * SLC_LEN
    j_ids = jnp.arange(n_slc)
    overlap = ((c_start[:, None] < s_start[None, :] + SLC_LEN)
               & (c_start[:, None] + CMP_LEN > s_start[None, :])).astype(jnp.float32)
    ks_blk = k3[:, :, 1].reshape(B, n_slc, SLC_LEN, G, NSA_DK).transpose(0, 3, 1, 2, 4)
    vs_blk = v3[:, :, 1].reshape(B, n_slc, SLC_LEN, G, NSA_DV).transpose(0, 3, 1, 2, 4)
    kw_pad = jnp.pad(k3[:, :, 2], ((0, 0), (WINDOW, 0), (0, 0), (0, 0)))
    vw_pad = jnp.pad(v3[:, :, 2], ((0, 0), (WINDOW, 0), (0, 0), (0, 0)))
    rb_group = rel_bias.reshape(REL_BUCKETS, G, HPG)
    scale = NSA_DK ** -0.5
    nb = S // NQ
    qb = q.reshape(B, nb, NQ, G, HPG, NSA_DK).transpose(1, 0, 2, 3, 4, 5)
    gb = gates.reshape(B, nb, NQ, G, HPG, N_BRANCH).transpose(1, 0, 2, 3, 4, 5)
    b_idx = jnp.arange(B)[:, None, None, None]
    g_idx = jnp.arange(G)[None, None, :, None]

    def head_bias(bucket):
        nq, nk = bucket.shape
        return rel_bias[bucket].reshape(nq, nk, G, HPG).transpose(2, 3, 0, 1)

    def step(args):
        qi, gi, i = args
        tq = i * NQ + jnp.arange(NQ)
        s_c = (jnp.einsum('bqghd,bngd->bghqn', qi, kc) * scale
               + head_bias(t5_bucket(tq[:, None] - cmp_end[None, :])))
        p_c = masked_softmax(s_c, cmp_end[None, :] <= tq[:, None])
        o_c = jnp.einsum('bghqn,bngd->bqghd', p_c.astype(vc.dtype), vc)
        imp = jnp.einsum('bghqn,nj->bqgj', p_c, overlap)
        valid = (s_start[None, :] <= tq[:, None])[None, :, None, :]
        cur = (tq // SLC_LEN)[:, None]
        forced = ((j_ids[None, :] == 0)
                  | ((j_ids[None, :] <= cur) & (j_ids[None, :] >= cur - 1)))[None, :, None, :]
        score = jnp.where(valid, jnp.where(forced, jnp.inf, imp), -jnp.inf)
        top_val, top_idx = lax.top_k(score, n_top)
        k_sel = ks_blk[b_idx, g_idx, top_idx].reshape(B, NQ, G, n_top * SLC_LEN, NSA_DK)
        v_sel = vs_blk[b_idx, g_idx, top_idx].reshape(B, NQ, G, n_top * SLC_LEN, NSA_DV)
        tok = (top_idx[..., None] * SLC_LEN + jnp.arange(SLC_LEN)).reshape(B, NQ, G, n_top * SLC_LEN)
        tq_b = tq[None, :, None, None]
        m_s = jnp.repeat(top_val > -jnp.inf, SLC_LEN, axis=-1) & (tok <= tq_b)
        bias_s = rb_group[t5_bucket(tq_b - tok), g_idx].transpose(0, 2, 4, 1, 3)
        s_s = jnp.einsum('bqghd,bqgkd->bghqk', qi, k_sel) * scale + bias_s
        p_s = masked_softmax(s_s, m_s.transpose(0, 2, 1, 3)[:, :, None])
        o_s = jnp.einsum('bghqk,bqgkd->bqghd', p_s.astype(v_sel.dtype), v_sel)
        kw = lax.dynamic_slice_in_dim(kw_pad, i * NQ, WINDOW + NQ, axis=1)
        vw = lax.dynamic_slice_in_dim(vw_pad, i * NQ, WINDOW + NQ, axis=1)
        kpos = i * NQ - WINDOW + jnp.arange(WINDOW + NQ)
        dist = tq[:, None] - kpos[None, :]
        m_w = (kpos[None, :] >= 0) & (dist >= 0) & (dist < WINDOW)
        s_w = jnp.einsum('bqghd,bkgd->bghqk', qi, kw) * scale + head_bias(t5_bucket(dist))
        p_w = masked_softmax(s_w, m_w)
        o_w = jnp.einsum('bghqk,bkgd->bqghd', p_w.astype(vw.dtype), vw)
        o = gi[..., 0:1] * o_c + gi[..., 1:2] * o_s + gi[..., 2:3] * o_w
        return o.reshape(B, NQ, NSA_HEADS * NSA_DV)

    o = lax.map(step, (qb, gb, jnp.arange(nb)))
    return o.transpose(1, 0, 2, 3).reshape(B, S, NSA_HEADS * NSA_DV)


def token_mixing(h, w_in, mla_q_norm, w_uq, mla_kv_norm, w_ukv, pe_cmp_k, w_cmp_k1, w_cmp_k2,
                 pe_cmp_v, w_cmp_v1, w_cmp_v2, rel_bias, w_out):
    B, S, _ = h.shape
    cq, ckv, kr, q_n, k_n, v_n, g_n = split_cols(h @ w_in, IN_SPLITS)
    pos = jnp.arange(S)
    o_mla = mla_group(cq, ckv, kr, pos, mla_q_norm, w_uq, mla_kv_norm, w_ukv)
    o_nsa = nsa_group(q_n.reshape(B, S, NSA_HEADS, NSA_DK),
                      k_n.reshape(B, S, N_BRANCH, NSA_GROUPS, NSA_DK),
                      v_n.reshape(B, S, N_BRANCH, NSA_GROUPS, NSA_DV),
                      jax.nn.sigmoid(g_n.reshape(B, S, NSA_HEADS, N_BRANCH)),
                      pe_cmp_k, w_cmp_k1, w_cmp_k2, pe_cmp_v, w_cmp_v1, w_cmp_v2, rel_bias)
    return jnp.concatenate([o_mla, o_nsa], axis=-1) @ w_out


def setup_inputs(seed: int = 0) -> dict:
    key = jax.random.key(seed)
    keys = iter(jax.random.split(key, 40))
    L, D = DEPTH, D_MODEL

    def nrm(shape, s=1.0):
        return jax.random.normal(next(keys), shape, jnp.float32) * s

    def w(shape, fan_in, s=1.0):
        return nrm(shape, s * fan_in ** -0.5)

    def gain(shape):
        return 1.0 + nrm(shape, 0.02)

    return {
        'x': nrm((BATCH, SEQ, D)),
        'c': nrm((BATCH, D)),
        'w_ada': w((L, D, 9 * D), D, 0.5),
        'b_ada': nrm((L, 9 * D), 0.02),
        'norm_ffn1': gain((L, D)),
        'w1_gate': w((L, D, D_FF), D),
        'w1_up': w((L, D, D_FF), D),
        'w1_down': w((L, D_FF, D), D_FF),
        'norm_mix': gain((L, D)),
        'w_in': w((L, D, D_IN), D),
        'mla_q_norm': gain((L, MLA_Q_RANK)),
        'w_uq': w((L, MLA_Q_RANK, MLA_HEADS * (MLA_NOPE + MLA_ROPE)), MLA_Q_RANK),
        'mla_kv_norm': gain((L, MLA_KV_RANK)),
        'w_ukv': w((L, MLA_KV_RANK, MLA_HEADS * (MLA_NOPE + MLA_V)), MLA_KV_RANK),
        'pe_cmp_k': nrm((L, CMP_LEN, NSA_DK), 0.1),
        'w_cmp_k1': w((L, CMP_LEN * NSA_DK, CMP_HIDDEN), CMP_LEN * NSA_DK),
        'w_cmp_k2': w((L, CMP_HIDDEN, NSA_DK), CMP_HIDDEN),
        'pe_cmp_v': nrm((L, CMP_LEN, NSA_DV), 0.1),
        'w_cmp_v1': w((L, CMP_LEN * NSA_DV, CMP_HIDDEN), CMP_LEN * NSA_DV),
        'w_cmp_v2': w((L, CMP_HIDDEN, NSA_DV), CMP_HIDDEN),
        'rel_bias': nrm((REL_BUCKETS, NSA_HEADS), 0.1),
        'w_out': w((L, MIX_WIDTH, D), MIX_WIDTH),
        'norm_ffn2': gain((L, D)),
        'w2_gate': w((L, D, D_FF), D),
        'w2_up': w((L, D, D_FF), D),
        'w2_down': w((L, D_FF, D), D_FF),
        'norm_final': gain((D,)),
    }


def reference(x, c, w_ada, b_ada, norm_ffn1, w1_gate, w1_up, w1_down, norm_mix, w_in,
              mla_q_norm, w_uq, mla_kv_norm, w_ukv, pe_cmp_k, w_cmp_k1, w_cmp_k2,
              pe_cmp_v, w_cmp_v1, w_cmp_v2, rel_bias, w_out, norm_ffn2, w2_gate, w2_up,
              w2_down, norm_final):
    for l in range(DEPTH):
        mod = jax.nn.silu(c) @ w_ada[l] + b_ada[l]
        sh1, sc1, g1, sh2, sc2, g2, sh3, sc3, g3 = jnp.split(mod, 9, axis=-1)
        h = modulate(rms_norm(x, norm_ffn1[l]), sh1, sc1)
        x = x + 0.5 * g1[:, None, :] * swiglu(h, w1_gate[l], w1_up[l], w1_down[l])
        h = modulate(rms_norm(x, norm_mix[l]), sh2, sc2)
        x = x + g2[:, None, :] * token_mixing(h, w_in[l], mla_q_norm[l], w_uq[l], mla_kv_norm[l],
                                              w_ukv[l], pe_cmp_k[l], w_cmp_k1[l], w_cmp_k2[l],
                                              pe_cmp_v[l], w_cmp_v1[l], w_cmp_v2[l], rel_bias,
                                              w_out[l])
        h = modulate(rms_norm(x, norm_ffn2[l]), sh3, sc3)
        x = x + 0.5 * g3[:, None, :] * swiglu(h, w2_gate[l], w2_up[l], w2_down[l])
    return rms_norm(x, norm_final)
```

```cpp
#include <hip/hip_runtime.h>
#include <cstdio>
#include <cstdint>
#include <cmath>
namespace pg8 {
#define PG8_LAS __attribute__((address_space(3)))
typedef unsigned short bf16_t;
typedef short bf16x8 __attribute__((ext_vector_type(8)));
typedef float f32x4 __attribute__((ext_vector_type(4)));
typedef unsigned u32x4 __attribute__((ext_vector_type(4)));
constexpr int BM = 256, BK = 64, HALF = 128, HTB = HALF * BK * 2  , STAGE_BYTES = 8 * HTB, NXCD = 8, WGM = 8;

__host__ __device__ __forceinline__ int lds_byte(int r, int c) { const int st = (r >> 4) * 2 + (c >> 5), rr = r & 15, cc = c & 31, ob = rr * 64 + cc * 2; return st * 1024 + (ob ^ (((ob >> 9) & 1) << 5)); }
__host__ __device__ __forceinline__ void stage_rc(int b, int& R, int& C) { const int st = b / 1024, sb = b % 1024, swz = sb ^ (((sb >> 9) & 1) << 5); R = (st >> 1) * 16 + swz / 64; C = (st & 1) * 32 + (swz % 64) / 2; }
__host__ __device__ __forceinline__ int perm32(int rho) { const int n = rho >> 4, i = rho & 15; return 8 * (i >> 2) + 4 * n + (i & 3); }

struct Unit { int pm, pn; };
struct Gemm { const bf16_t* A; const bf16_t* Bt; int M, N, K, lda, ldb; };

struct StaticOrder {
    int nM, nN, nwg, G, c;
    __host__ __device__ void init(int M, int N, int G_, int c_) { nM = M / BM; nN = N / BM; nwg = nM * nN; G = G_; c = c_; }
    __host__ __device__ void init_units(int nM_, int nN_, int G_, int c_) { nM = nM_; nN = nN_; nwg = nM * nN; G = G_; c = c_; }
    __host__ __device__ bool next(int i, Unit& u) const {
        const long L = (long)i * G + c; if (L >= nwg) return false;
        int wgid = (int)L; { const int q = nwg / NXCD, r = nwg % NXCD, xcd = wgid % NXCD, off = wgid / NXCD; wgid = (xcd < r ? xcd * (q + 1) : r * (q + 1) + (xcd - r) * q) + off; }
        const int nig = WGM * nN, gid = wgid / nig, fm = gid * WGM, gsz = (nM - fm) < WGM ? (nM - fm) : WGM;
        u.pm = fm + ((wgid % nig) % gsz); u.pn = (wgid % nig) / gsz; return true;
    }
    __device__ __forceinline__ void a_ready(const Unit&) const {}
    __device__ __forceinline__ void done(const Unit&) const {}
};
__device__ __forceinline__ unsigned cvt_pk_bf16(float lo, float hi) { unsigned r; asm volatile("v_cvt_pk_bf16_f32 %0, %1, %2" : "=v"(r) : "v"(lo), "v"(hi)); return r; }
typedef unsigned u32x4 __attribute__((ext_vector_type(4)));
__device__ __forceinline__ float silu_f(float v) { return v * __builtin_amdgcn_rcpf(1.0f + __builtin_amdgcn_exp2f(-1.4426950408889634f * v)); }
struct EpiSwiglu {
    static constexpr bool PERM = true, AFTER_DRAIN = false;
    bf16_t* O; int ldc;
    __device__ __forceinline__ void operator()(const f32x4 (&acc)[2][2][4][2], const Unit& u, int wr, int wc, int fr, int fq) const {
        const int row0 = u.pm * BM + wr * 64 + fr, col0 = u.pn * 128 + wc * 32 + 8 * fq;
#pragma unroll
        for (int ai = 0; ai < 2; ++ai)
#pragma unroll
            for (int m = 0; m < 4; ++m) {
                bf16_t* rowp = O + (size_t)(row0 + ai * HALF + m * 16) * ldc + col0;
                const f32x4 g0 = acc[ai][0][m][0], g1 = acc[ai][0][m][1], u0 = acc[ai][1][m][0], u1 = acc[ai][1][m][1];
                u32x4 w;
                w.x = cvt_pk_bf16(silu_f(g0[0]) * u0[0], silu_f(g0[1]) * u0[1]); w.y = cvt_pk_bf16(silu_f(g0[2]) * u0[2], silu_f(g0[3]) * u0[3]);
                w.z = cvt_pk_bf16(silu_f(g1[0]) * u1[0], silu_f(g1[1]) * u1[1]); w.w = cvt_pk_bf16(silu_f(g1[2]) * u1[2], silu_f(g1[3]) * u1[3]);
                *(u32x4*)rowp = w;
            }
    }
};
struct EpiStore {
    static constexpr bool PERM = true, AFTER_DRAIN = false;
    bf16_t* O; int ldc;
    __device__ __forceinline__ void operator()(const f32x4 (&acc)[2][2][4][2], const Unit& u, int wr, int wc, int fr, int fq) const {
        const int row0 = u.pm * BM + wr * 64 + fr, col0 = u.pn * BM + wc * 32 + 8 * fq;
#pragma unroll
        for (int ai = 0; ai < 2; ++ai)
#pragma unroll
            for (int m = 0; m < 4; ++m) {
                bf16_t* rowp = O + (size_t)(row0 + ai * HALF + m * 16) * ldc + col0;
#pragma unroll
                for (int bj = 0; bj < 2; ++bj) {
                    const f32x4 v0 = acc[ai][bj][m][0], v1 = acc[ai][bj][m][1];
                    u32x4 w; w.x = cvt_pk_bf16(v0[0], v0[1]); w.y = cvt_pk_bf16(v0[2], v0[3]); w.z = cvt_pk_bf16(v1[0], v1[1]); w.w = cvt_pk_bf16(v1[2], v1[3]);
                    *(u32x4*)(rowp + bj * HALF) = w;
                }
            }
    }
};
struct EpiResid {
    static constexpr bool PERM = false, AFTER_DRAIN = false;
    const float* base; float* out; int ldc; const float* gv; float coef;
    __device__ __forceinline__ void operator()(const f32x4 (&acc)[2][2][4][2], const Unit& u, int wr, int wc, int fr, int fq) const {
        const int col0 = u.pn * BM + wc * 32 + 4 * fq;
        f32x4 gg[2][2];
#pragma unroll
        for (int bj = 0; bj < 2; ++bj)
#pragma unroll
            for (int n = 0; n < 2; ++n) gg[bj][n] = *(const f32x4*)(gv + col0 + bj * HALF + n * 16) * coef;
#pragma unroll
        for (int ai = 0; ai < 2; ++ai)
#pragma unroll
            for (int m = 0; m < 4; ++m) {
                const size_t off = (size_t)(u.pm * BM + ai * HALF + wr * 64 + m * 16 + fr) * ldc + col0;
#pragma unroll
                for (int bj = 0; bj < 2; ++bj)
#pragma unroll
                    for (int n = 0; n < 2; ++n) {
                        const f32x4 bs = *(const f32x4*)(base + off + bj * HALF + n * 16);
                        *(f32x4*)(out + off + bj * HALF + n * 16) = bs + gg[bj][n] * acc[ai][bj][m][n];
                    }
            }
    }
};
struct EpiPart {
    static constexpr bool PERM = false, AFTER_DRAIN = false;
    float* P; int rows;
    __device__ __forceinline__ void operator()(const f32x4 (&acc)[2][2][4][2], const Unit& u, int wr, int wc, int fr, int fq) const {
        const int col0 = wc * 32 + 4 * fq;
#pragma unroll
        for (int ai = 0; ai < 2; ++ai)
#pragma unroll
            for (int m = 0; m < 4; ++m) {
                float* rowp = P + ((size_t)u.pn * rows + (u.pm * BM + ai * HALF + wr * 64 + m * 16 + fr)) * 256 + col0;
#pragma unroll
                for (int bj = 0; bj < 2; ++bj)
#pragma unroll
                    for (int n = 0; n < 2; ++n) *(f32x4*)(rowp + bj * HALF + n * 16) = acc[ai][bj][m][n];
            }
    }
};

template <class Epi, class Sched, bool ALIGN_EPI = false, bool SP2 = false, bool SPLITK = false>
__device__ __forceinline__ void gemm_phase(PG8_LAS unsigned char* lds, const Gemm g, const Sched& S, const Epi& E, int wave_id) {
    int lane_; asm volatile("v_mbcnt_lo_u32_b32 %0, -1, 0\n\tv_mbcnt_hi_u32_b32 %0, -1, %0" : "=v"(lane_));
    const int wid = wave_id, lane = lane_, tid = wid * 64 + lane, wr = wid >> 2, wc = wid & 3, fr = lane & 15, fq = lane >> 4;
    const int K = g.K, nt = K / BK;
    unsigned voffA[2], voffB[2];
#pragma unroll
    for (int i = 0; i < 2; ++i) { int R, C; stage_rc(tid * 16 + i * 8192, R, C); const int Rb = Epi::PERM ? ((R & ~31) + perm32(R & 31)) : R;
        voffA[i] = (unsigned)(R * g.lda + C) * 2u; voffB[i] = (unsigned)(Rb * g.ldb + C) * 2u; }
    const size_t kstep = (size_t)(BK * 2);
    const size_t hstepA = (size_t)HALF * g.lda * 2, hstepB = (size_t)HALF * g.ldb * 2;
    const size_t tstepA = 2 * hstepA, tstepB = 2 * hstepB; const size_t kchunk = (size_t)K * 2;
    const unsigned ldsw = (unsigned)wid * 1024u;
    const int aoff = lds_byte(wr * 64 + fr, fq * 8), boff = lds_byte(wc * 32 + fr, fq * 8);
#define PG8_SA(b, h) (((b) * 2 + (h)) * HTB)
#define PG8_SB(b, h) ((4 + (b) * 2 + (h)) * HTB)
#define PG8_STAGE(bufoff, gbase, voff) do { _Pragma("unroll") for (int _i = 0; _i < 2; ++_i) \
        __builtin_amdgcn_global_load_lds((const unsigned*)((const char*)(gbase) + (voff)[_i]), (PG8_LAS unsigned*)(lds + (bufoff) + ldsw + _i * 8192), 16, 0, 0); } while (0)
#define PG8_LDA(dst, b, h) do { _Pragma("unroll") for (int m = 0; m < 4; ++m) _Pragma("unroll") for (int k = 0; k < 2; ++k) dst[m][k] = *(const PG8_LAS bf16x8*)(lds + PG8_SA(b, h) + aoff + m * 2048 + k * 1024); } while (0)
#define PG8_LDB(dst, b, h) do { _Pragma("unroll") for (int n = 0; n < 2; ++n) _Pragma("unroll") for (int k = 0; k < 2; ++k) dst[n][k] = *(const PG8_LAS bf16x8*)(lds + PG8_SB(b, h) + boff + n * 2048 + k * 1024); } while (0)
#define PG8_MMA(ai, bj, At, Bt) do { __builtin_amdgcn_s_setprio(1); _Pragma("unroll") for (int m = 0; m < 4; ++m) _Pragma("unroll") for (int n = 0; n < 2; ++n) _Pragma("unroll") for (int k = 0; k < 2; ++k) \
        acc[ai][bj][m][n] = __builtin_amdgcn_mfma_f32_16x16x32_bf16(Bt[n][k], At[m][k], acc[ai][bj][m][n], 0, 0, 0); __builtin_amdgcn_s_setprio(0); } while (0)
#define PG8_WAIT_V(n) asm volatile("s_waitcnt vmcnt(" #n ")" ::: "memory")
#define PG8_WAIT_L(n) asm volatile("s_waitcnt lgkmcnt(" #n ")" ::: "memory")
#define PG8_BAR __builtin_amdgcn_s_barrier()
#define PG8_SCHED __builtin_amdgcn_sched_barrier(0)
    Unit cur, nxt; int ui = 0;
    if (!S.next(0, cur)) return;
    f32x4 acc[2][2][4][2];
#pragma unroll
    for (int a = 0; a < 2; ++a)
#pragma unroll
        for (int b = 0; b < 2; ++b)
#pragma unroll
            for (int m = 0; m < 4; ++m)
#pragma unroll
                for (int n = 0; n < 2; ++n) acc[a][b][m][n] = (f32x4){0.f, 0.f, 0.f, 0.f};
    bf16x8 At[4][2], B0[2][2], B1[2][2];
    const char* cA = (const char*)g.A + (size_t)cur.pm * tstepA + (SPLITK ? (size_t)cur.pn * kchunk : 0); const char* cB = (const char*)g.Bt + (SPLITK ? (size_t)cur.pn * kchunk : (size_t)cur.pn * tstepB);
    S.a_ready(cur);
    if constexpr (SP2) {
        PG8_STAGE(PG8_SB(0, 0), cB, voffB); PG8_STAGE(PG8_SB(0, 1), cB + hstepB, voffB); PG8_STAGE(PG8_SA(0, 0), cA, voffA); PG8_STAGE(PG8_SA(0, 1), cA + hstepA, voffA);
        if (wr == 1) PG8_BAR;
        PG8_WAIT_V(2); PG8_BAR;
        PG8_STAGE(PG8_SB(1, 0), cB + kstep, voffB); PG8_STAGE(PG8_SA(1, 0), cA + kstep, voffA); PG8_STAGE(PG8_SB(1, 1), cB + hstepB + kstep, voffB);
        PG8_WAIT_V(6); PG8_BAR;
    } else {
        PG8_STAGE(PG8_SB(0, 0), cB, voffB); PG8_STAGE(PG8_SA(0, 0), cA, voffA); PG8_STAGE(PG8_SB(0, 1), cB + hstepB, voffB); PG8_STAGE(PG8_SA(0, 1), cA + hstepA, voffA);
        if (wr == 1) PG8_BAR;
        PG8_WAIT_V(4); PG8_BAR;
        PG8_STAGE(PG8_SB(1, 0), cB + kstep, voffB); PG8_STAGE(PG8_SA(1, 0), cA + kstep, voffA); PG8_STAGE(PG8_SB(1, 1), cB + hstepB + kstep, voffB);
        PG8_WAIT_V(6); PG8_BAR;
    }
    for (;;) {
        const bool has_next = S.next(ui + 1, nxt);
        const char* nA = has_next ? (const char*)g.A + (size_t)nxt.pm * tstepA + (SPLITK ? (size_t)nxt.pn * kchunk : 0) : cA; const char* nB = has_next ? (const char*)g.Bt + (SPLITK ? (size_t)nxt.pn * kchunk : (size_t)nxt.pn * tstepB) : cB;
        for (int t = 0; t < nt; t += 2) {
            const bool last = (t == nt - 2);
            const char* a1 = cA + (size_t)(t + 1) * kstep;
            const char* a2 = last ? nA : cA + (size_t)(t + 2) * kstep; const char* b2 = last ? nB : cB + (size_t)(t + 2) * kstep;
            const char* a3 = a2 + kstep; const char* b3 = b2 + kstep;
            if (last && has_next) S.a_ready(nxt);
            if constexpr (SP2) {
            PG8_LDB(B0, 0, 0); PG8_LDB(B1, 0, 1); PG8_SCHED; PG8_LDA(At, 0, 0); PG8_STAGE(PG8_SA(1, 1), a1 + hstepA, voffA);
            PG8_WAIT_V(8); PG8_WAIT_L(0); PG8_BAR; PG8_MMA(0, 0, At, B0); PG8_MMA(0, 1, At, B1); PG8_BAR; PG8_SCHED;
            PG8_LDA(At, 0, 1); PG8_STAGE(PG8_SB(0, 0), b2, voffB); PG8_STAGE(PG8_SB(0, 1), b2 + hstepB, voffB); PG8_STAGE(PG8_SA(0, 0), a2, voffA);
            PG8_WAIT_V(8); PG8_WAIT_L(0); PG8_BAR; PG8_MMA(1, 0, At, B0); PG8_MMA(1, 1, At, B1); PG8_BAR; PG8_SCHED;
            PG8_LDB(B0, 1, 0); PG8_LDB(B1, 1, 1); PG8_SCHED; PG8_LDA(At, 1, 0); PG8_STAGE(PG8_SA(0, 1), a2 + hstepA, voffA);
            PG8_WAIT_V(8); PG8_WAIT_L(0); PG8_BAR; PG8_MMA(0, 0, At, B0); PG8_MMA(0, 1, At, B1); PG8_BAR; PG8_SCHED;
            PG8_LDA(At, 1, 1); PG8_STAGE(PG8_SB(1, 0), b3, voffB); PG8_STAGE(PG8_SB(1, 1), b3 + hstepB, voffB); PG8_STAGE(PG8_SA(1, 0), a3, voffA);
            PG8_WAIT_V(8); PG8_WAIT_L(0); PG8_BAR; PG8_MMA(1, 0, At, B0); PG8_MMA(1, 1, At, B1); PG8_BAR; PG8_SCHED;
            } else {
            PG8_LDB(B0, 0, 0); PG8_SCHED; PG8_LDA(At, 0, 0); PG8_STAGE(PG8_SA(1, 1), a1 + hstepA, voffA);
            PG8_WAIT_L(8); PG8_BAR; PG8_WAIT_L(0); PG8_MMA(0, 0, At, B0); PG8_BAR; PG8_SCHED;
            PG8_LDB(B1, 0, 1); PG8_STAGE(PG8_SB(0, 0), b2, voffB);
            PG8_BAR; PG8_WAIT_L(0); PG8_MMA(0, 1, At, B1); PG8_BAR;
            PG8_LDA(At, 0, 1); PG8_STAGE(PG8_SA(0, 0), a2, voffA);
            PG8_BAR; PG8_WAIT_L(0); PG8_MMA(1, 0, At, B0); PG8_BAR; PG8_SCHED;
            PG8_STAGE(PG8_SB(0, 1), b2 + hstepB, voffB);
            PG8_WAIT_V(6); PG8_BAR; PG8_MMA(1, 1, At, B1); PG8_BAR;
            PG8_LDB(B0, 1, 0); PG8_SCHED; PG8_LDA(At, 1, 0); PG8_STAGE(PG8_SA(0, 1), a2 + hstepA, voffA);
            PG8_WAIT_L(8); PG8_BAR; PG8_WAIT_L(0); PG8_MMA(0, 0, At, B0); PG8_BAR; PG8_SCHED;
            PG8_LDB(B1, 1, 1); PG8_STAGE(PG8_SB(1, 0), b3, voffB);
            PG8_BAR; PG8_WAIT_L(0); PG8_MMA(0, 1, At, B1); PG8_BAR;
            PG8_LDA(At, 1, 1); PG8_STAGE(PG8_SA(1, 0), a3, voffA);
            PG8_BAR; PG8_WAIT_L(0); PG8_MMA(1, 0, At, B0); PG8_BAR; PG8_SCHED;
            PG8_STAGE(PG8_SB(1, 1), b3 + hstepB, voffB);
            PG8_WAIT_V(6); PG8_BAR; PG8_MMA(1, 1, At, B1); PG8_BAR;
            }
        }
        if constexpr (ALIGN_EPI) { if (wr == 0) PG8_BAR; }
        if constexpr (!Epi::AFTER_DRAIN) { E(acc, cur, wr, wc, fr, fq); S.done(cur); }
        if (!has_next) break;
#pragma unroll
        for (int a = 0; a < 2; ++a)
#pragma unroll
            for (int b = 0; b < 2; ++b)
#pragma unroll
                for (int m = 0; m < 4; ++m)
#pragma unroll
                    for (int n = 0; n < 2; ++n) acc[a][b][m][n] = (f32x4){0.f, 0.f, 0.f, 0.f};
        cur = nxt; cA = nA; cB = nB; ++ui;
        if constexpr (ALIGN_EPI) { if (wr == 1) PG8_BAR; }
    }
    PG8_WAIT_V(0);
    if constexpr (!ALIGN_EPI) { if (wr == 0) PG8_BAR; }
    PG8_BAR;
    if constexpr (Epi::AFTER_DRAIN) { E.fused(acc, cur, wr, wc, fr, fq, lds, wid, lane); S.done(cur); }
#undef PG8_SA
#undef PG8_SB
#undef PG8_STAGE
#undef PG8_LDA
#undef PG8_LDB
#undef PG8_MMA
#undef PG8_WAIT_V
#undef PG8_WAIT_L
#undef PG8_BAR
#undef PG8_SCHED
}
}

constexpr int S_ = 8192, D_ = 2048, FF_ = 5632, DIN = 4824, DINP = 4864;
constexpr int O_CQ = 0, O_CKV = 768, O_KR = 1280, O_QN = 1344, O_KN = 2880, O_VN = 4032, O_GN = 4800;
constexpr int NWAVES = 8, NTHR = 512;
constexpr size_t MiB = 1u << 20;
constexpr size_t WS_CTL = 0;
constexpr size_t WS_MODP = 507 * MiB;
constexpr size_t WS_MOD = 2 * MiB;
constexpr size_t WS_ROPE = 3 * MiB;
constexpr size_t WS_WGU1 = 6 * MiB;
constexpr size_t WS_WD1 = 50 * MiB;
constexpr size_t WS_WIN = 72 * MiB;
constexpr size_t WS_WUQ = 91 * MiB;
constexpr size_t WS_WUKV = 94 * MiB;
constexpr size_t WS_WCK1 = 96 * MiB;
constexpr size_t WS_WCV1 = 99 * MiB;
constexpr size_t WS_WCK2 = 101 * MiB;
constexpr size_t WS_WCV2 = 101 * MiB + 512 * 1024;
constexpr size_t WS_WOUT = 102 * MiB;
constexpr size_t WS_WGU2 = 110 * MiB;
constexpr size_t WS_WD2 = 154 * MiB;
constexpr size_t WS_H = 176 * MiB;
constexpr size_t WS_ACT = 208 * MiB;
constexpr size_t WS_X1 = 296 * MiB;
constexpr size_t WS_Q = 360 * MiB;
constexpr size_t WS_KV = 384 * MiB;
constexpr size_t WS_KR = 416 * MiB;
constexpr size_t WS_CQN = 417 * MiB;
constexpr size_t WS_CKVN = 429 * MiB;
constexpr size_t WS_FLATK = 437 * MiB;
constexpr size_t WS_FLATV = 449 * MiB;
constexpr size_t WS_PARTK = 457 * MiB;
constexpr size_t WS_PARTV = 469 * MiB;
constexpr size_t WS_HIDK = 473 * MiB;
constexpr size_t WS_HIDV = 473 * MiB + 512 * 1024;
constexpr size_t WS_KC = 474 * MiB;
constexpr size_t WS_VC = 474 * MiB + 512 * 1024;
constexpr size_t WS_MIXF = 475 * MiB;
constexpr size_t WS_END = 509 * MiB;
constexpr int KCH_K = 512, NCH_K = 12, KCH_V = 1024, NCH_V = 4;

constexpr int RING_BYTES = 131072, LDSCTL_OFF = RING_BYTES, MISC_OFF = LDSCTL_OFF + 320, LDS_BYTES = 147456;

#define GAS __attribute__((address_space(1)))
#define LAS __attribute__((address_space(3)))
typedef unsigned short bf16;
typedef unsigned v4u __attribute__((ext_vector_type(4)));
typedef unsigned v2u __attribute__((ext_vector_type(2)));
typedef float f32x4 __attribute__((ext_vector_type(4)));
typedef GAS unsigned gu32;
#define RLX_AGENT __ATOMIC_RELAXED, __HIP_MEMORY_SCOPE_AGENT
#define LDS_WAIT() asm volatile("s_waitcnt lgkmcnt(0)" ::: "memory")
#define VM_WAIT() asm volatile("s_waitcnt vmcnt(0)" ::: "memory")
__device__ __forceinline__ unsigned f2bf(float f) { unsigned u = __builtin_bit_cast(unsigned, f); return (u + 0x7fffu + ((u >> 16) & 1u)) >> 16; }
__device__ __forceinline__ unsigned pk2(float lo, float hi) { return f2bf(lo) | (f2bf(hi) << 16); }
__device__ __forceinline__ float bflo(unsigned w) { return __builtin_bit_cast(float, w << 16); }
__device__ __forceinline__ float bfhi(unsigned w) { return __builtin_bit_cast(float, w & 0xffff0000u); }
__device__ __forceinline__ float bf1(bf16 b) { return __builtin_bit_cast(float, (unsigned)b << 16); }
__device__ __forceinline__ float wave_sum(float v) {
#pragma unroll
    for (int o = 1; o < 64; o <<= 1) v += __shfl_xor(v, o);
    return v;
}

#define XB_TMO      128
#define XB_XCNT(j)  (256  + 64 * (j))
#define XB_XSUB(j)  (1280 + 64 * (j))
#define XB_XGEN(j)  (2304 + 64 * (j))
#define XB_TOP      3328
#define XB_TOPGEN   3392
#define XCD_BAR_WORDS 3456
#define XB_SPIN_CAP (1u << 18)

__device__ __forceinline__ unsigned xb_ld(unsigned* p)              { return __hip_atomic_load(p, __ATOMIC_RELAXED, __HIP_MEMORY_SCOPE_AGENT); }
__device__ __forceinline__ unsigned xb_add(unsigned* p, unsigned v) { return __hip_atomic_fetch_add(p, v, __ATOMIC_RELAXED, __HIP_MEMORY_SCOPE_AGENT); }
__device__ __forceinline__ unsigned xb_xcc_id() { return (unsigned)__builtin_amdgcn_s_getreg((3 << 11) | 20) & 0xFu; }
#define XB_SPIN(cond, bar) do { unsigned _sp = 0; while (cond) { __builtin_amdgcn_s_sleep(1); \
    if ((++_sp & 255u) == 0u) { if (xb_ld(&(bar)[XB_TMO])) break; if (_sp > XB_SPIN_CAP) { atomicAdd(&(bar)[XB_TMO], 1u); break; } } } } while (0)

struct XcdBarrier {
    int w0;
    unsigned* bar; unsigned x;
    volatile LAS unsigned* st;
};

__device__ __forceinline__ int xb_lane() { int l; asm volatile("v_mbcnt_lo_u32_b32 %0, -1, 0\n\tv_mbcnt_hi_u32_b32 %0, -1, %0" : "=v"(l)); return l; }
__device__ __forceinline__ XcdBarrier xcd_barrier_post(unsigned* bar, volatile LAS unsigned* st, int w0) {
    XcdBarrier b; b.w0 = w0; b.bar = bar; b.x = xb_xcc_id(); b.st = st;
    if (w0 && xb_lane() == 0) (void)xb_add(&bar[XB_XCNT(b.x)], 1u);
    return b;
}
__device__ __forceinline__ void xcd_barrier_complete(unsigned* bar, unsigned x, unsigned& nloc, unsigned& nx) {
    const unsigned G = gridDim.x * gridDim.y * gridDim.z;
    unsigned sum, cnt, mine, sp = 0u;
    for (;;) {
        sum = 0u; cnt = 0u; mine = 0u;
#pragma unroll
        for (unsigned j = 0; j < 16; ++j) { const unsigned c = xb_ld(&bar[XB_XCNT(j)]); sum += c; cnt += (c > 0u) ? 1u : 0u; mine = (j == x) ? c : mine; }
        if (sum == G) break;
        __builtin_amdgcn_s_sleep(1);
        if ((++sp & 255u) == 0u) { if (xb_ld(&bar[XB_TMO])) break; if (sp > XB_SPIN_CAP) { atomicAdd(&bar[XB_TMO], 1u); break; } }
    }
    nloc = mine > 0u ? mine : 1u; nx = cnt > 0u ? cnt : 1u;
}

__device__ __forceinline__ void xcd_barrier(const XcdBarrier& b) {
    asm volatile("s_waitcnt vmcnt(0)" ::: "memory");
    __syncthreads();
    if (b.w0 && xb_lane() == 0) {
        unsigned* bar = b.bar;
        __builtin_amdgcn_s_waitcnt(0);
        unsigned nloc = b.st[0], nx = b.st[1];
        if (nloc == 0u) { xcd_barrier_complete(bar, b.x, nloc, nx); b.st[0] = nloc; b.st[1] = nx; }
        const unsigned old = xb_add(&bar[XB_XSUB(b.x)], 1u);
        const unsigned gen = old / nloc;
        if (old + 1u == (gen + 1u) * nloc) {
            __builtin_amdgcn_fence(__ATOMIC_RELEASE, "agent");
            asm volatile("s_waitcnt vmcnt(0)" ::: "memory");
            const unsigned og = xb_add(&bar[XB_TOP], 1u);
            const unsigned tg = og / nx;
            if (og + 1u == (tg + 1u) * nx) xb_add(&bar[XB_TOPGEN], 1u);
            else XB_SPIN(xb_ld(&bar[XB_TOPGEN]) == tg, bar);
            __builtin_amdgcn_fence(__ATOMIC_ACQUIRE, "agent");
            xb_add(&bar[XB_XGEN(b.x)], 1u);
            asm volatile("s_waitcnt vmcnt(0)" ::: "memory");
        } else {
            XB_SPIN(xb_ld(&bar[XB_XGEN(b.x)]) == gen, bar);
            __builtin_amdgcn_fence(__ATOMIC_ACQUIRE, "agent");
            asm volatile("s_waitcnt vmcnt(0)" ::: "memory");
        }
    }
    __syncthreads();
}

struct Ctx { LAS unsigned char* lds; int tid, lane, wave, vcu, G; };

__device__ __forceinline__ void tr_item(const float* W, int K, int Nreal, int nblk, bf16* WT, int mode, LAS float* scr, int item, int lane) {
    const int kb = item / nblk, nb = item % nblk, k0 = 64 * kb, n0 = 32 * nb;
    const int n4 = (lane & 7) * 4, kr = lane >> 3; const bool ok = n0 + n4 < Nreal;
    f32x4 v[8];
#pragma unroll
    for (int i = 0; i < 8; ++i) v[i] = ok ? __builtin_nontemporal_load((const f32x4*)(W + (size_t)(k0 + kr + 8 * i) * Nreal + n0 + n4)) : (f32x4){0.f, 0.f, 0.f, 0.f};
#pragma unroll
    for (int i = 0; i < 8; ++i) { LAS float* d = scr + (kr + 8 * i) * 33 + n4; d[0] = v[i].x; d[1] = v[i].y; d[2] = v[i].z; d[3] = v[i].w; }
    LDS_WAIT(); asm volatile("" ::: "memory");
    const int c = lane & 7;
    const int drow0 = mode == 0 ? n0 : ((n0 >> 7) * 256 + (n0 & 127) + (mode == 2 ? 128 : 0));
#pragma unroll
    for (int j = 0; j < 4; ++j) { const int n = (lane >> 3) + 8 * j; const LAS float* s = scr + (8 * c) * 33 + n;
        v4u o; o.x = pk2(s[0 * 33], s[1 * 33]); o.y = pk2(s[2 * 33], s[3 * 33]); o.z = pk2(s[4 * 33], s[5 * 33]); o.w = pk2(s[6 * 33], s[7 * 33]);
        *(GAS v4u*)(WT + (size_t)(drow0 + n) * K + k0 + 8 * c) = o; }
    LDS_WAIT(); asm volatile("" ::: "memory");
}

struct P0Args { const float *w1g, *w1u, *w1d, *win, *wuq, *wukv, *ck1, *ck2, *cv1, *cv2, *wout, *w2g, *w2u, *w2d, *c, *wada; unsigned char* ws; };
constexpr int I_GU = 32 * 176, I_DN = 88 * 64, I_IN = 32 * 152, I_UQ = 12 * 48, I_UKV = 8 * 64, I_CK1 = 96 * 8, I_CK2 = 4 * 8, I_CV1 = 64 * 8, I_CV2 = 4 * 8, I_OUT = 32 * 64;
constexpr int NIT_A = 2 * I_GU, NIT_B = I_DN + I_IN, NIT_C = I_UQ + I_UKV + I_CK1 + I_CK2 + I_CV1 + I_CV2 + I_OUT + I_DN, NIT_D = 2 * I_GU;
__device__ __forceinline__ void conv_item(int grp, int r, const P0Args& a, LAS float* scr, int lane) {
    unsigned char* ws = a.ws;
    if (grp == 0) {
        if (r < I_GU) { tr_item(a.w1g, 2048, 5632, 176, (bf16*)(ws + WS_WGU1), 1, scr, r, lane); return; } r -= I_GU;
        tr_item(a.w1u, 2048, 5632, 176, (bf16*)(ws + WS_WGU1), 2, scr, r, lane);
    } else if (grp == 1) {
        if (r < I_DN) { tr_item(a.w1d, 5632, 2048, 64, (bf16*)(ws + WS_WD1), 0, scr, r, lane); return; } r -= I_DN;
        tr_item(a.win, 2048, DIN, 152, (bf16*)(ws + WS_WIN), 0, scr, r, lane);
    } else if (grp == 2) {
        if (r < I_UQ) { tr_item(a.wuq, 768, 1536, 48, (bf16*)(ws + WS_WUQ), 0, scr, r, lane); return; } r -= I_UQ;
        if (r < I_UKV) { tr_item(a.wukv, 512, 2048, 64, (bf16*)(ws + WS_WUKV), 0, scr, r, lane); return; } r -= I_UKV;
        if (r < I_CK1) { tr_item(a.ck1, 6144, 256, 8, (bf16*)(ws + WS_WCK1), 0, scr, r, lane); return; } r -= I_CK1;
        if (r < I_CK2) { tr_item(a.ck2, 256, 192, 8, (bf16*)(ws + WS_WCK2), 0, scr, r, lane); return; } r -= I_CK2;
        if (r < I_CV1) { tr_item(a.cv1, 4096, 256, 8, (bf16*)(ws + WS_WCV1), 0, scr, r, lane); return; } r -= I_CV1;
        if (r < I_CV2) { tr_item(a.cv2, 256, 128, 8, (bf16*)(ws + WS_WCV2), 0, scr, r, lane); return; } r -= I_CV2;
        if (r < I_OUT) { tr_item(a.wout, 2048, 2048, 64, (bf16*)(ws + WS_WOUT), 0, scr, r, lane); return; } r -= I_OUT;
        tr_item(a.w2d, 5632, 2048, 64, (bf16*)(ws + WS_WD2), 0, scr, r, lane);
    } else {
        if (r < I_GU) { tr_item(a.w2g, 2048, 5632, 176, (bf16*)(ws + WS_WGU2), 1, scr, r, lane); return; } r -= I_GU;
        tr_item(a.w2u, 2048, 5632, 176, (bf16*)(ws + WS_WGU2), 2, scr, r, lane);
    }
}
__device__ __forceinline__ void conv_tail(const Ctx& F, const P0Args& a, int grp, int nitems, int nwg) {
    const int G = F.G, rem = nwg % G, c = (int)blockIdx.x;
    int rank, nidle;
    if (rem == 0) { rank = c; nidle = G; } else { if (c < rem) return; rank = c - rem; nidle = G - rem; }
    LAS float* scr = (LAS float*)(F.lds + F.wave * 16384);
    for (int it = rank * NWAVES + F.wave; it < nitems; it += nidle * NWAVES) conv_item(grp, it, a, scr, F.lane);
}
__device__ __forceinline__ void p0_prologue(const Ctx& F, const P0Args& a) {
    LAS float* scr = (LAS float*)(F.lds + F.wave * 16384);
    const int gw = F.vcu * NWAVES + F.wave, NGW = F.G * NWAVES;
    unsigned char* ws = a.ws;
    for (int it = gw; it < NIT_A; it += NGW) conv_item(0, it, a, scr, F.lane);
    float* modp = (float*)(ws + WS_MODP);
    for (int it = gw; it < 72 * 16; it += NGW) {
        const int cg = it >> 4, kc = it & 15, col = cg * 256 + F.lane * 4;
        const float* wp = a.wada + (size_t)(kc * 128) * 18432 + col; const float* cp = a.c + kc * 128;
        f32x4 acc = (f32x4){0.f, 0.f, 0.f, 0.f};
#pragma unroll 16
        for (int i = 0; i < 128; ++i) { const float ci = cp[i]; const float sl = ci / (1.f + __expf(-ci)); acc += __builtin_nontemporal_load((const f32x4*)(wp + (size_t)i * 18432)) * sl; }
        *(f32x4*)(modp + kc * 18432 + col) = acc;
    }
    float* cs = (float*)(ws + WS_ROPE); float* sn = cs + 8192 * 32;
    for (int idx = (F.vcu * NTHR + F.tid); idx < 8192 * 32; idx += F.G * NTHR) {
        const int t = idx >> 5, i = idx & 31;
        const float inv = powf(10000.0f, -(float)(2 * i) / 64.0f); const float ang = (float)t * inv;
        cs[idx] = cosf(ang); sn[idx] = sinf(ang);
    }
}

__device__ __forceinline__ void norm_rows_bf16(const Ctx& F, const float* X, bf16* O, const LAS float* gwt, const LAS float* sht) {
    const int gw = F.vcu * NWAVES + F.wave, NGW = F.G * NWAVES;
    for (int m = gw; m < S_; m += NGW) {
        const GAS f32x4* xr = (const GAS f32x4*)(X + (size_t)m * D_) + F.lane;
        f32x4 v[8]; float s = 0.f;
#pragma unroll
        for (int j = 0; j < 8; ++j) { v[j] = xr[64 * j]; s += (v[j].x * v[j].x + v[j].y * v[j].y) + (v[j].z * v[j].z + v[j].w * v[j].w); }
        const float rstd = 1.f / sqrtf(wave_sum(s) * (1.f / D_) + 1e-6f);
        GAS v2u* o8 = (GAS v2u*)(O + (size_t)m * D_) + F.lane;
#pragma unroll
        for (int j = 0; j < 8; ++j) { const f32x4 g = *(const LAS f32x4*)(gwt + 4 * (F.lane + 64 * j)), sh = *(const LAS f32x4*)(sht + 4 * (F.lane + 64 * j));
            const f32x4 y = v[j] * rstd * g + sh; v2u w; w.x = pk2(y.x, y.y); w.y = pk2(y.z, y.w); o8[64 * j] = w; }
    }
}
__device__ __forceinline__ void build_mod_tables(const Ctx& F, unsigned char* ws, const float* nw, const float* b_ada, int chunk_sh, bool first, LAS float* gwt, LAS float* sht) {
    const float* modp = (const float*)(ws + WS_MODP); float* mod = (float*)(ws + WS_MOD);
    if (first) {
        for (int col = blockIdx.x * NTHR + F.tid; col < 18432; col += F.G * NTHR) { { float a = b_ada[col];
#pragma unroll
            for (int k = 0; k < 16; ++k) a += modp[k * 18432 + col]; mod[col] = a; } }
    }
    for (int c = F.tid; c < D_; c += NTHR) {
        float sh, sc;
        if (first) { sh = b_ada[chunk_sh * D_ + c]; sc = b_ada[(chunk_sh + 1) * D_ + c];
#pragma unroll
            for (int k = 0; k < 16; ++k) { sh += modp[k * 18432 + chunk_sh * D_ + c]; sc += modp[k * 18432 + (chunk_sh + 1) * D_ + c]; } }
        else { sh = mod[chunk_sh * D_ + c]; sc = mod[(chunk_sh + 1) * D_ + c]; }
        gwt[c] = nw[c] * (1.f + sc); sht[c] = sh;
    }
    LDS_WAIT(); __syncthreads();
}

__device__ __forceinline__ void p6_prep(const Ctx& F, unsigned char* ws, const float* qn_w, const float* kvn_w, const float* pe_k, const float* pe_v) {
    const bf16* U = (const bf16*)(ws + WS_ACT);
    bf16* CQN = (bf16*)(ws + WS_CQN); bf16* CKVN = (bf16*)(ws + WS_CKVN); bf16* KR = (bf16*)(ws + WS_KR);
    const float* cs = (const float*)(ws + WS_ROPE); const float* sn = cs + 8192 * 32;
    const int gw = F.vcu * NWAVES + F.wave, NGW = F.G * NWAVES;
    for (int t = gw; t < S_; t += NGW) {
        const bf16* ur = U + (size_t)t * DINP;
        v2u a[3]; float s = 0.f;
#pragma unroll
        for (int j = 0; j < 3; ++j) { a[j] = *(const GAS v2u*)(ur + O_CQ + 4 * (F.lane + 64 * j)); const float x0 = bflo(a[j].x), x1 = bfhi(a[j].x), x2 = bflo(a[j].y), x3 = bfhi(a[j].y); s += (x0 * x0 + x1 * x1) + (x2 * x2 + x3 * x3); }
        float rstd = 1.f / sqrtf(wave_sum(s) * (1.f / 768.f) + 1e-6f);
#pragma unroll
        for (int j = 0; j < 3; ++j) { const int c0 = 4 * (F.lane + 64 * j); const f32x4 g = *(const f32x4*)(qn_w + c0);
            v2u w; w.x = pk2(bflo(a[j].x) * rstd * g.x, bfhi(a[j].x) * rstd * g.y); w.y = pk2(bflo(a[j].y) * rstd * g.z, bfhi(a[j].y) * rstd * g.w); *(GAS v2u*)(CQN + (size_t)t * 768 + c0) = w; }
        v2u b[2]; s = 0.f;
#pragma unroll
        for (int j = 0; j < 2; ++j) { b[j] = *(const GAS v2u*)(ur + O_CKV + 4 * (F.lane + 64 * j)); const float x0 = bflo(b[j].x), x1 = bfhi(b[j].x), x2 = bflo(b[j].y), x3 = bfhi(b[j].y); s += (x0 * x0 + x1 * x1) + (x2 * x2 + x3 * x3); }
        rstd = 1.f / sqrtf(wave_sum(s) * (1.f / 512.f) + 1e-6f);
#pragma unroll
        for (int j = 0; j < 2; ++j) { const int c0 = 4 * (F.lane + 64 * j); const f32x4 g = *(const f32x4*)(kvn_w + c0);
            v2u w; w.x = pk2(bflo(b[j].x) * rstd * g.x, bfhi(b[j].x) * rstd * g.y); w.y = pk2(bflo(b[j].y) * rstd * g.z, bfhi(b[j].y) * rstd * g.w); *(GAS v2u*)(CKVN + (size_t)t * 512 + c0) = w; }
        if (F.lane < 32) { const int i = F.lane; const float t1 = bf1(ur[O_KR + i]), t2 = bf1(ur[O_KR + i + 32]); const float c = cs[t * 32 + i], sv = sn[t * 32 + i];
            KR[(size_t)t * 64 + i] = (bf16)f2bf(t1 * c - t2 * sv); KR[(size_t)t * 64 + i + 32] = (bf16)f2bf(t1 * sv + t2 * c); }
    }
    bf16* FK = (bf16*)(ws + WS_FLATK); bf16* FV = (bf16*)(ws + WS_FLATV);
    const int gt = F.vcu * NTHR + F.tid, NGT = F.G * NTHR;
    for (int e = gt; e < 1024 * 768; e += NGT) {
        const int r = e / 768, c8 = e % 768, l = c8 / 24, d0 = (c8 % 24) * 8, n = r >> 1, g = r & 1;
        v4u o = (v4u){0u, 0u, 0u, 0u};
        if (r < 1022) { const v4u u = *(const GAS v4u*)(U + (size_t)(16 * n + l) * DINP + O_KN + g * 192 + d0); const f32x4 p0 = *(const f32x4*)(pe_k + l * 192 + d0), p1 = *(const f32x4*)(pe_k + l * 192 + d0 + 4);
            o.x = pk2(bflo(u.x) + p0.x, bfhi(u.x) + p0.y); o.y = pk2(bflo(u.y) + p0.z, bfhi(u.y) + p0.w); o.z = pk2(bflo(u.z) + p1.x, bfhi(u.z) + p1.y); o.w = pk2(bflo(u.w) + p1.z, bfhi(u.w) + p1.w); }
        *(GAS v4u*)(FK + (size_t)r * 6144 + c8 * 8) = o;
    }
    for (int e = gt; e < 1024 * 512; e += NGT) {
        const int r = e / 512, c8 = e % 512, l = c8 / 16, d0 = (c8 % 16) * 8, n = r >> 1, g = r & 1;
        v4u o = (v4u){0u, 0u, 0u, 0u};
        if (r < 1022) { const v4u u = *(const GAS v4u*)(U + (size_t)(16 * n + l) * DINP + O_VN + g * 128 + d0); const f32x4 p0 = *(const f32x4*)(pe_v + l * 128 + d0), p1 = *(const f32x4*)(pe_v + l * 128 + d0 + 4);
            o.x = pk2(bflo(u.x) + p0.x, bfhi(u.x) + p0.y); o.y = pk2(bflo(u.y) + p0.z, bfhi(u.y) + p0.w); o.z = pk2(bflo(u.z) + p1.x, bfhi(u.z) + p1.y); o.w = pk2(bflo(u.w) + p1.z, bfhi(u.w) + p1.w); }
        *(GAS v4u*)(FV + (size_t)r * 4096 + c8 * 8) = o;
    }
}

__device__ __forceinline__ void p8_prep2(const Ctx& F, unsigned char* ws) {
    bf16* Q = (bf16*)(ws + WS_Q);
    const float* cs = (const float*)(ws + WS_ROPE); const float* sn = cs + 8192 * 32;
    const int gw = F.vcu * NWAVES + F.wave, NGW = F.G * NWAVES;
    for (int t = gw; t < S_; t += NGW) {
        const int i = F.lane & 31; const float c = cs[t * 32 + i], sv = sn[t * 32 + i];
#pragma unroll
        for (int j = 0; j < 4; ++j) { const int h = j * 2 + (F.lane >> 5); bf16* qp = Q + (size_t)t * 1536 + h * 192 + 128;
            const float t1 = bf1(qp[i]), t2 = bf1(qp[i + 32]); qp[i] = (bf16)f2bf(t1 * c - t2 * sv); qp[i + 32] = (bf16)f2bf(t1 * sv + t2 * c); }
    }
    const int gt = F.vcu * NTHR + F.tid, NGT = F.G * NTHR;
    const float* PK = (const float*)(ws + WS_PARTK); const float* PV = (const float*)(ws + WS_PARTV);
    bf16* HK = (bf16*)(ws + WS_HIDK); bf16* HV = (bf16*)(ws + WS_HIDV);
    for (int e = gt; e < 2 * 65536; e += NGT) {
        const int which = e >> 16, q4 = e & 65535; const float* P = which ? PV : PK; const int nch = which ? NCH_V : NCH_K;
        f32x4 a = (f32x4){0.f, 0.f, 0.f, 0.f};
        for (int s = 0; s < nch; ++s) a += *(const f32x4*)(P + (size_t)s * 262144 + q4 * 4);
        v2u w; w.x = pk2(a.x / (1.f + __expf(-a.x)), a.y / (1.f + __expf(-a.y))); w.y = pk2(a.z / (1.f + __expf(-a.z)), a.w / (1.f + __expf(-a.w)));
        *(GAS v2u*)((which ? HV : HK) + q4 * 4) = w;
    }
}

__device__ __forceinline__ void final_norm(const Ctx& F, float* out, const float* nw) {
    const int gw = F.vcu * NWAVES + F.wave, NGW = F.G * NWAVES;
    for (int m = gw; m < S_; m += NGW) {
        GAS f32x4* xr = (GAS f32x4*)(out + (size_t)m * D_) + F.lane;
        f32x4 v[8]; float s = 0.f;
#pragma unroll
        for (int j = 0; j < 8; ++j) { v[j] = xr[64 * j]; s += (v[j].x * v[j].x + v[j].y * v[j].y) + (v[j].z * v[j].z + v[j].w * v[j].w); }
        const float rstd = 1.f / sqrtf(wave_sum(s) * (1.f / D_) + 1e-6f);
#pragma unroll
        for (int j = 0; j < 8; ++j) { const f32x4 g = *(const f32x4*)(nw + 4 * (F.lane + 64 * j)); xr[64 * j] = v[j] * rstd * g; }
    }
}

namespace att {
typedef short bf16x8 __attribute__((ext_vector_type(8)));
typedef short s16x4 __attribute__((ext_vector_type(4)));
typedef short v4i16_t __attribute__((ext_vector_type(4)));
typedef float f32x16 __attribute__((ext_vector_type(16)));
typedef LAS const char* lds_cptr;
typedef unsigned u32x4 __attribute__((ext_vector_type(4)));
constexpr int KSLOT = 24576, VSLOT = 16384;
constexpr int L_K = 0, L_V = 2 * KSLOT, L_WSF = L_V + 2 * VSLOT, L_BT = L_WSF + 2048, L_IMP = L_BT + 2048, L_SEL = L_IMP + 32768, L_LIST = L_SEL + 1024, L_MISC = L_LIST + 512, L_END = L_MISC + 256;
static_assert(L_END <= RING_BYTES, "attention LDS map");
constexpr float LOG2E = 1.4426950408889634f;
constexpr float C2 = 0.07216878364870322f * LOG2E;
constexpr float THR = 8.0f;
#ifndef ATT_RESCALE
#define ATT_RESCALE 0
#endif
__device__ __forceinline__ int lane_id() { int l; asm volatile("v_mbcnt_lo_u32_b32 %0, -1, 0\n\tv_mbcnt_hi_u32_b32 %0, -1, %0" : "=v"(l)); return l; }
__device__ __forceinline__ int crow(int r, int hi) { return (r & 3) + 8 * (r >> 2) + 4 * hi; }
__device__ __forceinline__ void glds16(const void* gsrc, unsigned lds_dst) { unsigned keep;
    asm volatile("s_mov_b32 %0, m0\n\ts_mov_b32 m0, %2\n\ts_nop 0\n\tglobal_load_lds_dwordx4 %1, off\n\ts_mov_b32 m0, %0" : "=&s"(keep) : "v"(gsrc), "s"(lds_dst) : "memory"); }
#define ATT_WAIT_BAR() asm volatile("s_waitcnt vmcnt(0) lgkmcnt(0)\n\ts_barrier" ::: "memory")
__device__ __forceinline__ unsigned cvtpk(float lo, float hi) { typedef float f2 __attribute__((ext_vector_type(2))); typedef __bf16 b2 __attribute__((ext_vector_type(2))); f2 v = {lo, hi}; b2 b = __builtin_convertvector(v, b2); return __builtin_bit_cast(unsigned, b); }
__device__ __forceinline__ s16x4 vtr(lds_cptr p) { return __builtin_bit_cast(s16x4, __builtin_amdgcn_ds_read_tr16_b64_v4i16((LAS v4i16_t*)p)); }
__device__ __forceinline__ float xhalf_max(float m) { auto rr = __builtin_amdgcn_permlane32_swap(__float_as_uint(m), __float_as_uint(m), false, false); return fmaxf(__uint_as_float(rr[0]), __uint_as_float(rr[1])); }
__device__ __forceinline__ float xhalf_sum(float m) { auto rr = __builtin_amdgcn_permlane32_swap(__float_as_uint(m), __float_as_uint(m), false, false); return __uint_as_float(rr[0]) + __uint_as_float(rr[1]); }

template <int NKS>
__device__ __forceinline__ void qk_tile(f32x16& p0, f32x16& p1, lds_cptr kslot, const bf16x8* qf, int r32, int hi) {
    const lds_cptr kb = kslot + hi * 1024 + r32 * 16;
    p0 = f32x16{}; p1 = f32x16{};
    bf16x8 fa[3], fb[3];
#define QK_LD(ks) do { fa[(ks) % 3] = *(const LAS bf16x8*)(kb + (ks) * 2048); fb[(ks) % 3] = *(const LAS bf16x8*)(kb + (ks) * 2048 + 512); } while (0)
    QK_LD(0); QK_LD(1);
#pragma unroll
    for (int ks = 0; ks < NKS; ++ks) {
        if (ks + 2 < NKS) QK_LD(ks + 2);
        p0 = __builtin_amdgcn_mfma_f32_32x32x16_bf16(fa[ks % 3], qf[ks], p0, 0, 0, 0);
        p1 = __builtin_amdgcn_mfma_f32_32x32x16_bf16(fb[ks % 3], qf[ks], p1, 0, 0, 0);
        __builtin_amdgcn_sched_barrier(0);
    }
#undef QK_LD
}
struct Soft { float mhat, l; };
template <bool SCALED>
__device__ __forceinline__ void softmax_tile(f32x16& p0, f32x16& p1, Soft& st, f32x16 (&o)[4], bool first, LAS float* wsf, int r32, int hi, float cb = 0.f) {
    float a = fmaxf(p0[0], p1[0]), b = fmaxf(p0[1], p1[1]);
#pragma unroll
    for (int r = 2; r < 16; r += 2) { a = fmaxf(a, fmaxf(p0[r], p1[r])); b = fmaxf(b, fmaxf(p0[r + 1], p1[r + 1])); }
    float rm = xhalf_max(fmaxf(a, b));
    if (!SCALED) rm = fmaf(rm, C2, cb);
    if (first) { st.mhat = rm > -1e30f ? rm : 0.f; }
#if ATT_RESCALE
    else if (__any(rm > st.mhat + THR)) {
        const float nm = fmaxf(st.mhat, rm); const float f = __builtin_amdgcn_exp2f(st.mhat - nm); st.l *= f; st.mhat = nm;
        if (hi == 0) wsf[r32] = f;
        LDS_WAIT();
        LAS float* wb = wsf + 4 * hi; asm volatile("" : "+v"(wb));
#pragma unroll
        for (int r = 0; r < 16; ++r) { const float fr = wb[(r & 3) + 8 * (r >> 2)];
#pragma unroll
            for (int d = 0; d < 4; ++d) o[d][r] *= fr;
            asm volatile("" ::: "memory"); }
    }
#endif
    float s = 0.f; const float nb = SCALED ? -st.mhat : cb - st.mhat;
#pragma unroll
    for (int r = 0; r < 16; ++r) {
        if (SCALED) { p0[r] = __builtin_amdgcn_exp2f(p0[r] + nb); p1[r] = __builtin_amdgcn_exp2f(p1[r] + nb); }
        else { p0[r] = __builtin_amdgcn_exp2f(fmaf(p0[r], C2, nb)); p1[r] = __builtin_amdgcn_exp2f(fmaf(p1[r], C2, nb)); }
        s += p0[r] + p1[r]; }
    st.l += s;
}
__device__ __forceinline__ void wait_bar_n(int n) {
    if (n == 3) asm volatile("s_waitcnt vmcnt(3) lgkmcnt(0)\n\ts_barrier" ::: "memory");
    else if (n == 2) asm volatile("s_waitcnt vmcnt(2) lgkmcnt(0)\n\ts_barrier" ::: "memory");
    else asm volatile("s_waitcnt vmcnt(0) lgkmcnt(0)\n\ts_barrier" ::: "memory");
}
template <bool G1, int NKP, int NVP, class SK, class SV, class FA, class FB>
__device__ __forceinline__ void tile_stream_g(int nt, SK stageK, SV stageV, FA fa, FB fb) {
    stageK(0, 0); stageV(0, 0);
    if (nt > 1) { stageK(1, 1); stageV(1, 1); }
    int pend = 0;
    if (G1) { wait_bar_n(0); }
    for (int t = 0; t < nt; ++t) {
        f32x16 p0, p1;
        wait_bar_n(pend); pend = 0;
        if (G1) { if (t >= 1 && t + 1 < nt) { stageV(t + 1, (t + 1) & 1); pend = NVP; } } else { if (t >= 1 && t + 1 < nt) { stageK(t + 1, (t + 1) & 1); pend = NKP; } }
        fa(t, t & 1, p0, p1);
        wait_bar_n(pend); pend = 0;
        if (G1) { if (t + 2 < nt) { stageK(t + 2, t & 1); pend = NKP; } } else { if (t >= 1 && t + 1 < nt) { stageV(t + 1, (t + 1) & 1); pend = NVP; } }
        fb(t, t & 1, p0, p1);
    }
    if (!G1) { wait_bar_n(pend); }
}
template <int NKP, int NVP, class SK, class SV, class FA, class FB>
__device__ __forceinline__ void tile_stream(int nt, bool g1, SK stageK, SV stageV, FA fa, FB fb) {
    if (g1) tile_stream_g<true, NKP, NVP>(nt, stageK, stageV, fa, fb); else tile_stream_g<false, NKP, NVP>(nt, stageK, stageV, fa, fb);
}
__device__ __forceinline__ void pv_tile(f32x16 (&o)[4], const f32x16& p0, const f32x16& p1, lds_cptr vslot, int lane, int hi) {
    const lds_cptr vp = vslot + ((lane >> 4) & 1) * 32 + (lane & 3) * 8 + (4 * hi + ((lane & 15) >> 2)) * 64;
    u32x4 pw[4];
    pw[0] = (u32x4){cvtpk(p0[0], p0[1]), cvtpk(p0[2], p0[3]), cvtpk(p0[4], p0[5]), cvtpk(p0[6], p0[7])};
    pw[1] = (u32x4){cvtpk(p0[8], p0[9]), cvtpk(p0[10], p0[11]), cvtpk(p0[12], p0[13]), cvtpk(p0[14], p0[15])};
    pw[2] = (u32x4){cvtpk(p1[0], p1[1]), cvtpk(p1[2], p1[3]), cvtpk(p1[4], p1[5]), cvtpk(p1[6], p1[7])};
    pw[3] = (u32x4){cvtpk(p1[8], p1[9]), cvtpk(p1[10], p1[11]), cvtpk(p1[12], p1[13]), cvtpk(p1[14], p1[15])};
    s16x4 vlo[5], vhi[5];
#define PV_LD(st_) do { vlo[(st_) % 5] = vtr(vp + ((st_) >> 2) * 4096 + ((st_) & 3) * 1024); vhi[(st_) % 5] = vtr(vp + ((st_) >> 2) * 4096 + ((st_) & 3) * 1024 + 512); } while (0)
    PV_LD(0); PV_LD(1); PV_LD(2); PV_LD(3);
#pragma unroll
    for (int st_ = 0; st_ < 16; ++st_) {
        if (st_ + 4 < 16) PV_LD(st_ + 4);
        const s16x4 lo = vlo[st_ % 5], hh = vhi[st_ % 5];
        const bf16x8 vf = (bf16x8){lo[0], lo[1], lo[2], lo[3], hh[0], hh[1], hh[2], hh[3]};
        o[st_ >> 2] = __builtin_amdgcn_mfma_f32_32x32x16_bf16(__builtin_bit_cast(bf16x8, pw[st_ & 3]), vf, o[st_ >> 2], 0, 0, 0);
        __builtin_amdgcn_sched_barrier(0);
    }
#undef PV_LD
}
__device__ __forceinline__ void mla_stage_k(int tl, int h, const bf16* KV, const bf16* KR, unsigned kdst, int wid) {
    const int lane = lane_id();
    const size_t row = (size_t)(64 * tl + lane);
    glds16(KV + row * 2048 + h * 256 + wid * 8, (unsigned)__builtin_amdgcn_readfirstlane(kdst + wid * 1024));
    glds16(KV + row * 2048 + h * 256 + (wid + 8) * 8, (unsigned)__builtin_amdgcn_readfirstlane(kdst + (wid + 8) * 1024));
    glds16(KR + row * 64 + wid * 8, (unsigned)__builtin_amdgcn_readfirstlane(kdst + (wid + 16) * 1024));
}
__device__ __forceinline__ void mla_stage_v(int tl, int h, const bf16* KV, unsigned vdst, int wid) {
    const int lane = lane_id();
#pragma unroll
    for (int i = 0; i < 2; ++i) { const int p = wid + 8 * i, d0 = p >> 2, ks = p & 3;
        glds16(KV + (size_t)(64 * tl + 16 * ks + (lane >> 2)) * 2048 + h * 256 + 128 + d0 * 32 + (lane & 3) * 8, (unsigned)__builtin_amdgcn_readfirstlane(vdst + p * 1024)); }
}
template <int probe>
__device__ __forceinline__ void mla_unit(int h, int qb, const bf16* Q, const bf16* KV, const bf16* KR, bf16* MIX, LAS unsigned char* shm, int wid) {
    const int lane = lane_id(); const int r32 = lane & 31, hi = lane >> 5;
    const unsigned lds0 = (unsigned)(uintptr_t)shm;
    const lds_cptr shc = (lds_cptr)shm; LAS float* wsf = (LAS float*)(shm + L_WSF) + wid * 64;
    const int q0w = qb * 256 + wid * 32;
    bf16x8 qf[12];
    { const bf16* qp = Q + (size_t)(q0w + r32) * 1536 + h * 192 + hi * 8;
#pragma unroll
      for (int ks = 0; ks < 12; ++ks) qf[ks] = *(const bf16x8*)(qp + ks * 16); }
    const int NT = 4 * qb + 4, myNT = (q0w + 31) / 64 + 1;
    Soft st; st.mhat = 0.f; st.l = 0.f; f32x16 o[4]; o[0] = f32x16{}; o[1] = f32x16{}; o[2] = f32x16{}; o[3] = f32x16{};
    tile_stream<3, 2>(NT, wid >= 4,
        [&](int t, int sl) { if (probe & 1) return; mla_stage_k(t, h, KV, KR, lds0 + L_K + sl * KSLOT, wid); },
        [&](int t, int sl) { if (probe & 1) return; mla_stage_v(t, h, KV, lds0 + L_V + sl * VSLOT, wid); },
        [&](int t, int sl, f32x16& p0, f32x16& p1) {
            if (t >= myNT || (probe & 2)) return;
            qk_tile<12>(p0, p1, shc + L_K + sl * KSLOT, qf, r32, hi);
            if (64 * t + 63 > q0w) { const int q = q0w + r32, kb = 64 * t + 4 * hi;
#pragma unroll
                for (int r = 0; r < 16; ++r) { const int kv = kb + (r & 3) + 8 * (r >> 2); p0[r] = kv > q ? -INFINITY : p0[r]; p1[r] = kv + 32 > q ? -INFINITY : p1[r]; } }
        },
        [&](int t, int sl, f32x16& p0, f32x16& p1) {
            if (t >= myNT || (probe & 2)) return;
            softmax_tile<false>(p0, p1, st, o, t == 0, wsf, r32, hi);
            pv_tile(o, p0, p1, shc + L_V + sl * VSLOT, lane, hi);
        });
    const float lt = xhalf_sum(st.l);
    if (hi == 0) wsf[32 + r32] = lt;
    LDS_WAIT();
    const int le = lane_id(); const int r32e = le & 31, hie = le >> 5;
    bf16* op = MIX + (size_t)q0w * 2048 + h * 128 + r32e;
#pragma unroll
    for (int r = 0; r < 16; ++r) { const float rl = __builtin_amdgcn_rcpf(wsf[32 + crow(r, hie)]); bf16* orow = op + (size_t)crow(r, hie) * 2048;
#pragma unroll
        for (int d0 = 0; d0 < 4; ++d0) orow[d0 * 32] = (bf16)f2bf(o[d0][r] * rl); }
    ATT_WAIT_BAR();
}
}

namespace att {
__device__ __forceinline__ float dpp_xor1(float v) { return __builtin_bit_cast(float, __builtin_amdgcn_update_dpp(0, __builtin_bit_cast(int, v), 0xB1, 0xF, 0xF, true)); }
__device__ __forceinline__ float dpp_xor2(float v) { return __builtin_bit_cast(float, __builtin_amdgcn_update_dpp(0, __builtin_bit_cast(int, v), 0x4E, 0xF, 0xF, true)); }
__device__ __forceinline__ int t5b(int d) {
    if (d < 16) return d;
    int b = 16;
    b += d >= 19; b += d >= 21; b += d >= 24; b += d >= 27; b += d >= 31; b += d >= 35; b += d >= 40; b += d >= 46; b += d >= 52; b += d >= 59; b += d >= 67; b += d >= 77; b += d >= 87; b += d >= 99; b += d >= 113;
    return b;
}
__device__ __forceinline__ void stage_kv(const bf16* krow0, size_t kpitch, const bf16* vrow0, size_t vpitch, unsigned kdst, unsigned vdst, bool withV, int wid, int lane) {
    lane = lane_id();
    const bf16* kp = krow0 + (size_t)lane * kpitch + wid * 8;
    glds16(kp, (unsigned)__builtin_amdgcn_readfirstlane(kdst + wid * 1024));
    glds16(kp + 64, (unsigned)__builtin_amdgcn_readfirstlane(kdst + (wid + 8) * 1024));
    glds16(kp + 128, (unsigned)__builtin_amdgcn_readfirstlane(kdst + (wid + 16) * 1024));
    if (withV) {
#pragma unroll
        for (int i = 0; i < 2; ++i) { const int p = wid + 8 * i, d0 = p >> 2, ks = p & 3;
            glds16(vrow0 + (size_t)(16 * ks + (lane >> 2)) * vpitch + d0 * 32 + (lane & 3) * 8, (unsigned)__builtin_amdgcn_readfirstlane(vdst + p * 1024)); }
    }
}
__device__ __forceinline__ void stage_k(const bf16* krow0, size_t kpitch, unsigned kdst, int wid) {
    const int lane = lane_id();
    const bf16* kp = krow0 + (size_t)lane * kpitch + wid * 8;
    glds16(kp, (unsigned)__builtin_amdgcn_readfirstlane(kdst + wid * 1024));
    glds16(kp + 64, (unsigned)__builtin_amdgcn_readfirstlane(kdst + (wid + 8) * 1024));
    glds16(kp + 128, (unsigned)__builtin_amdgcn_readfirstlane(kdst + (wid + 16) * 1024));
}
__device__ __forceinline__ void stage_v(const bf16* vrow0, size_t vpitch, unsigned vdst, int wid) {
    const int lane = lane_id();
#pragma unroll
    for (int i = 0; i < 2; ++i) { const int p = wid + 8 * i, d0 = p >> 2, ks = p & 3;
        glds16(vrow0 + (size_t)(16 * ks + (lane >> 2)) * vpitch + d0 * 32 + (lane & 3) * 8, (unsigned)__builtin_amdgcn_readfirstlane(vdst + p * 1024)); }
}
struct TileP { int pbase, pstride, dmax; bool lookup, mask; };
__device__ __forceinline__ void logits(f32x16& p0, f32x16& p1, int tq, bool rowsel, const TileP tp, float cbias, const LAS float* bt, int hi) {
    if (tp.lookup || tp.mask) {
        const int dq = tq - tp.pbase - tp.pstride * 4 * hi;
#pragma unroll
        for (int r = 0; r < 16; ++r) {
            const int d0 = dq - tp.pstride * ((r & 3) + 8 * (r >> 2)), d1 = d0 - 32 * tp.pstride;
            const bool v0 = rowsel && d0 >= 0 && d0 <= tp.dmax, v1 = rowsel && d1 >= 0 && d1 <= tp.dmax;
            float b0 = cbias, b1 = cbias;
            if (tp.lookup) { b0 = bt[min(max(d0, 0), 127)]; b1 = bt[min(max(d1, 0), 127)]; }
            p0[r] = v0 ? fmaf(p0[r], C2, b0) : -INFINITY; p1[r] = v1 ? fmaf(p1[r], C2, b1) : -INFINITY;
            if ((r & 3) == 3) __builtin_amdgcn_sched_barrier(0);
        }
    } else {
#pragma unroll
        for (int r = 0; r < 16; ++r) { p0[r] = rowsel ? fmaf(p0[r], C2, cbias) : -INFINITY; p1[r] = rowsel ? fmaf(p1[r], C2, cbias) : -INFINITY; }
    }
}
__device__ __forceinline__ float rowmax32(const f32x16& p0, const f32x16& p1) {
    float a = fmaxf(p0[0], p1[0]), b = fmaxf(p0[1], p1[1]);
#pragma unroll
    for (int r = 2; r < 16; r += 2) { a = fmaxf(a, fmaxf(p0[r], p1[r])); b = fmaxf(b, fmaxf(p0[r + 1], p1[r + 1])); }
    return xhalf_max(fmaxf(a, b));
}
__device__ __forceinline__ void nsa_out(const f32x16 (&o)[4], const LAS float* wsf, int mode, float* MIXF, bf16* MIX, int trow0, int g, int lane) {
    const int le = lane_id(); const int r32e = le & 31, hie = le >> 5;
#pragma unroll
    for (int r = 0; r < 16; ++r) {
        const int q = crow(r, hie); const float sc = wsf[q];
        const size_t off = (size_t)(trow0 + (q >> 2)) * 1024 + (size_t)((4 * g + (q & 3)) * 128 + r32e);
#pragma unroll
        for (int d0 = 0; d0 < 4; ++d0) {
            const float v = o[d0][r] * sc;
            if (mode == 0) MIXF[off + d0 * 32] = v;
            else if (mode == 1) MIXF[off + d0 * 32] = __hip_atomic_load(MIXF + off + d0 * 32, __ATOMIC_RELAXED, __HIP_MEMORY_SCOPE_AGENT) + v;
            else MIX[(size_t)(trow0 + (q >> 2)) * 2048 + 1024 + (4 * g + (q & 3)) * 128 + r32e + d0 * 32] = (bf16)f2bf(__hip_atomic_load(MIXF + off + d0 * 32, __ATOMIC_RELAXED, __HIP_MEMORY_SCOPE_AGENT) + v);
        }
    }
}

template <int probe>
__device__ __forceinline__ void nsa_unit(int i, int g, const bf16* U, const bf16* KC, const bf16* VC, const float* rel_bias, float* MIXF, bf16* MIX, LAS unsigned char* shm, int wid) {
    const unsigned lds0 = (unsigned)(uintptr_t)shm; const lds_cptr shc = (lds_cptr)shm;
    LAS float* wsf = (LAS float*)(shm + L_WSF) + wid * 64; LAS float* btab = (LAS float*)(shm + L_BT); LAS float* imp = (LAS float*)(shm + L_IMP);
    LAS unsigned* selw = (LAS unsigned*)(shm + L_SEL); LAS unsigned* uni = (LAS unsigned*)(shm + L_MISC); LAS unsigned char* blist = (LAS unsigned char*)(shm + L_LIST);
    const int t0 = 64 * i, trow0 = t0 + 8 * wid; const bool g1 = wid >= 4;
    auto nsa_gate = [&](int b) -> float { const int r_ = lane_id() & 31, tq_ = trow0 + (r_ >> 2), hd_ = 4 * g + (r_ & 3);
        return 1.f / (1.f + __expf(-bf1(U[(size_t)tq_ * DINP + O_GN + hd_ * 3 + b]))); };
#define NSA_DERIVE() const int lane = lane_id(); const int r32 = lane & 31, hi = lane >> 5; const int tq = trow0 + (r32 >> 2), hd = r32 & 3, head = 4 * g + hd; \
    const float c31 = rel_bias[31 * 8 + head] * LOG2E; const LAS float* bt = btab + hd * 128; (void)tq; (void)c31; (void)bt; (void)hi
    bf16x8 qf[12];
    f32x16 o[4];
    { const int tid = wid * 64 + lane_id();
      for (int k = tid; k < 8192; k += NTHR) imp[k] = 0.f;
      { const int hh = tid >> 7, d = tid & 127; btab[tid] = rel_bias[t5b(d) * 8 + 4 * g + hh] * LOG2E; }
      if (tid < 4) uni[tid] = 0u; }
    { NSA_DERIVE();
      const bf16* qp = U + (size_t)tq * DINP + O_QN + head * 192 + hi * 8;
#pragma unroll
      for (int ks = 0; ks < 12; ++ks) qf[ks] = *(const bf16x8*)(qp + ks * 16); }
    const int nct = (4 * i + 3 + 63) >> 6;
    const bf16* kc0 = KC + g * 256; const bf16* vc0 = VC + g * 256;
    float m = 0.f, inv_lc = 0.f;
    ATT_WAIT_BAR();
    { NSA_DERIVE();
      float l = 0.f;
      tile_stream<3, 0>(nct, g1,
        [&](int ct, int sl) { if (probe & 1) return; stage_k(kc0 + (size_t)(64 * ct) * 512, 512, lds0 + L_K + sl * KSLOT, wid); },
        [&](int ct, int sl) {},
        [&](int ct, int sl, f32x16& p0, f32x16& p1) {
            if (probe & 2) return;
            qk_tile<12>(p0, p1, shc + L_K + sl * KSLOT, qf, r32, hi);
            const TileP tp{16 * 64 * ct + 31, 16, 1 << 30, ct >= nct - 2, true};
            logits(p0, p1, tq, true, tp, c31, bt, hi); },
        [&](int ct, int sl, f32x16& p0, f32x16& p1) {
            if (probe & 2) return;
            const float rm = rowmax32(p0, p1);
            if (ct == 0) m = rm > -1e30f ? rm : 0.f;
            else { const float nm = fmaxf(m, rm); l *= __builtin_amdgcn_exp2f(m - nm); m = nm; }
            float s = 0.f;
#pragma unroll
            for (int r = 0; r < 16; ++r) s += __builtin_amdgcn_exp2f(p0[r] - m) + __builtin_amdgcn_exp2f(p1[r] - m);
            l += s; });
      const float lc = xhalf_sum(l); inv_lc = lc > 0.f ? 1.f / lc : 0.f; }
    { NSA_DERIVE();
      o[0] = f32x16{}; o[1] = f32x16{}; o[2] = f32x16{}; o[3] = f32x16{};
      tile_stream<3, 2>(nct, g1,
        [&](int ct, int sl) { if (probe & 1) return; stage_k(kc0 + (size_t)(64 * ct) * 512, 512, lds0 + L_K + sl * KSLOT, wid); },
        [&](int ct, int sl) { if (probe & 1) return; stage_v(vc0 + (size_t)(64 * ct) * 512, 512, lds0 + L_V + sl * VSLOT, wid); },
        [&](int ct, int sl, f32x16& p0, f32x16& p1) {
            if (probe & 2) return;
            qk_tile<12>(p0, p1, shc + L_K + sl * KSLOT, qf, r32, hi);
            const TileP tp{16 * 64 * ct + 31, 16, 1 << 30, ct >= nct - 2, true};
            logits(p0, p1, tq, true, tp, c31, bt, hi); },
        [&](int ct, int sl, f32x16& p0, f32x16& p1) {
            if (probe & 2) return;
#pragma unroll
            for (int r = 0; r < 16; ++r) { p0[r] = __builtin_amdgcn_exp2f(p0[r] - m) * inv_lc; p1[r] = __builtin_amdgcn_exp2f(p1[r] - m) * inv_lc; }
            LAS float* iq = imp + (8 * wid + (r32 >> 2)) * 128 + 16 * ct + hi;
#pragma unroll
            for (int a = 0; a < 4; ++a) {
#pragma unroll
                for (int kh = 0; kh < 2; ++kh) {
                    const f32x16& pp = kh ? p1 : p0;
                    float s3 = pp[4 * a + 3], s4 = (pp[4 * a] + pp[4 * a + 1]) + (pp[4 * a + 2] + s3);
                    s4 += dpp_xor1(s4); s4 += dpp_xor2(s4); s3 += dpp_xor1(s3); s3 += dpp_xor2(s3);
                    const int jj = 8 * kh + 2 * a;
                    if (hd == 0) { __hip_atomic_fetch_add(iq + jj, s4, __ATOMIC_RELAXED, __HIP_MEMORY_SCOPE_WORKGROUP);
                        if (16 * ct + hi + jj + 1 < 128) __hip_atomic_fetch_add(iq + jj + 1, s3, __ATOMIC_RELAXED, __HIP_MEMORY_SCOPE_WORKGROUP); }
                }
            }
            pv_tile(o, p0, p1, shc + L_V + sl * VSLOT, lane, hi); });
      if (hi == 0) wsf[r32] = nsa_gate(0);
      LDS_WAIT();
      nsa_out(o, wsf, 0, MIXF, MIX, trow0, g, lane); }
    unsigned long long wm_lo = 0ull, wm_hi = 0ull;
    {
        const int lane = lane_id();
        const unsigned long long all_lo = (i >= 63) ? ~0ull : ((1ull << (i + 1)) - 1ull), all_hi = (i >= 64) ? ((i >= 127) ? ~0ull : ((1ull << (i - 63)) - 1ull)) : 0ull;
        for (int ql = 0; ql < 8; ++ql) {
            unsigned long long s_lo = all_lo, s_hi = all_hi;
            if (i >= 16) {
                const LAS float* iq = imp + (8 * wid + ql) * 128;
                const int j0 = lane, j1 = lane + 64;
                const unsigned b0 = (j0 >= 1 && j0 <= i - 2) ? __float_as_uint(iq[j0]) + 1u : 0u;
                const unsigned b1 = (j1 <= i - 2) ? __float_as_uint(iq[j1]) + 1u : 0u;
                unsigned T = 0u;
                for (int bit = 30; bit >= 0; --bit) {
                    const unsigned c = T | (1u << bit);
                    const int cnt = __popcll(__ballot(b0 >= c)) + __popcll(__ballot(b1 >= c));
                    if (cnt >= 13) T = c;
                }
                const unsigned long long gt0 = __ballot(b0 > T), gt1 = __ballot(b1 > T), eq0 = __ballot(b0 == T), eq1 = __ballot(b1 == T);
                int rem = 13 - (__popcll(gt0) + __popcll(gt1));
                unsigned long long e0 = eq0, e1 = eq1, k0 = 0ull, k1 = 0ull;
                while (rem > 0 && e0) { const unsigned long long low = e0 & (~e0 + 1ull); k0 |= low; e0 ^= low; --rem; }
                while (rem > 0 && e1) { const unsigned long long low = e1 & (~e1 + 1ull); k1 |= low; e1 ^= low; --rem; }
                s_lo = gt0 | k0 | 1ull; s_hi = gt1 | k1;
                if (i < 64) s_lo |= (1ull << i) | (1ull << (i - 1));
                else { s_hi |= (1ull << (i - 64)); if (i == 64) s_lo |= (1ull << 63); else s_hi |= (1ull << (i - 65)); }
            }
            if (lane == 0) { LAS unsigned* sp = selw + (8 * wid + ql) * 4; sp[0] = (unsigned)s_lo; sp[1] = (unsigned)(s_lo >> 32); sp[2] = (unsigned)s_hi; sp[3] = (unsigned)(s_hi >> 32); }
            wm_lo |= s_lo; wm_hi |= s_hi;
        }
        if (lane == 0) { __hip_atomic_fetch_or(uni + 0, (unsigned)wm_lo, __ATOMIC_RELAXED, __HIP_MEMORY_SCOPE_WORKGROUP); __hip_atomic_fetch_or(uni + 1, (unsigned)(wm_lo >> 32), __ATOMIC_RELAXED, __HIP_MEMORY_SCOPE_WORKGROUP);
                         __hip_atomic_fetch_or(uni + 2, (unsigned)wm_hi, __ATOMIC_RELAXED, __HIP_MEMORY_SCOPE_WORKGROUP); __hip_atomic_fetch_or(uni + 3, (unsigned)(wm_hi >> 32), __ATOMIC_RELAXED, __HIP_MEMORY_SCOPE_WORKGROUP); }
    }
    ATT_WAIT_BAR();
    if (wid == 0 && lane_id() == 0) {
        int n = 0;
        for (int w4 = 0; w4 < 4; ++w4) { unsigned mk = uni[w4]; while (mk) { const int b = __builtin_ctz(mk); mk &= mk - 1u; blist[n++] = (unsigned char)(32 * w4 + b); } }
        uni[4] = (unsigned)n;
    }
    ATT_WAIT_BAR();
    {
        NSA_DERIVE();
        const int nsl = __builtin_amdgcn_readfirstlane((int)uni[4]);
        const LAS unsigned* sp = selw + (8 * wid + (r32 >> 2)) * 4;
        const bf16* ks0 = U + O_KN + 384 + g * 192; const bf16* vs0 = U + O_VN + 256 + g * 128;
        Soft st; st.mhat = 0.f; st.l = 0.f;
        o[0] = f32x16{}; o[1] = f32x16{}; o[2] = f32x16{}; o[3] = f32x16{};
        auto blk = [&](int t) -> int { return __builtin_amdgcn_readfirstlane((int)blist[t]); };
        auto wsel = [&](int j) -> bool { return j < 64 ? ((wm_lo >> j) & 1ull) : ((wm_hi >> (j - 64)) & 1ull); };
        tile_stream<3, 2>(nsl, g1,
            [&](int t, int sl) { if (probe & 1) return; const int j = blk(t); stage_k(ks0 + (size_t)(64 * j) * DINP, DINP, lds0 + L_K + sl * KSLOT, wid); },
            [&](int t, int sl) { if (probe & 1) return; const int j = blk(t); stage_v(vs0 + (size_t)(64 * j) * DINP, DINP, lds0 + L_V + sl * VSLOT, wid); },
            [&](int t, int sl, f32x16& p0, f32x16& p1) {
            if (probe & 2) return;
                const int j = blk(t); if (!wsel(j)) return;
                qk_tile<12>(p0, p1, shc + L_K + sl * KSLOT, qf, r32, hi);
                const bool rowsel = (sp[j >> 5] >> (j & 31)) & 1u;
                if (j >= i - 2) { const TileP tp{64 * j, 1, 1 << 30, true, j == i}; logits(p0, p1, tq, rowsel, tp, c31, bt, hi); }
                else if (!__all(rowsel)) {
#pragma unroll
                    for (int r = 0; r < 16; ++r) { p0[r] = rowsel ? p0[r] : -INFINITY; p1[r] = rowsel ? p1[r] : -INFINITY; } } },
            [&](int t, int sl, f32x16& p0, f32x16& p1) {
            if (probe & 2) return;
                const int j = blk(t); if (!wsel(j)) return;
                if (j >= i - 2) softmax_tile<true>(p0, p1, st, o, t == 0, wsf, r32, hi);
                else softmax_tile<false>(p0, p1, st, o, t == 0, wsf, r32, hi, c31);
                pv_tile(o, p0, p1, shc + L_V + sl * VSLOT, lane, hi); });
        const float ls = xhalf_sum(st.l);
        if (hi == 0) wsf[r32] = ls > 0.f ? nsa_gate(1) / ls : 0.f;
        LDS_WAIT();
        nsa_out(o, wsf, 1, MIXF, MIX, trow0, g, lane);
    }
    {
        NSA_DERIVE();
        const bf16* kw0 = U + O_KN + 768 + g * 192; const bf16* vw0 = U + O_VN + 512 + g * 128;
        Soft st; st.mhat = 0.f; st.l = 0.f;
        o[0] = f32x16{}; o[1] = f32x16{}; o[2] = f32x16{}; o[3] = f32x16{};
        const int nw = (i >= 8 ? 8 : i) + 1;
        tile_stream<3, 2>(nw, g1,
            [&](int t, int sl) { if (probe & 1) return; stage_k(kw0 + (size_t)(64 * (i - t)) * DINP, DINP, lds0 + L_K + sl * KSLOT, wid); },
            [&](int t, int sl) { if (probe & 1) return; stage_v(vw0 + (size_t)(64 * (i - t)) * DINP, DINP, lds0 + L_V + sl * VSLOT, wid); },
            [&](int t, int sl, f32x16& p0, f32x16& p1) {
            if (probe & 2) return;
                qk_tile<12>(p0, p1, shc + L_K + sl * KSLOT, qf, r32, hi);
                if (t <= 2 || t == 8) { const TileP tp{64 * (i - t), 1, 511, t <= 2, t == 0 || t == 8}; logits(p0, p1, tq, true, tp, c31, bt, hi); } },
            [&](int t, int sl, f32x16& p0, f32x16& p1) {
            if (probe & 2) return;
                if (t <= 2 || t == 8) softmax_tile<true>(p0, p1, st, o, t == 0, wsf, r32, hi);
                else softmax_tile<false>(p0, p1, st, o, false, wsf, r32, hi, c31);
                pv_tile(o, p0, p1, shc + L_V + sl * VSLOT, lane, hi); });
        const float lw = xhalf_sum(st.l);
        if (hi == 0) wsf[r32] = lw > 0.f ? nsa_gate(2) / lw : 0.f;
        LDS_WAIT();
        nsa_out(o, wsf, 2, MIXF, MIX, trow0, g, lane);
    }
    ATT_WAIT_BAR();
#undef NSA_DERIVE
}
}

__device__ __forceinline__ int att_lane_id() { int l; asm volatile("v_mbcnt_lo_u32_b32 %0, -1, 0\n\tv_mbcnt_hi_u32_b32 %0, -1, %0" : "=v"(l)); return l; }
struct Args { const float* in[27]; float* out; unsigned char* ws; int ph_lo, ph_hi, nbar, pad; };
constexpr int NPHASE = 16;
#ifndef PG8_SP2
#define PG8_SP2 true
#endif
#ifndef PG8_ALIGN
#define PG8_ALIGN true
#endif
#ifndef PROBE_MODE
#define PROBE_MODE 0
#endif
#ifndef REP0
#define REP0 1
#endif
#ifndef REP2
#define REP2 1
#endif
#ifndef REP3
#define REP3 1
#endif
#ifndef REP10
#define REP10 1
#endif
__global__ void __launch_bounds__(NTHR, 2) mega(Args args) {
    extern __shared__ __attribute__((aligned(16))) unsigned char lds[];
    Ctx F;
    F.lds = (LAS unsigned char*)lds;
    F.wave = __builtin_amdgcn_readfirstlane((int)threadIdx.x >> 6);
#define REFRESH_CTX() do { const int l_ = att_lane_id(); F.lane = l_; F.tid = F.wave * 64 + l_; } while (0)
    REFRESH_CTX();
    F.G = gridDim.x; { const int bx = blockIdx.x; F.vcu = (F.G % 8 == 0) ? (bx % 8) * (F.G / 8) + bx / 8 : bx; }
    unsigned char* ws = args.ws;
    volatile LAS unsigned* MISC = (volatile LAS unsigned*)(F.lds + MISC_OFF);
    for (int u = F.tid; u < (LDS_BYTES - LDSCTL_OFF) / 4; u += NTHR) ((LAS unsigned*)(F.lds + LDSCTL_OFF))[u] = 0u;
    __syncthreads();
    XcdBarrier bar; bar.w0 = 0; bar.bar = (unsigned*)(ws + WS_CTL) + 4096; bar.x = 0; bar.st = nullptr;
    const int lo = args.ph_lo, hi = args.ph_hi;
    if (hi - lo > 1) bar = xcd_barrier_post((unsigned*)(ws + WS_CTL) + 4096 + args.nbar * XCD_BAR_WORDS, MISC + 8, F.wave == 0 ? 1 : 0);
#define IN(k) (lo <= (k) && (k) < hi)
#define SEAM(k) do { if (IN(k) && IN((k) + 1)) xcd_barrier(bar); } while (0)
    const P0Args pa{args.in[5], args.in[6], args.in[7], args.in[9], args.in[11], args.in[13], args.in[15], args.in[16], args.in[18], args.in[19], args.in[21], args.in[23], args.in[24], args.in[25], args.in[1], args.in[2], ws};
    LAS float* gwt = (LAS float*)(F.lds); LAS float* sht = (LAS float*)(F.lds + 8192);
    const float* x = args.in[0];
    float* X1 = (float*)(ws + WS_X1);
    const float* MOD = (const float*)(ws + WS_MOD);
    bf16* H = (bf16*)(ws + WS_H); bf16* ACT = (bf16*)(ws + WS_ACT);

    for (int rep = 0; rep < REP0; ++rep) { if (rep) xcd_barrier(bar);
    if (IN(0)) { REFRESH_CTX();
        p0_prologue(F, pa);
        if (blockIdx.x == 0) {
            LAS int* cst = (LAS int*)(F.lds + 65536);
            __syncthreads();
            { const int me = F.tid; cst[me] = me < 256 ? 400 * ((me >> 3) + 1) : 65 * (((me - 256) >> 1) + 1) + 2200; }
            __syncthreads();
            { const int me = F.tid, cm = cst[me]; int rank = 0;
              for (int k2 = 0; k2 < 512; ++k2) { const int ck = cst[k2]; rank += (ck > cm || (ck == cm && k2 < me)) ? 1 : 0; }
              ((unsigned*)(ws + WS_CTL) + 8192)[rank] = (unsigned)me; }
        }
    }
    }
    SEAM(0);
    if (IN(1)) { REFRESH_CTX(); build_mod_tables(F, ws, args.in[4], args.in[3], 0, true, gwt, sht); norm_rows_bf16(F, x, H, gwt, sht); __syncthreads(); }
    SEAM(1);
    for (int rep = 0; rep < REP2; ++rep) { if (rep) xcd_barrier(bar);
    if (IN(2)) { REFRESH_CTX(); pg8::Gemm g{H, (const bf16*)(ws + WS_WGU1), S_, 2 * FF_, D_, D_, D_}; pg8::StaticOrder S; S.init(S_, 2 * FF_, F.G, (int)blockIdx.x);
        pg8::EpiSwiglu E{ACT, FF_}; pg8::gemm_phase<pg8::EpiSwiglu, pg8::StaticOrder, PG8_ALIGN, PG8_SP2>(F.lds, g, S, E, F.wave);
        if (rep == 0) { REFRESH_CTX(); conv_tail(F, pa, 1, NIT_B, (S_ / 256) * (2 * FF_ / 256)); } }
    }
    SEAM(2);
    for (int rep = 0; rep < REP3; ++rep) { if (rep) xcd_barrier(bar);
    if (IN(3)) { REFRESH_CTX(); pg8::Gemm g{ACT, (const bf16*)(ws + WS_WD1), S_, D_, FF_, FF_, FF_}; pg8::StaticOrder S; S.init(S_, D_, F.G, (int)blockIdx.x);
        pg8::EpiResid E{x, X1, D_, MOD + 2 * D_, 0.5f}; pg8::gemm_phase<pg8::EpiResid, pg8::StaticOrder, PG8_ALIGN, PG8_SP2>(F.lds, g, S, E, F.wave); }
    }
    SEAM(3);
    if (IN(4)) { REFRESH_CTX(); build_mod_tables(F, ws, args.in[8], args.in[3], 3, false, gwt, sht); norm_rows_bf16(F, X1, H, gwt, sht); __syncthreads(); }
    SEAM(4);
    if (IN(5)) { REFRESH_CTX(); pg8::Gemm g{H, (const bf16*)(ws + WS_WIN), S_, DINP, D_, D_, D_}; pg8::StaticOrder S; S.init(S_, DINP, F.G, (int)blockIdx.x);
        pg8::EpiStore E{ACT, DINP}; pg8::gemm_phase<pg8::EpiStore, pg8::StaticOrder, PG8_ALIGN, PG8_SP2>(F.lds, g, S, E, F.wave);
        REFRESH_CTX(); conv_tail(F, pa, 2, NIT_C, (S_ / 256) * (DINP / 256)); }
    SEAM(5);
    if (IN(6)) { REFRESH_CTX(); p6_prep(F, ws, args.in[10], args.in[12], args.in[14], args.in[17]); }
    SEAM(6);
    if (IN(7)) { REFRESH_CTX();
        const int c = (int)blockIdx.x, G = F.G;
        { pg8::Gemm g{(const bf16*)(ws + WS_CQN), (const bf16*)(ws + WS_WUQ), S_, 1536, 768, 768, 768}; pg8::StaticOrder S; S.init(S_, 1536, G, c);
          pg8::EpiStore E{(bf16*)(ws + WS_Q), 1536}; pg8::gemm_phase<pg8::EpiStore, pg8::StaticOrder, PG8_ALIGN, PG8_SP2>(F.lds, g, S, E, F.wave); }
        { pg8::Gemm g{(const bf16*)(ws + WS_CKVN), (const bf16*)(ws + WS_WUKV), S_, 2048, 512, 512, 512}; pg8::StaticOrder S; S.init(S_, 2048, G, c);
          pg8::EpiStore E{(bf16*)(ws + WS_KV), 2048}; pg8::gemm_phase<pg8::EpiStore, pg8::StaticOrder, PG8_ALIGN, PG8_SP2>(F.lds, g, S, E, F.wave); }
        { pg8::Gemm g{(const bf16*)(ws + WS_FLATK), (const bf16*)(ws + WS_WCK1), 1024, 256, KCH_K, 6144, 6144}; pg8::StaticOrder S; S.init_units(4, NCH_K, G, (c + G - 192 % G) % G);
          pg8::EpiPart E{(float*)(ws + WS_PARTK), 1024}; pg8::gemm_phase<pg8::EpiPart, pg8::StaticOrder, false, PG8_SP2, true>(F.lds, g, S, E, F.wave); }
        { pg8::Gemm g{(const bf16*)(ws + WS_FLATV), (const bf16*)(ws + WS_WCV1), 1024, 256, KCH_V, 4096, 4096}; pg8::StaticOrder S; S.init_units(4, NCH_V, G, (c + G - 240 % G) % G);
          pg8::EpiPart E{(float*)(ws + WS_PARTV), 1024}; pg8::gemm_phase<pg8::EpiPart, pg8::StaticOrder, false, PG8_SP2, true>(F.lds, g, S, E, F.wave); }
    }
    SEAM(7);
    if (IN(8)) { REFRESH_CTX(); p8_prep2(F, ws); }
    SEAM(8);
    if (IN(9)) { REFRESH_CTX();
        const int c = (int)blockIdx.x, G = F.G;
        { pg8::Gemm g{(const bf16*)(ws + WS_HIDK), (const bf16*)(ws + WS_WCK2), 1024, 256, 256, 256, 256}; pg8::StaticOrder S; S.init(1024, 256, G, c);
          pg8::EpiStore E{(bf16*)(ws + WS_KC), 256}; pg8::gemm_phase<pg8::EpiStore, pg8::StaticOrder, false, PG8_SP2>(F.lds, g, S, E, F.wave); }
        { pg8::Gemm g{(const bf16*)(ws + WS_HIDV), (const bf16*)(ws + WS_WCV2), 1024, 256, 256, 256, 256}; pg8::StaticOrder S; S.init(1024, 256, G, (c + G - 8 % G) % G);
          pg8::EpiStore E{(bf16*)(ws + WS_VC), 256}; pg8::gemm_phase<pg8::EpiStore, pg8::StaticOrder, false, PG8_SP2>(F.lds, g, S, E, F.wave); }
    }
    SEAM(9);
    for (int rep = 0; rep < REP10; ++rep) { if (rep) xcd_barrier(bar);
    if (IN(10)) { REFRESH_CTX();
        gu32* ctr = (gu32*)(ws + WS_CTL) + 2048 + 64 * rep; const unsigned* order = (const unsigned*)(ws + WS_CTL) + 8192;
        for (;;) {
            int moff = MISC_OFF + 64; asm volatile("" : "+s"(moff));
            volatile LAS unsigned* mq = (volatile LAS unsigned*)(F.lds + moff);
            if (att::lane_id() == 0 && F.wave == 0) mq[0] = __hip_atomic_fetch_add(ctr, 1u, RLX_AGENT);
            __syncthreads(); const int n = __builtin_amdgcn_readfirstlane((int)mq[0]); __syncthreads();
            if (n >= 512) {
                if (rep == 0) { gu32* cc = (gu32*)(ws + WS_CTL) + 3072; LAS float* scr = (LAS float*)(F.lds + F.wave * 16384);
                    for (;;) { int it = 0; if (att::lane_id() == 0) it = (int)__hip_atomic_fetch_add(cc, 1u, RLX_AGENT); it = __builtin_amdgcn_readfirstlane(it); if (it >= NIT_D) break; conv_item(3, it, pa, scr, att::lane_id()); } }
                break; }
            const int id = __builtin_amdgcn_readfirstlane((int)order[n]);
#ifdef PROBE_MLA_ONLY
            if (rep > 0 && id >= 256) continue;
#endif
#ifdef PROBE_NSA_ONLY
            if (rep > 0 && id < 256) continue;
#endif
            if (rep == 0 && PROBE_MODE != 0) {
                if (id < 256) att::mla_unit<PROBE_MODE>(id & 7, id >> 3, (const bf16*)(ws + WS_Q), (const bf16*)(ws + WS_KV), (const bf16*)(ws + WS_KR), H, F.lds, F.wave);
                else att::nsa_unit<PROBE_MODE>((id - 256) >> 1, (id - 256) & 1, (const bf16*)(ws + WS_ACT), (const bf16*)(ws + WS_KC), (const bf16*)(ws + WS_VC), args.in[20], (float*)(ws + WS_MIXF), H, F.lds, F.wave);
            } else {
                if (id < 256) att::mla_unit<0>(id & 7, id >> 3, (const bf16*)(ws + WS_Q), (const bf16*)(ws + WS_KV), (const bf16*)(ws + WS_KR), H, F.lds, F.wave);
                else att::nsa_unit<0>((id - 256) >> 1, (id - 256) & 1, (const bf16*)(ws + WS_ACT), (const bf16*)(ws + WS_KC), (const bf16*)(ws + WS_VC), args.in[20], (float*)(ws + WS_MIXF), H, F.lds, F.wave);
            }
        }
    }
    }
    SEAM(10);
    if (IN(11)) { REFRESH_CTX(); pg8::Gemm g{H, (const bf16*)(ws + WS_WOUT), S_, D_, D_, D_, D_}; pg8::StaticOrder S; S.init(S_, D_, F.G, (int)blockIdx.x);
        pg8::EpiResid E{X1, X1, D_, MOD + 5 * D_, 1.0f}; pg8::gemm_phase<pg8::EpiResid, pg8::StaticOrder, PG8_ALIGN, PG8_SP2>(F.lds, g, S, E, F.wave); }
    SEAM(11);
    if (IN(12)) { REFRESH_CTX(); build_mod_tables(F, ws, args.in[22], args.in[3], 6, false, gwt, sht); norm_rows_bf16(F, X1, H, gwt, sht); __syncthreads(); }
    SEAM(12);
    if (IN(13)) { REFRESH_CTX(); pg8::Gemm g{H, (const bf16*)(ws + WS_WGU2), S_, 2 * FF_, D_, D_, D_}; pg8::StaticOrder S; S.init(S_, 2 * FF_, F.G, (int)blockIdx.x);
        pg8::EpiSwiglu E{ACT, FF_}; pg8::gemm_phase<pg8::EpiSwiglu, pg8::StaticOrder, PG8_ALIGN, PG8_SP2>(F.lds, g, S, E, F.wave); }
    SEAM(13);
    if (IN(14)) { REFRESH_CTX(); pg8::Gemm g{ACT, (const bf16*)(ws + WS_WD2), S_, D_, FF_, FF_, FF_}; pg8::StaticOrder S; S.init(S_, D_, F.G, (int)blockIdx.x);
        pg8::EpiResid E{X1, args.out, D_, MOD + 8 * D_, 0.5f}; pg8::gemm_phase<pg8::EpiResid, pg8::StaticOrder, PG8_ALIGN, PG8_SP2>(F.lds, g, S, E, F.wave); }
    SEAM(14);
    if (IN(15)) { REFRESH_CTX(); final_norm(F, args.out, args.in[26]); }
#undef IN
#undef SEAM
}

extern "C" void kernel_launch(void* const* d_in, const int* in_sizes, int n_in, void* d_out, int out_size, void* d_ws, size_t ws_size, hipStream_t stream) {
    static int grid = 0;
    if (grid == 0) {
        if (n_in != 27 || out_size != S_ * D_ || ws_size < WS_END) { fprintf(stderr, "kernel_launch: unexpected shapes (n_in %d out %d ws %zu)\n", n_in, out_size, ws_size); grid = -1; return; }
        int dev = 0, cus = 0;
        if (hipGetDevice(&dev) != hipSuccess || hipDeviceGetAttribute(&cus, hipDeviceAttributeMultiprocessorCount, dev) != hipSuccess) { grid = -1; return; }
        if (hipFuncSetAttribute((const void*)mega, hipFuncAttributeMaxDynamicSharedMemorySize, LDS_BYTES) != hipSuccess) { fprintf(stderr, "hipFuncSetAttribute failed\n"); grid = -1; return; }
        grid = cus;
    }
    if (grid < 0) return;
    (void)hipMemsetAsync((char*)d_ws + WS_CTL, 0, 1 * MiB, stream);
    Args a{};
    for (int i = 0; i < 27; ++i) a.in[i] = (const float*)d_in[i];
    a.out = (float*)d_out; a.ws = (unsigned char*)d_ws;
    unsigned char* ws = (unsigned char*)d_ws;
    auto run = [&](int lo, int hi, int nbar) { a.ph_lo = lo; a.ph_hi = hi; a.nbar = nbar; hipLaunchKernelGGL(mega, dim3(grid), dim3(NTHR), LDS_BYTES, stream, a); };
    run(0, 16, 0);
}
```

```cpp
#include <hip/hip_runtime.h>
#include <cstdio>
#include <cstdint>
#include <cmath>
namespace pg8 {
#define PG8_LAS __attribute__((address_space(3)))
typedef unsigned short bf16_t;
typedef short bf16x8 __attribute__((ext_vector_type(8)));
typedef float f32x4 __attribute__((ext_vector_type(4)));
typedef unsigned u32x4 __attribute__((ext_vector_type(4)));
constexpr int BM = 256, BK = 64, HALF = 128, HTB = HALF * BK * 2  , STAGE_BYTES = 8 * HTB, NXCD = 8, WGM = 8;

__host__ __device__ __forceinline__ int lds_byte(int r, int c) { const int st = (r >> 4) * 2 + (c >> 5), rr = r & 15, cc = c & 31, ob = rr * 64 + cc * 2; return st * 1024 + (ob ^ (((ob >> 9) & 1) << 5)); }
__host__ __device__ __forceinline__ void stage_rc(int b, int& R, int& C) { const int st = b / 1024, sb = b % 1024, swz = sb ^ (((sb >> 9) & 1) << 5); R = (st >> 1) * 16 + swz / 64; C = (st & 1) * 32 + (swz % 64) / 2; }
__host__ __device__ __forceinline__ int perm32(int rho) { const int n = rho >> 4, i = rho & 15; return 8 * (i >> 2) + 4 * n + (i & 3); }

struct Unit { int pm, pn; };
struct Gemm { const bf16_t* A; const bf16_t* Bt; int M, N, K, lda, ldb; };

struct StaticOrder {
    int nM, nN, nwg, G, c;
    __host__ __device__ void init(int M, int N, int G_, int c_) { nM = M / BM; nN = N / BM; nwg = nM * nN; G = G_; c = c_; }
    __host__ __device__ void init_units(int nM_, int nN_, int G_, int c_) { nM = nM_; nN = nN_; nwg = nM * nN; G = G_; c = c_; }
    __host__ __device__ bool next(int i, Unit& u) const {
        const long L = (long)i * G + c; if (L >= nwg) return false;
        int wgid = (int)L; { const int q = nwg / NXCD, r = nwg % NXCD, xcd = wgid % NXCD, off = wgid / NXCD; wgid = (xcd < r ? xcd * (q + 1) : r * (q + 1) + (xcd - r) * q) + off; }
        const int nig = WGM * nN, gid = wgid / nig, fm = gid * WGM, gsz = (nM - fm) < WGM ? (nM - fm) : WGM;
        u.pm = fm + ((wgid % nig) % gsz); u.pn = (wgid % nig) / gsz; return true;
    }
    __device__ __forceinline__ void a_ready(const Unit&) const {}
    __device__ __forceinline__ void done(const Unit&) const {}
};
__device__ __forceinline__ unsigned cvt_pk_bf16(float lo, float hi) { unsigned r; asm volatile("v_cvt_pk_bf16_f32 %0, %1, %2" : "=v"(r) : "v"(lo), "v"(hi)); return r; }
typedef unsigned u32x4 __attribute__((ext_vector_type(4)));
__device__ __forceinline__ float silu_f(float v) { return v * __builtin_amdgcn_rcpf(1.0f + __builtin_amdgcn_exp2f(-1.4426950408889634f * v)); }
struct EpiSwiglu {
    static constexpr bool PERM = true, AFTER_DRAIN = false;
    bf16_t* O; int ldc;
    __device__ __forceinline__ void operator()(const f32x4 (&acc)[2][2][4][2], const Unit& u, int wr, int wc, int fr, int fq) const {
        const int row0 = u.pm * BM + wr * 64 + fr, col0 = u.pn * 128 + wc * 32 + 8 * fq;
#pragma unroll
        for (int ai = 0; ai < 2; ++ai)
#pragma unroll
            for (int m = 0; m < 4; ++m) {
                bf16_t* rowp = O + (size_t)(row0 + ai * HALF + m * 16) * ldc + col0;
                const f32x4 g0 = acc[ai][0][m][0], g1 = acc[ai][0][m][1], u0 = acc[ai][1][m][0], u1 = acc[ai][1][m][1];
                u32x4 w;
                w.x = cvt_pk_bf16(silu_f(g0[0]) * u0[0], silu_f(g0[1]) * u0[1]); w.y = cvt_pk_bf16(silu_f(g0[2]) * u0[2], silu_f(g0[3]) * u0[3]);
                w.z = cvt_pk_bf16(silu_f(g1[0]) * u1[0], silu_f(g1[1]) * u1[1]); w.w = cvt_pk_bf16(silu_f(g1[2]) * u1[2], silu_f(g1[3]) * u1[3]);
                *(u32x4*)rowp = w;
            }
    }
};
struct EpiStore {
    static constexpr bool PERM = true, AFTER_DRAIN = false;
    bf16_t* O; int ldc;
    __device__ __forceinline__ void operator()(const f32x4 (&acc)[2][2][4][2], const Unit& u, int wr, int wc, int fr, int fq) const {
        const int row0 = u.pm * BM + wr * 64 + fr, col0 = u.pn * BM + wc * 32 + 8 * fq;
#pragma unroll
        for (int ai = 0; ai < 2; ++ai)
#pragma unroll
            for (int m = 0; m < 4; ++m) {
                bf16_t* rowp = O + (size_t)(row0 + ai * HALF + m * 16) * ldc + col0;
#pragma unroll
                for (int bj = 0; bj < 2; ++bj) {
                    const f32x4 v0 = acc[ai][bj][m][0], v1 = acc[ai][bj][m][1];
                    u32x4 w; w.x = cvt_pk_bf16(v0[0], v0[1]); w.y = cvt_pk_bf16(v0[2], v0[3]); w.z = cvt_pk_bf16(v1[0], v1[1]); w.w = cvt_pk_bf16(v1[2], v1[3]);
                    *(u32x4*)(rowp + bj * HALF) = w;
                }
            }
    }
};
struct EpiResid {
    static constexpr bool PERM = false, AFTER_DRAIN = false;
    const float* base; float* out; int ldc; const float* gv; float coef;
    __device__ __forceinline__ void operator()(const f32x4 (&acc)[2][2][4][2], const Unit& u, int wr, int wc, int fr, int fq) const {
        const int col0 = u.pn * BM + wc * 32 + 4 * fq;
        f32x4 gg[2][2];
#pragma unroll
        for (int bj = 0; bj < 2; ++bj)
#pragma unroll
            for (int n = 0; n < 2; ++n) gg[bj][n] = *(const f32x4*)(gv + col0 + bj * HALF + n * 16) * coef;
#pragma unroll
        for (int ai = 0; ai < 2; ++ai)
#pragma unroll
            for (int m = 0; m < 4; ++m) {
                const size_t off = (size_t)(u.pm * BM + ai * HALF + wr * 64 + m * 16 + fr) * ldc + col0;
#pragma unroll
                for (int bj = 0; bj < 2; ++bj)
#pragma unroll
                    for (int n = 0; n < 2; ++n) {
                        const f32x4 bs = *(const f32x4*)(base + off + bj * HALF + n * 16);
                        *(f32x4*)(out + off + bj * HALF + n * 16) = bs + gg[bj][n] * acc[ai][bj][m][n];
                    }
            }
    }
};
struct EpiPart {
    static constexpr bool PERM = false, AFTER_DRAIN = false;
    float* P; int rows;
    __device__ __forceinline__ void operator()(const f32x4 (&acc)[2][2][4][2], const Unit& u, int wr, int wc, int fr, int fq) const {
        const int col0 = wc * 32 + 4 * fq;
#pragma unroll
        for (int ai = 0; ai < 2; ++ai)
#pragma unroll
            for (int m = 0; m < 4; ++m) {
                float* rowp = P + ((size_t)u.pn * rows + (u.pm * BM + ai * HALF + wr * 64 + m * 16 + fr)) * 256 + col0;
#pragma unroll
                for (int bj = 0; bj < 2; ++bj)
#pragma unroll
                    for (int n = 0; n < 2; ++n) *(f32x4*)(rowp + bj * HALF + n * 16) = acc[ai][bj][m][n];
            }
    }
};

template <class Epi, class Sched, bool ALIGN_EPI = false, bool SP2 = false, bool SPLITK = false>
__device__ __forceinline__ void gemm_phase(PG8_LAS unsigned char* lds, const Gemm g, const Sched& S, const Epi& E, int wave_id) {
    int lane_; asm volatile("v_mbcnt_lo_u32_b32 %0, -1, 0\n\tv_mbcnt_hi_u32_b32 %0, -1, %0" : "=v"(lane_));
    const int wid = wave_id, lane = lane_, tid = wid * 64 + lane, wr = wid >> 2, wc = wid & 3, fr = lane & 15, fq = lane >> 4;
    const int K = g.K, nt = K / BK;
    unsigned voffA[2], voffB[2];
#pragma unroll
    for (int i = 0; i < 2; ++i) { int R, C; stage_rc(tid * 16 + i * 8192, R, C); const int Rb = Epi::PERM ? ((R & ~31) + perm32(R & 31)) : R;
        voffA[i] = (unsigned)(R * g.lda + C) * 2u; voffB[i] = (unsigned)(Rb * g.ldb + C) * 2u; }
    const size_t kstep = (size_t)(BK * 2);
    const size_t hstepA = (size_t)HALF * g.lda * 2, hstepB = (size_t)HALF * g.ldb * 2;
    const size_t tstepA = 2 * hstepA, tstepB = 2 * hstepB; const size_t kchunk = (size_t)K * 2;
    const unsigned ldsw = (unsigned)wid * 1024u;
    const int aoff = lds_byte(wr * 64 + fr, fq * 8), boff = lds_byte(wc * 32 + fr, fq * 8);
#define PG8_SA(b, h) (((b) * 2 + (h)) * HTB)
#define PG8_SB(b, h) ((4 + (b) * 2 + (h)) * HTB)
#define PG8_STAGE(bufoff, gbase, voff) do { _Pragma("unroll") for (int _i = 0; _i < 2; ++_i) \
        __builtin_amdgcn_global_load_lds((const unsigned*)((const char*)(gbase) + (voff)[_i]), (PG8_LAS unsigned*)(lds + (bufoff) + ldsw + _i * 8192), 16, 0, 0); } while (0)
#define PG8_LDA(dst, b, h) do { _Pragma("unroll") for (int m = 0; m < 4; ++m) _Pragma("unroll") for (int k = 0; k < 2; ++k) dst[m][k] = *(const PG8_LAS bf16x8*)(lds + PG8_SA(b, h) + aoff + m * 2048 + k * 1024); } while (0)
#define PG8_LDB(dst, b, h) do { _Pragma("unroll") for (int n = 0; n < 2; ++n) _Pragma("unroll") for (int k = 0; k < 2; ++k) dst[n][k] = *(const PG8_LAS bf16x8*)(lds + PG8_SB(b, h) + boff + n * 2048 + k * 1024); } while (0)
#define PG8_MMA(ai, bj, At, Bt) do { __builtin_amdgcn_s_setprio(1); _Pragma("unroll") for (int m = 0; m < 4; ++m) _Pragma("unroll") for (int n = 0; n < 2; ++n) _Pragma("unroll") for (int k = 0; k < 2; ++k) \
        acc[ai][bj][m][n] = __builtin_amdgcn_mfma_f32_16x16x32_bf16(Bt[n][k], At[m][k], acc[ai][bj][m][n], 0, 0, 0); __builtin_amdgcn_s_setprio(0); } while (0)
#define PG8_WAIT_V(n) asm volatile("s_waitcnt vmcnt(" #n ")" ::: "memory")
#define PG8_WAIT_L(n) asm volatile("s_waitcnt lgkmcnt(" #n ")" ::: "memory")
#define PG8_BAR __builtin_amdgcn_s_barrier()
#define PG8_SCHED __builtin_amdgcn_sched_barrier(0)
    Unit cur, nxt; int ui = 0;
    if (!S.next(0, cur)) return;
    f32x4 acc[2][2][4][2];
#pragma unroll
    for (int a = 0; a < 2; ++a)
#pragma unroll
        for (int b = 0; b < 2; ++b)
#pragma unroll
            for (int m = 0; m < 4; ++m)
#pragma unroll
                for (int n = 0; n < 2; ++n) acc[a][b][m][n] = (f32x4){0.f, 0.f, 0.f, 0.f};
    bf16x8 At[4][2], B0[2][2], B1[2][2];
    const char* cA = (const char*)g.A + (size_t)cur.pm * tstepA + (SPLITK ? (size_t)cur.pn * kchunk : 0); const char* cB = (const char*)g.Bt + (SPLITK ? (size_t)cur.pn * kchunk : (size_t)cur.pn * tstepB);
    S.a_ready(cur);
    if constexpr (SP2) {
        PG8_STAGE(PG8_SB(0, 0), cB, voffB); PG8_STAGE(PG8_SB(0, 1), cB + hstepB, voffB); PG8_STAGE(PG8_SA(0, 0), cA, voffA); PG8_STAGE(PG8_SA(0, 1), cA + hstepA, voffA);
        if (wr == 1) PG8_BAR;
        PG8_WAIT_V(2); PG8_BAR;
        PG8_STAGE(PG8_SB(1, 0), cB + kstep, voffB); PG8_STAGE(PG8_SA(1, 0), cA + kstep, voffA); PG8_STAGE(PG8_SB(1, 1), cB + hstepB + kstep, voffB);
        PG8_WAIT_V(6); PG8_BAR;
    } else {
        PG8_STAGE(PG8_SB(0, 0), cB, voffB); PG8_STAGE(PG8_SA(0, 0), cA, voffA); PG8_STAGE(PG8_SB(0, 1), cB + hstepB, voffB); PG8_STAGE(PG8_SA(0, 1), cA + hstepA, voffA);
        if (wr == 1) PG8_BAR;
        PG8_WAIT_V(4); PG8_BAR;
        PG8_STAGE(PG8_SB(1, 0), cB + kstep, voffB); PG8_STAGE(PG8_SA(1, 0), cA + kstep, voffA); PG8_STAGE(PG8_SB(1, 1), cB + hstepB + kstep, voffB);
        PG8_WAIT_V(6); PG8_BAR;
    }
    for (;;) {
        const bool has_next = S.next(ui + 1, nxt);
        const char* nA = has_next ? (const char*)g.A + (size_t)nxt.pm * tstepA + (SPLITK ? (size_t)nxt.pn * kchunk : 0) : cA; const char* nB = has_next ? (const char*)g.Bt + (SPLITK ? (size_t)nxt.pn * kchunk : (size_t)nxt.pn * tstepB) : cB;
        for (int t = 0; t < nt; t += 2) {
            const bool last = (t == nt - 2);
            const char* a1 = cA + (size_t)(t + 1) * kstep;
            const char* a2 = last ? nA : cA + (size_t)(t + 2) * kstep; const char* b2 = last ? nB : cB + (size_t)(t + 2) * kstep;
            const char* a3 = a2 + kstep; const char* b3 = b2 + kstep;
            if (last && has_next) S.a_ready(nxt);
            if constexpr (SP2) {
            PG8_LDB(B0, 0, 0); PG8_LDB(B1, 0, 1); PG8_SCHED; PG8_LDA(At, 0, 0); PG8_STAGE(PG8_SA(1, 1), a1 + hstepA, voffA);
            PG8_WAIT_V(8); PG8_WAIT_L(0); PG8_BAR; PG8_MMA(0, 0, At, B0); PG8_MMA(0, 1, At, B1); PG8_BAR; PG8_SCHED;
            PG8_LDA(At, 0, 1); PG8_STAGE(PG8_SB(0, 0), b2, voffB); PG8_STAGE(PG8_SB(0, 1), b2 + hstepB, voffB); PG8_STAGE(PG8_SA(0, 0), a2, voffA);
            PG8_WAIT_V(8); PG8_WAIT_L(0); PG8_BAR; PG8_MMA(1, 0, At, B0); PG8_MMA(1, 1, At, B1); PG8_BAR; PG8_SCHED;
            PG8_LDB(B0, 1, 0); PG8_LDB(B1, 1, 1); PG8_SCHED; PG8_LDA(At, 1, 0); PG8_STAGE(PG8_SA(0, 1), a2 + hstepA, voffA);
            PG8_WAIT_V(8); PG8_WAIT_L(0); PG8_BAR; PG8_MMA(0, 0, At, B0); PG8_MMA(0, 1, At, B1); PG8_BAR; PG8_SCHED;
            PG8_LDA(At, 1, 1); PG8_STAGE(PG8_SB(1, 0), b3, voffB); PG8_STAGE(PG8_SB(1, 1), b3 + hstepB, voffB); PG8_STAGE(PG8_SA(1, 0), a3, voffA);
            PG8_WAIT_V(8); PG8_WAIT_L(0); PG8_BAR; PG8_MMA(1, 0, At, B0); PG8_MMA(1, 1, At, B1); PG8_BAR; PG8_SCHED;
            } else {
            PG8_LDB(B0, 0, 0); PG8_SCHED; PG8_LDA(At, 0, 0); PG8_STAGE(PG8_SA(1, 1), a1 + hstepA, voffA);
            PG8_WAIT_L(8); PG8_BAR; PG8_WAIT_L(0); PG8_MMA(0, 0, At, B0); PG8_BAR; PG8_SCHED;
            PG8_LDB(B1, 0, 1); PG8_STAGE(PG8_SB(0, 0), b2, voffB);
            PG8_BAR; PG8_WAIT_L(0); PG8_MMA(0, 1, At, B1); PG8_BAR;
            PG8_LDA(At, 0, 1); PG8_STAGE(PG8_SA(0, 0), a2, voffA);
            PG8_BAR; PG8_WAIT_L(0); PG8_MMA(1, 0, At, B0); PG8_BAR; PG8_SCHED;
            PG8_STAGE(PG8_SB(0, 1), b2 + hstepB, voffB);
            PG8_WAIT_V(6); PG8_BAR; PG8_MMA(1, 1, At, B1); PG8_BAR;
            PG8_LDB(B0, 1, 0); PG8_SCHED; PG8_LDA(At, 1, 0); PG8_STAGE(PG8_SA(0, 1), a2 + hstepA, voffA);
            PG8_WAIT_L(8); PG8_BAR; PG8_WAIT_L(0); PG8_MMA(0, 0, At, B0); PG8_BAR; PG8_SCHED;
            PG8_LDB(B1, 1, 1); PG8_STAGE(PG8_SB(1, 0), b3, voffB);
            PG8_BAR; PG8_WAIT_L(0); PG8_MMA(0, 1, At, B1); PG8_BAR;
            PG8_LDA(At, 1, 1); PG8_STAGE(PG8_SA(1, 0), a3, voffA);
            PG8_BAR; PG8_WAIT_L(0); PG8_MMA(1, 0, At, B0); PG8_BAR; PG8_SCHED;
            PG8_STAGE(PG8_SB(1, 1), b3 + hstepB, voffB);
            PG8_WAIT_V(6); PG8_BAR; PG8_MMA(1, 1, At, B1); PG8_BAR;
            }
        }
        if constexpr (ALIGN_EPI) { if (wr == 0) PG8_BAR; }
        if constexpr (!Epi::AFTER_DRAIN) { E(acc, cur, wr, wc, fr, fq); S.done(cur); }
        if (!has_next) break;
#pragma unroll
        for (int a = 0; a < 2; ++a)
#pragma unroll
            for (int b = 0; b < 2; ++b)
#pragma unroll
                for (int m = 0; m < 4; ++m)
#pragma unroll
                    for (int n = 0; n < 2; ++n) acc[a][b][m][n] = (f32x4){0.f, 0.f, 0.f, 0.f};
        cur = nxt; cA = nA; cB = nB; ++ui;
        if constexpr (ALIGN_EPI) { if (wr == 1) PG8_BAR; }
    }
    PG8_WAIT_V(0);
    if constexpr (!ALIGN_EPI) { if (wr == 0) PG8_BAR; }
    PG8_BAR;
    if constexpr (Epi::AFTER_DRAIN) { E.fused(acc, cur, wr, wc, fr, fq, lds, wid, lane); S.done(cur); }
#undef PG8_SA
#undef PG8_SB
#undef PG8_STAGE
#undef PG8_LDA
#undef PG8_LDB
#undef PG8_MMA
#undef PG8_WAIT_V
#undef PG8_WAIT_L
#undef PG8_BAR
#undef PG8_SCHED
}
}

constexpr int S_ = 8192, D_ = 2048, FF_ = 5632, DIN = 4824, DINP = 4864;
constexpr int O_CQ = 0, O_CKV = 768, O_KR = 1280, O_QN = 1344, O_KN = 2880, O_VN = 4032, O_GN = 4800;
constexpr int NWAVES = 8, NTHR = 512;
constexpr size_t MiB = 1u << 20;
constexpr size_t WS_CTL = 0;
constexpr size_t WS_MODP = 507 * MiB;
constexpr size_t WS_MOD = 2 * MiB;
constexpr size_t WS_ROPE = 3 * MiB;
constexpr size_t WS_WGU1 = 6 * MiB;
constexpr size_t WS_WD1 = 50 * MiB;
constexpr size_t WS_WIN = 72 * MiB;
constexpr size_t WS_WUQ = 91 * MiB;
constexpr size_t WS_WUKV = 94 * MiB;
constexpr size_t WS_WCK1 = 96 * MiB;
constexpr size_t WS_WCV1 = 99 * MiB;
constexpr size_t WS_WCK2 = 101 * MiB;
constexpr size_t WS_WCV2 = 101 * MiB + 512 * 1024;
constexpr size_t WS_WOUT = 102 * MiB;
constexpr size_t WS_WGU2 = 110 * MiB;
constexpr size_t WS_WD2 = 154 * MiB;
constexpr size_t WS_H = 176 * MiB;
constexpr size_t WS_ACT = 208 * MiB;
constexpr size_t WS_X1 = 296 * MiB;
constexpr size_t WS_Q = 360 * MiB;
constexpr size_t WS_KV = 384 * MiB;
constexpr size_t WS_KR = 416 * MiB;
constexpr size_t WS_CQN = 417 * MiB;
constexpr size_t WS_CKVN = 429 * MiB;
constexpr size_t WS_FLATK = 437 * MiB;
constexpr size_t WS_FLATV = 449 * MiB;
constexpr size_t WS_PARTK = 457 * MiB;
constexpr size_t WS_PARTV = 469 * MiB;
constexpr size_t WS_HIDK = 473 * MiB;
constexpr size_t WS_HIDV = 473 * MiB + 512 * 1024;
constexpr size_t WS_KC = 474 * MiB;
constexpr size_t WS_VC = 474 * MiB + 512 * 1024;
constexpr size_t WS_MIXF = 475 * MiB;
constexpr size_t WS_END = 509 * MiB;
constexpr int KCH_K = 512, NCH_K = 12, KCH_V = 1024, NCH_V = 4;

constexpr int RING_BYTES = 131072, LDSCTL_OFF = RING_BYTES, MISC_OFF = LDSCTL_OFF + 320, LDS_BYTES = 147456;

#define GAS __attribute__((address_space(1)))
#define LAS __attribute__((address_space(3)))
typedef unsigned short bf16;
typedef unsigned v4u __attribute__((ext_vector_type(4)));
typedef unsigned v2u __attribute__((ext_vector_type(2)));
typedef float f32x4 __attribute__((ext_vector_type(4)));
typedef GAS unsigned gu32;
#define RLX_AGENT __ATOMIC_RELAXED, __HIP_MEMORY_SCOPE_AGENT
#define LDS_WAIT() asm volatile("s_waitcnt lgkmcnt(0)" ::: "memory")
#define VM_WAIT() asm volatile("s_waitcnt vmcnt(0)" ::: "memory")
__device__ __forceinline__ unsigned f2bf(float f) { unsigned u = __builtin_bit_cast(unsigned, f); return (u + 0x7fffu + ((u >> 16) & 1u)) >> 16; }
__device__ __forceinline__ unsigned pk2(float lo, float hi) { return f2bf(lo) | (f2bf(hi) << 16); }
__device__ __forceinline__ float bflo(unsigned w) { return __builtin_bit_cast(float, w << 16); }
__device__ __forceinline__ float bfhi(unsigned w) { return __builtin_bit_cast(float, w & 0xffff0000u); }
__device__ __forceinline__ float bf1(bf16 b) { return __builtin_bit_cast(float, (unsigned)b << 16); }
__device__ __forceinline__ float wave_sum(float v) {
#pragma unroll
    for (int o = 1; o < 64; o <<= 1) v += __shfl_xor(v, o);
    return v;
}

#define XB_TMO      128
#define XB_XCNT(j)  (256  + 64 * (j))
#define XB_XSUB(j)  (1280 + 64 * (j))
#define XB_XGEN(j)  (2304 + 64 * (j))
#define XB_TOP      3328
#define XB_TOPGEN   3392
#define XCD_BAR_WORDS 3456
#define XB_SPIN_CAP (1u << 18)

__device__ __forceinline__ unsigned xb_ld(unsigned* p)              { return __hip_atomic_load(p, __ATOMIC_RELAXED, __HIP_MEMORY_SCOPE_AGENT); }
__device__ __forceinline__ unsigned xb_add(unsigned* p, unsigned v) { return __hip_atomic_fetch_add(p, v, __ATOMIC_RELAXED, __HIP_MEMORY_SCOPE_AGENT); }
__device__ __forceinline__ unsigned xb_xcc_id() { return (unsigned)__builtin_amdgcn_s_getreg((3 << 11) | 20) & 0xFu; }
#define XB_SPIN(cond, bar) do { unsigned _sp = 0; while (cond) { __builtin_amdgcn_s_sleep(1); \
    if ((++_sp & 255u) == 0u) { if (xb_ld(&(bar)[XB_TMO])) break; if (_sp > XB_SPIN_CAP) { atomicAdd(&(bar)[XB_TMO], 1u); break; } } } } while (0)

struct XcdBarrier {
    int w0;
    unsigned* bar; unsigned x;
    volatile LAS unsigned* st;
};

__device__ __forceinline__ int xb_lane() { int l; asm volatile("v_mbcnt_lo_u32_b32 %0, -1, 0\n\tv_mbcnt_hi_u32_b32 %0, -1, %0" : "=v"(l)); return l; }
__device__ __forceinline__ XcdBarrier xcd_barrier_post(unsigned* bar, volatile LAS unsigned* st, int w0) {
    XcdBarrier b; b.w0 = w0; b.bar = bar; b.x = xb_xcc_id(); b.st = st;
    if (w0 && xb_lane() == 0) (void)xb_add(&bar[XB_XCNT(b.x)], 1u);
    return b;
}
__device__ __forceinline__ void xcd_barrier_complete(unsigned* bar, unsigned x, unsigned& nloc, unsigned& nx) {
    const unsigned G = gridDim.x * gridDim.y * gridDim.z;
    unsigned sum, cnt, mine, sp = 0u;
    for (;;) {
        sum = 0u; cnt = 0u; mine = 0u;
#pragma unroll
        for (unsigned j = 0; j < 16; ++j) { const unsigned c = xb_ld(&bar[XB_XCNT(j)]); sum += c; cnt += (c > 0u) ? 1u : 0u; mine = (j == x) ? c : mine; }
        if (sum == G) break;
        __builtin_amdgcn_s_sleep(1);
        if ((++sp & 255u) == 0u) { if (xb_ld(&bar[XB_TMO])) break; if (sp > XB_SPIN_CAP) { atomicAdd(&bar[XB_TMO], 1u); break; } }
    }
    nloc = mine > 0u ? mine : 1u; nx = cnt > 0u ? cnt : 1u;
}

__device__ __forceinline__ void xcd_barrier(const XcdBarrier& b) {
    asm volatile("s_waitcnt vmcnt(0)" ::: "memory");
    __syncthreads();
    if (b.w0 && xb_lane() == 0) {
        unsigned* bar = b.bar;
        __builtin_amdgcn_s_waitcnt(0);
        unsigned nloc = b.st[0], nx = b.st[1];
        if (nloc == 0u) { xcd_barrier_complete(bar, b.x, nloc, nx); b.st[0] = nloc; b.st[1] = nx; }
        const unsigned old = xb_add(&bar[XB_XSUB(b.x)], 1u);
        const unsigned gen = old / nloc;
        if (old + 1u == (gen + 1u) * nloc) {
            __builtin_amdgcn_fence(__ATOMIC_RELEASE, "agent");
            asm volatile("s_waitcnt vmcnt(0)" ::: "memory");
            const unsigned og = xb_add(&bar[XB_TOP], 1u);
            const unsigned tg = og / nx;
            if (og + 1u == (tg + 1u) * nx) xb_add(&bar[XB_TOPGEN], 1u);
            else XB_SPIN(xb_ld(&bar[XB_TOPGEN]) == tg, bar);
            __builtin_amdgcn_fence(__ATOMIC_ACQUIRE, "agent");
            xb_add(&bar[XB_XGEN(b.x)], 1u);
            asm volatile("s_waitcnt vmcnt(0)" ::: "memory");
        } else {
            XB_SPIN(xb_ld(&bar[XB_XGEN(b.x)]) == gen, bar);
            __builtin_amdgcn_fence(__ATOMIC_ACQUIRE, "agent");
            asm volatile("s_waitcnt vmcnt(0)" ::: "memory");
        }
    }
    __syncthreads();
}

struct Ctx { LAS unsigned char* lds; int tid, lane, wave, vcu, G; };

struct TD { const float* W; bf16* WT; int K, Nreal, nblk, mode, item; };
__device__ __forceinline__ void tr_load(const TD& d, f32x4 (&v)[8], int lane) {
    const int kb = d.item / d.nblk, nb = d.item % d.nblk, k0 = 64 * kb, n0 = 32 * nb;
    const int n4 = (lane & 7) * 4, kr = lane >> 3; const bool ok = n0 + n4 < d.Nreal;
#pragma unroll
    for (int i = 0; i < 8; ++i) v[i] = ok ? __builtin_nontemporal_load((const f32x4*)(d.W + (size_t)(k0 + kr + 8 * i) * d.Nreal + n0 + n4)) : (f32x4){0.f, 0.f, 0.f, 0.f};
}
__device__ __forceinline__ void tr_store(const TD& d, const f32x4 (&v)[8], LAS float* scr, int lane) {
    const int kb = d.item / d.nblk, nb = d.item % d.nblk, k0 = 64 * kb, n0 = 32 * nb;
    const int n4 = (lane & 7) * 4, kr = lane >> 3;
#pragma unroll
    for (int i = 0; i < 8; ++i) { LAS float* p = scr + (kr + 8 * i) * 33 + n4; p[0] = v[i].x; p[1] = v[i].y; p[2] = v[i].z; p[3] = v[i].w; }
    LDS_WAIT(); asm volatile("" ::: "memory");
    const int c = lane & 7;
    const int drow0 = d.mode == 0 ? n0 : ((n0 >> 7) * 256 + (n0 & 127) + (d.mode == 2 ? 128 : 0));
#pragma unroll
    for (int j = 0; j < 4; ++j) { const int n = (lane >> 3) + 8 * j; const LAS float* s = scr + (8 * c) * 33 + n;
        v4u o; o.x = pk2(s[0 * 33], s[1 * 33]); o.y = pk2(s[2 * 33], s[3 * 33]); o.z = pk2(s[4 * 33], s[5 * 33]); o.w = pk2(s[6 * 33], s[7 * 33]);
        *(GAS v4u*)(d.WT + (size_t)(drow0 + n) * d.K + k0 + 8 * c) = o; }
    LDS_WAIT(); asm volatile("" ::: "memory");
}

struct P0Args { const float *w1g, *w1u, *w1d, *win, *wuq, *wukv, *ck1, *ck2, *cv1, *cv2, *wout, *w2g, *w2u, *w2d, *c, *wada; unsigned char* ws; };
constexpr int I_GU = 32 * 176, I_DN = 88 * 64, I_IN = 32 * 152, I_UQ = 12 * 48, I_UKV = 8 * 64, I_CK1 = 96 * 8, I_CK2 = 4 * 8, I_CV1 = 64 * 8, I_CV2 = 4 * 8, I_OUT = 32 * 64;
constexpr int NIT_A = 2 * I_GU, NIT_B = I_DN + I_IN, NIT_C = I_UQ + I_UKV + I_CK1 + I_CK2 + I_CV1 + I_CV2 + I_OUT + I_DN, NIT_D = 2 * I_GU;
__device__ __forceinline__ TD conv_desc(int grp, int r, const P0Args& a) {
    unsigned char* ws = a.ws;
    if (grp == 0) {
        if (r < I_GU) return TD{a.w1g, (bf16*)(ws + WS_WGU1), 2048, 5632, 176, 1, r}; r -= I_GU;
        return TD{a.w1u, (bf16*)(ws + WS_WGU1), 2048, 5632, 176, 2, r};
    } else if (grp == 1) {
        if (r < I_DN) return TD{a.w1d, (bf16*)(ws + WS_WD1), 5632, 2048, 64, 0, r}; r -= I_DN;
        return TD{a.win, (bf16*)(ws + WS_WIN), 2048, DIN, 152, 0, r};
    } else if (grp == 2) {
        if (r < I_UQ) return TD{a.wuq, (bf16*)(ws + WS_WUQ), 768, 1536, 48, 0, r}; r -= I_UQ;
        if (r < I_UKV) return TD{a.wukv, (bf16*)(ws + WS_WUKV), 512, 2048, 64, 0, r}; r -= I_UKV;
        if (r < I_CK1) return TD{a.ck1, (bf16*)(ws + WS_WCK1), 6144, 256, 8, 0, r}; r -= I_CK1;
        if (r < I_CK2) return TD{a.ck2, (bf16*)(ws + WS_WCK2), 256, 192, 8, 0, r}; r -= I_CK2;
        if (r < I_CV1) return TD{a.cv1, (bf16*)(ws + WS_WCV1), 4096, 256, 8, 0, r}; r -= I_CV1;
        if (r < I_CV2) return TD{a.cv2, (bf16*)(ws + WS_WCV2), 256, 128, 8, 0, r}; r -= I_CV2;
        if (r < I_OUT) return TD{a.wout, (bf16*)(ws + WS_WOUT), 2048, 2048, 64, 0, r}; r -= I_OUT;
        return TD{a.w2d, (bf16*)(ws + WS_WD2), 5632, 2048, 64, 0, r};
    }
    if (r < I_GU) return TD{a.w2g, (bf16*)(ws + WS_WGU2), 2048, 5632, 176, 1, r}; r -= I_GU;
    return TD{a.w2u, (bf16*)(ws + WS_WGU2), 2048, 5632, 176, 2, r};
}
__device__ __forceinline__ void conv_run(int grp, int first, int step, int nitems, const P0Args& a, LAS float* scr, int lane) {
    if (first >= nitems) return;
    f32x4 va[8], vb[8];
    TD da = conv_desc(grp, first, a); tr_load(da, va, lane);
    for (int it = first; it < nitems; it += 2 * step) {
        const bool hb = it + step < nitems; TD db = da;
        if (hb) { db = conv_desc(grp, it + step, a); tr_load(db, vb, lane); }
        tr_store(da, va, scr, lane);
        if (!hb) break;
        const bool ha = it + 2 * step < nitems;
        if (ha) { da = conv_desc(grp, it + 2 * step, a); tr_load(da, va, lane); }
        tr_store(db, vb, scr, lane);
        if (!ha) break;
    }
}
__device__ __forceinline__ void conv_tail(const Ctx& F, const P0Args& a, int grp, int nitems, int nwg) {
    const int G = F.G, rem = nwg % G, c = (int)blockIdx.x;
    int rank, nidle;
    if (rem == 0) { rank = c; nidle = G; } else { if (c < rem) return; rank = c - rem; nidle = G - rem; }
    LAS float* scr = (LAS float*)(F.lds + F.wave * 16384);
    conv_run(grp, rank * NWAVES + F.wave, nidle * NWAVES, nitems, a, scr, F.lane);
}
__device__ __forceinline__ void p0_prologue(const Ctx& F, const P0Args& a) {
    LAS float* scr = (LAS float*)(F.lds + F.wave * 16384);
    const int gw = F.vcu * NWAVES + F.wave, NGW = F.G * NWAVES;
    unsigned char* ws = a.ws;
    conv_run(0, gw, NGW, NIT_A, a, scr, F.lane);
    float* modp = (float*)(ws + WS_MODP);
    for (int it = gw; it < 72 * 16; it += NGW) {
        const int cg = it >> 4, kc = it & 15, col = cg * 256 + F.lane * 4;
        const float* wp = a.wada + (size_t)(kc * 128) * 18432 + col; const float* cp = a.c + kc * 128;
        f32x4 acc = (f32x4){0.f, 0.f, 0.f, 0.f};
#pragma unroll 16
        for (int i = 0; i < 128; ++i) { const float ci = cp[i]; const float sl = ci / (1.f + __expf(-ci)); acc += __builtin_nontemporal_load((const f32x4*)(wp + (size_t)i * 18432)) * sl; }
        *(f32x4*)(modp + kc * 18432 + col) = acc;
    }
    float* cs = (float*)(ws + WS_ROPE); float* sn = cs + 8192 * 32;
    for (int idx = (F.vcu * NTHR + F.tid); idx < 8192 * 32; idx += F.G * NTHR) {
        const int t = idx >> 5, i = idx & 31;
        const float inv = powf(10000.0f, -(float)(2 * i) / 64.0f); const float ang = (float)t * inv;
        cs[idx] = cosf(ang); sn[idx] = sinf(ang);
    }
}

__device__ __forceinline__ void norm_rows_bf16(const Ctx& F, const float* X, bf16* O, const LAS float* gwt, const LAS float* sht) {
    const int gw = F.vcu * NWAVES + F.wave, NGW = F.G * NWAVES;
    for (int m = gw; m < S_; m += NGW) {
        const GAS f32x4* xr = (const GAS f32x4*)(X + (size_t)m * D_) + F.lane;
        f32x4 v[8]; float s = 0.f;
#pragma unroll
        for (int j = 0; j < 8; ++j) { v[j] = xr[64 * j]; s += (v[j].x * v[j].x + v[j].y * v[j].y) + (v[j].z * v[j].z + v[j].w * v[j].w); }
        const float rstd = 1.f / sqrtf(wave_sum(s) * (1.f / D_) + 1e-6f);
        GAS v2u* o8 = (GAS v2u*)(O + (size_t)m * D_) + F.lane;
#pragma unroll
        for (int j = 0; j < 8; ++j) { const f32x4 g = *(const LAS f32x4*)(gwt + 4 * (F.lane + 64 * j)), sh = *(const LAS f32x4*)(sht + 4 * (F.lane + 64 * j));
            const f32x4 y = v[j] * rstd * g + sh; v2u w; w.x = pk2(y.x, y.y); w.y = pk2(y.z, y.w); o8[64 * j] = w; }
    }
}
__device__ __forceinline__ void build_mod_tables(const Ctx& F, unsigned char* ws, const float* nw, const float* b_ada, int chunk_sh, bool first, LAS float* gwt, LAS float* sht) {
    const float* modp = (const float*)(ws + WS_MODP); float* mod = (float*)(ws + WS_MOD);
    if (first) {
        for (int col = blockIdx.x * NTHR + F.tid; col < 18432; col += F.G * NTHR) { { float a = b_ada[col];
#pragma unroll
            for (int k = 0; k < 16; ++k) a += modp[k * 18432 + col]; mod[col] = a; } }
    }
    for (int c = F.tid; c < D_; c += NTHR) {
        float sh, sc;
        if (first) { sh = b_ada[chunk_sh * D_ + c]; sc = b_ada[(chunk_sh + 1) * D_ + c];
#pragma unroll
            for (int k = 0; k < 16; ++k) { sh += modp[k * 18432 + chunk_sh * D_ + c]; sc += modp[k * 18432 + (chunk_sh + 1) * D_ + c]; } }
        else { sh = mod[chunk_sh * D_ + c]; sc = mod[(chunk_sh + 1) * D_ + c]; }
        gwt[c] = nw[c] * (1.f + sc); sht[c] = sh;
    }
    LDS_WAIT(); __syncthreads();
}

__device__ __forceinline__ void p6_prep(const Ctx& F, unsigned char* ws, const float* qn_w, const float* kvn_w, const float* pe_k, const float* pe_v) {
    const bf16* U = (const bf16*)(ws + WS_ACT);
    bf16* CQN = (bf16*)(ws + WS_CQN); bf16* CKVN = (bf16*)(ws + WS_CKVN); bf16* KR = (bf16*)(ws + WS_KR);
    const float* cs = (const float*)(ws + WS_ROPE); const float* sn = cs + 8192 * 32;
    const int gw = F.vcu * NWAVES + F.wave, NGW = F.G * NWAVES;
    for (int t = gw; t < S_; t += NGW) {
        const bf16* ur = U + (size_t)t * DINP;
        v2u a[3]; float s = 0.f;
#pragma unroll
        for (int j = 0; j < 3; ++j) { a[j] = *(const GAS v2u*)(ur + O_CQ + 4 * (F.lane + 64 * j)); const float x0 = bflo(a[j].x), x1 = bfhi(a[j].x), x2 = bflo(a[j].y), x3 = bfhi(a[j].y); s += (x0 * x0 + x1 * x1) + (x2 * x2 + x3 * x3); }
        float rstd = 1.f / sqrtf(wave_sum(s) * (1.f / 768.f) + 1e-6f);
#pragma unroll
        for (int j = 0; j < 3; ++j) { const int c0 = 4 * (F.lane + 64 * j); const f32x4 g = *(const f32x4*)(qn_w + c0);
            v2u w; w.x = pk2(bflo(a[j].x) * rstd * g.x, bfhi(a[j].x) * rstd * g.y); w.y = pk2(bflo(a[j].y) * rstd * g.z, bfhi(a[j].y) * rstd * g.w); *(GAS v2u*)(CQN + (size_t)t * 768 + c0) = w; }
        v2u b[2]; s = 0.f;
#pragma unroll
        for (int j = 0; j < 2; ++j) { b[j] = *(const GAS v2u*)(ur + O_CKV + 4 * (F.lane + 64 * j)); const float x0 = bflo(b[j].x), x1 = bfhi(b[j].x), x2 = bflo(b[j].y), x3 = bfhi(b[j].y); s += (x0 * x0 + x1 * x1) + (x2 * x2 + x3 * x3); }
        rstd = 1.f / sqrtf(wave_sum(s) * (1.f / 512.f) + 1e-6f);
#pragma unroll
        for (int j = 0; j < 2; ++j) { const int c0 = 4 * (F.lane + 64 * j); const f32x4 g = *(const f32x4*)(kvn_w + c0);
            v2u w; w.x = pk2(bflo(b[j].x) * rstd * g.x, bfhi(b[j].x) * rstd * g.y); w.y = pk2(bflo(b[j].y) * rstd * g.z, bfhi(b[j].y) * rstd * g.w); *(GAS v2u*)(CKVN + (size_t)t * 512 + c0) = w; }
        if (F.lane < 32) { const int i = F.lane; const float t1 = bf1(ur[O_KR + i]), t2 = bf1(ur[O_KR + i + 32]); const float c = cs[t * 32 + i], sv = sn[t * 32 + i];
            KR[(size_t)t * 64 + i] = (bf16)f2bf(t1 * c - t2 * sv); KR[(size_t)t * 64 + i + 32] = (bf16)f2bf(t1 * sv + t2 * c); }
    }
    bf16* FK = (bf16*)(ws + WS_FLATK); bf16* FV = (bf16*)(ws + WS_FLATV);
    const int gt = F.vcu * NTHR + F.tid, NGT = F.G * NTHR;
    for (int e = gt; e < 1024 * 768; e += NGT) {
        const int r = e / 768, c8 = e % 768, l = c8 / 24, d0 = (c8 % 24) * 8, n = r >> 1, g = r & 1;
        v4u o = (v4u){0u, 0u, 0u, 0u};
        if (r < 1022) { const v4u u = *(const GAS v4u*)(U + (size_t)(16 * n + l) * DINP + O_KN + g * 192 + d0); const f32x4 p0 = *(const f32x4*)(pe_k + l * 192 + d0), p1 = *(const f32x4*)(pe_k + l * 192 + d0 + 4);
            o.x = pk2(bflo(u.x) + p0.x, bfhi(u.x) + p0.y); o.y = pk2(bflo(u.y) + p0.z, bfhi(u.y) + p0.w); o.z = pk2(bflo(u.z) + p1.x, bfhi(u.z) + p1.y); o.w = pk2(bflo(u.w) + p1.z, bfhi(u.w) + p1.w); }
        *(GAS v4u*)(FK + (size_t)r * 6144 + c8 * 8) = o;
    }
    for (int e = gt; e < 1024 * 512; e += NGT) {
        const int r = e / 512, c8 = e % 512, l = c8 / 16, d0 = (c8 % 16) * 8, n = r >> 1, g = r & 1;
        v4u o = (v4u){0u, 0u, 0u, 0u};
        if (r < 1022) { const v4u u = *(const GAS v4u*)(U + (size_t)(16 * n + l) * DINP + O_VN + g * 128 + d0); const f32x4 p0 = *(const f32x4*)(pe_v + l * 128 + d0), p1 = *(const f32x4*)(pe_v + l * 128 + d0 + 4);
            o.x = pk2(bflo(u.x) + p0.x, bfhi(u.x) + p0.y); o.y = pk2(bflo(u.y) + p0.z, bfhi(u.y) + p0.w); o.z = pk2(bflo(u.z) + p1.x, bfhi(u.z) + p1.y); o.w = pk2(bflo(u.w) + p1.z, bfhi(u.w) + p1.w); }
        *(GAS v4u*)(FV + (size_t)r * 4096 + c8 * 8) = o;
    }
}

__device__ __forceinline__ void p8_prep2(const Ctx& F, unsigned char* ws) {
    bf16* Q = (bf16*)(ws + WS_Q);
    const float* cs = (const float*)(ws + WS_ROPE); const float* sn = cs + 8192 * 32;
    const int gw = F.vcu * NWAVES + F.wave, NGW = F.G * NWAVES;
    for (int t = gw; t < S_; t += NGW) {
        const int i = F.lane & 31; const float c = cs[t * 32 + i], sv = sn[t * 32 + i];
#pragma unroll
        for (int j = 0; j < 4; ++j) { const int h = j * 2 + (F.lane >> 5); bf16* qp = Q + (size_t)t * 1536 + h * 192 + 128;
            const float t1 = bf1(qp[i]), t2 = bf1(qp[i + 32]); qp[i] = (bf16)f2bf(t1 * c - t2 * sv); qp[i + 32] = (bf16)f2bf(t1 * sv + t2 * c); }
    }
    const int gt = F.vcu * NTHR + F.tid, NGT = F.G * NTHR;
    const float* PK = (const float*)(ws + WS_PARTK); const float* PV = (const float*)(ws + WS_PARTV);
    bf16* HK = (bf16*)(ws + WS_HIDK); bf16* HV = (bf16*)(ws + WS_HIDV);
    for (int e = gt; e < 2 * 65536; e += NGT) {
        const int which = e >> 16, q4 = e & 65535; const float* P = which ? PV : PK; const int nch = which ? NCH_V : NCH_K;
        f32x4 a = (f32x4){0.f, 0.f, 0.f, 0.f};
        for (int s = 0; s < nch; ++s) a += *(const f32x4*)(P + (size_t)s * 262144 + q4 * 4);
        v2u w; w.x = pk2(a.x / (1.f + __expf(-a.x)), a.y / (1.f + __expf(-a.y))); w.y = pk2(a.z / (1.f + __expf(-a.z)), a.w / (1.f + __expf(-a.w)));
        *(GAS v2u*)((which ? HV : HK) + q4 * 4) = w;
    }
}

__device__ __forceinline__ void final_norm(const Ctx& F, float* out, const float* nw) {
    const int gw = F.vcu * NWAVES + F.wave, NGW = F.G * NWAVES;
    for (int m = gw; m < S_; m += NGW) {
        GAS f32x4* xr = (GAS f32x4*)(out + (size_t)m * D_) + F.lane;
        f32x4 v[8]; float s = 0.f;
#pragma unroll
        for (int j = 0; j < 8; ++j) { v[j] = xr[64 * j]; s += (v[j].x * v[j].x + v[j].y * v[j].y) + (v[j].z * v[j].z + v[j].w * v[j].w); }
        const float rstd = 1.f / sqrtf(wave_sum(s) * (1.f / D_) + 1e-6f);
#pragma unroll
        for (int j = 0; j < 8; ++j) { const f32x4 g = *(const f32x4*)(nw + 4 * (F.lane + 64 * j)); xr[64 * j] = v[j] * rstd * g; }
    }
}

namespace att {
typedef short bf16x8 __attribute__((ext_vector_type(8)));
typedef short s16x4 __attribute__((ext_vector_type(4)));
typedef short v4i16_t __attribute__((ext_vector_type(4)));
typedef float f32x16 __attribute__((ext_vector_type(16)));
typedef LAS const char* lds_cptr;
typedef unsigned u32x4 __attribute__((ext_vector_type(4)));
constexpr int KSLOT = 24576, VSLOT = 16384;
constexpr int L_K = 0, L_V = 2 * KSLOT, L_WSF = L_V + 2 * VSLOT, L_BT = L_WSF + 2048, L_IMP = L_BT + 2048, L_SEL = L_IMP + 32768, L_LIST = L_SEL + 1024, L_MISC = L_LIST + 512, L_END = L_MISC + 256;
static_assert(L_END <= RING_BYTES, "attention LDS map");
constexpr float LOG2E = 1.4426950408889634f;
constexpr float C2 = 0.07216878364870322f * LOG2E;
constexpr float THR = 8.0f;
#ifndef ATT_RESCALE
#define ATT_RESCALE 0
#endif
__device__ __forceinline__ int lane_id() { int l; asm volatile("v_mbcnt_lo_u32_b32 %0, -1, 0\n\tv_mbcnt_hi_u32_b32 %0, -1, %0" : "=v"(l)); return l; }
__device__ __forceinline__ int crow(int r, int hi) { return (r & 3) + 8 * (r >> 2) + 4 * hi; }
__device__ __forceinline__ void glds16(const void* gsrc, unsigned lds_dst) { unsigned keep;
    asm volatile("s_mov_b32 %0, m0\n\ts_mov_b32 m0, %2\n\ts_nop 0\n\tglobal_load_lds_dwordx4 %1, off\n\ts_mov_b32 m0, %0" : "=&s"(keep) : "v"(gsrc), "s"(lds_dst) : "memory"); }
#define ATT_WAIT_BAR() asm volatile("s_waitcnt vmcnt(0) lgkmcnt(0)\n\ts_barrier" ::: "memory")
__device__ __forceinline__ unsigned cvtpk(float lo, float hi) { typedef float f2 __attribute__((ext_vector_type(2))); typedef __bf16 b2 __attribute__((ext_vector_type(2))); f2 v = {lo, hi}; b2 b = __builtin_convertvector(v, b2); return __builtin_bit_cast(unsigned, b); }
__device__ __forceinline__ s16x4 vtr(lds_cptr p) { return __builtin_bit_cast(s16x4, __builtin_amdgcn_ds_read_tr16_b64_v4i16((LAS v4i16_t*)p)); }
__device__ __forceinline__ float xhalf_max(float m) { auto rr = __builtin_amdgcn_permlane32_swap(__float_as_uint(m), __float_as_uint(m), false, false); return fmaxf(__uint_as_float(rr[0]), __uint_as_float(rr[1])); }
__device__ __forceinline__ float xhalf_sum(float m) { auto rr = __builtin_amdgcn_permlane32_swap(__float_as_uint(m), __float_as_uint(m), false, false); return __uint_as_float(rr[0]) + __uint_as_float(rr[1]); }

template <int NKS>
__device__ __forceinline__ void qk_tile(f32x16& p0, f32x16& p1, lds_cptr kslot, const bf16x8* qf, int r32, int hi) {
    const lds_cptr kb = kslot + hi * 1024 + r32 * 16;
    p0 = f32x16{}; p1 = f32x16{};
    bf16x8 fa[3], fb[3];
#define QK_LD(ks) do { fa[(ks) % 3] = *(const LAS bf16x8*)(kb + (ks) * 2048); fb[(ks) % 3] = *(const LAS bf16x8*)(kb + (ks) * 2048 + 512); } while (0)
    QK_LD(0); QK_LD(1);
#pragma unroll
    for (int ks = 0; ks < NKS; ++ks) {
        if (ks + 2 < NKS) QK_LD(ks + 2);
        p0 = __builtin_amdgcn_mfma_f32_32x32x16_bf16(fa[ks % 3], qf[ks], p0, 0, 0, 0);
        p1 = __builtin_amdgcn_mfma_f32_32x32x16_bf16(fb[ks % 3], qf[ks], p1, 0, 0, 0);
        __builtin_amdgcn_sched_barrier(0);
    }
#undef QK_LD
}
struct Soft { float mhat, l; };
template <bool SCALED>
__device__ __forceinline__ void softmax_tile(f32x16& p0, f32x16& p1, Soft& st, f32x16 (&o)[4], bool first, LAS float* wsf, int r32, int hi, float cb = 0.f) {
    float a = fmaxf(p0[0], p1[0]), b = fmaxf(p0[1], p1[1]);
#pragma unroll
    for (int r = 2; r < 16; r += 2) { a = fmaxf(a, fmaxf(p0[r], p1[r])); b = fmaxf(b, fmaxf(p0[r + 1], p1[r + 1])); }
    float rm = xhalf_max(fmaxf(a, b));
    if (!SCALED) rm = fmaf(rm, C2, cb);
    if (first) { st.mhat = rm > -1e30f ? rm : 0.f; }
#if ATT_RESCALE
    else if (__any(rm > st.mhat + THR)) {
        const float nm = fmaxf(st.mhat, rm); const float f = __builtin_amdgcn_exp2f(st.mhat - nm); st.l *= f; st.mhat = nm;
        if (hi == 0) wsf[r32] = f;
        LDS_WAIT();
        LAS float* wb = wsf + 4 * hi; asm volatile("" : "+v"(wb));
#pragma unroll
        for (int r = 0; r < 16; ++r) { const float fr = wb[(r & 3) + 8 * (r >> 2)];
#pragma unroll
            for (int d = 0; d < 4; ++d) o[d][r] *= fr;
            asm volatile("" ::: "memory"); }
    }
#endif
    float s = 0.f; const float nb = SCALED ? -st.mhat : cb - st.mhat;
#pragma unroll
    for (int r = 0; r < 16; ++r) {
        if (SCALED) { p0[r] = __builtin_amdgcn_exp2f(p0[r] + nb); p1[r] = __builtin_amdgcn_exp2f(p1[r] + nb); }
        else { p0[r] = __builtin_amdgcn_exp2f(fmaf(p0[r], C2, nb)); p1[r] = __builtin_amdgcn_exp2f(fmaf(p1[r], C2, nb)); }
        s += p0[r] + p1[r]; }
    st.l += s;
}
__device__ __forceinline__ void wait_bar_n(int n) {
    if (n == 3) asm volatile("s_waitcnt vmcnt(3) lgkmcnt(0)\n\ts_barrier" ::: "memory");
    else if (n == 2) asm volatile("s_waitcnt vmcnt(2) lgkmcnt(0)\n\ts_barrier" ::: "memory");
    else asm volatile("s_waitcnt vmcnt(0) lgkmcnt(0)\n\ts_barrier" ::: "memory");
}
template <bool G1, int NKP, int NVP, class SK, class SV, class FA, class FB>
__device__ __forceinline__ void tile_stream_g(int nt, SK stageK, SV stageV, FA fa, FB fb) {
    stageK(0, 0); stageV(0, 0);
    if (nt > 1) { stageK(1, 1); stageV(1, 1); }
    int pend = 0;
    if (G1) { wait_bar_n(0); }
    for (int t = 0; t < nt; ++t) {
        f32x16 p0, p1;
        wait_bar_n(pend); pend = 0;
        if (G1) { if (t >= 1 && t + 1 < nt) { stageV(t + 1, (t + 1) & 1); pend = NVP; } } else { if (t >= 1 && t + 1 < nt) { stageK(t + 1, (t + 1) & 1); pend = NKP; } }
        fa(t, t & 1, p0, p1);
        wait_bar_n(pend); pend = 0;
        if (G1) { if (t + 2 < nt) { stageK(t + 2, t & 1); pend = NKP; } } else { if (t >= 1 && t + 1 < nt) { stageV(t + 1, (t + 1) & 1); pend = NVP; } }
        fb(t, t & 1, p0, p1);
    }
    if (!G1) { wait_bar_n(pend); }
}
template <int NKP, int NVP, class SK, class SV, class FA, class FB>
__device__ __forceinline__ void tile_stream(int nt, bool g1, SK stageK, SV stageV, FA fa, FB fb) {
    if (g1) tile_stream_g<true, NKP, NVP>(nt, stageK, stageV, fa, fb); else tile_stream_g<false, NKP, NVP>(nt, stageK, stageV, fa, fb);
}
__device__ __forceinline__ void pv_tile(f32x16 (&o)[4], const f32x16& p0, const f32x16& p1, lds_cptr vslot, int lane, int hi) {
    const lds_cptr vp = vslot + ((lane >> 4) & 1) * 32 + (lane & 3) * 8 + (4 * hi + ((lane & 15) >> 2)) * 64;
    u32x4 pw[4];
    pw[0] = (u32x4){cvtpk(p0[0], p0[1]), cvtpk(p0[2], p0[3]), cvtpk(p0[4], p0[5]), cvtpk(p0[6], p0[7])};
    pw[1] = (u32x4){cvtpk(p0[8], p0[9]), cvtpk(p0[10], p0[11]), cvtpk(p0[12], p0[13]), cvtpk(p0[14], p0[15])};
    pw[2] = (u32x4){cvtpk(p1[0], p1[1]), cvtpk(p1[2], p1[3]), cvtpk(p1[4], p1[5]), cvtpk(p1[6], p1[7])};
    pw[3] = (u32x4){cvtpk(p1[8], p1[9]), cvtpk(p1[10], p1[11]), cvtpk(p1[12], p1[13]), cvtpk(p1[14], p1[15])};
    s16x4 vlo[5], vhi[5];
#define PV_LD(st_) do { vlo[(st_) % 5] = vtr(vp + ((st_) >> 2) * 4096 + ((st_) & 3) * 1024); vhi[(st_) % 5] = vtr(vp + ((st_) >> 2) * 4096 + ((st_) & 3) * 1024 + 512); } while (0)
    PV_LD(0); PV_LD(1); PV_LD(2); PV_LD(3);
#pragma unroll
    for (int st_ = 0; st_ < 16; ++st_) {
        if (st_ + 4 < 16) PV_LD(st_ + 4);
        const s16x4 lo = vlo[st_ % 5], hh = vhi[st_ % 5];
        const bf16x8 vf = (bf16x8){lo[0], lo[1], lo[2], lo[3], hh[0], hh[1], hh[2], hh[3]};
        o[st_ >> 2] = __builtin_amdgcn_mfma_f32_32x32x16_bf16(__builtin_bit_cast(bf16x8, pw[st_ & 3]), vf, o[st_ >> 2], 0, 0, 0);
        __builtin_amdgcn_sched_barrier(0);
    }
#undef PV_LD
}
__device__ __forceinline__ void mla_stage_k(int tl, int h, const bf16* KV, const bf16* KR, unsigned kdst, int wid) {
    const int lane = lane_id();
    const size_t row = (size_t)(64 * tl + lane);
    glds16(KV + row * 2048 + h * 256 + wid * 8, (unsigned)__builtin_amdgcn_readfirstlane(kdst + wid * 1024));
    glds16(KV + row * 2048 + h * 256 + (wid + 8) * 8, (unsigned)__builtin_amdgcn_readfirstlane(kdst + (wid + 8) * 1024));
    glds16(KR + row * 64 + wid * 8, (unsigned)__builtin_amdgcn_readfirstlane(kdst + (wid + 16) * 1024));
}
__device__ __forceinline__ void mla_stage_v(int tl, int h, const bf16* KV, unsigned vdst, int wid) {
    const int lane = lane_id();
#pragma unroll
    for (int i = 0; i < 2; ++i) { const int p = wid + 8 * i, d0 = p >> 2, ks = p & 3;
        glds16(KV + (size_t)(64 * tl + 16 * ks + (lane >> 2)) * 2048 + h * 256 + 128 + d0 * 32 + (lane & 3) * 8, (unsigned)__builtin_amdgcn_readfirstlane(vdst + p * 1024)); }
}
template <int probe>
__device__ __forceinline__ void mla_unit(int h, int qb, const bf16* Q, const bf16* KV, const bf16* KR, bf16* MIX, LAS unsigned char* shm, int wid) {
    const int lane = lane_id(); const int r32 = lane & 31, hi = lane >> 5;
    const unsigned lds0 = (unsigned)(uintptr_t)shm;
    const lds_cptr shc = (lds_cptr)shm; LAS float* wsf = (LAS float*)(shm + L_WSF) + wid * 64;
    const int q0w = qb * 256 + wid * 32;
    bf16x8 qf[12];
    { const bf16* qp = Q + (size_t)(q0w + r32) * 1536 + h * 192 + hi * 8;
#pragma unroll
      for (int ks = 0; ks < 12; ++ks) qf[ks] = *(const bf16x8*)(qp + ks * 16); }
    const int NT = 4 * qb + 4, myNT = (q0w + 31) / 64 + 1;
    Soft st; st.mhat = 0.f; st.l = 0.f; f32x16 o[4]; o[0] = f32x16{}; o[1] = f32x16{}; o[2] = f32x16{}; o[3] = f32x16{};
    tile_stream<3, 2>(NT, wid >= 4,
        [&](int t, int sl) { if (probe & 1) return; mla_stage_k(t, h, KV, KR, lds0 + L_K + sl * KSLOT, wid); },
        [&](int t, int sl) { if (probe & 1) return; mla_stage_v(t, h, KV, lds0 + L_V + sl * VSLOT, wid); },
        [&](int t, int sl, f32x16& p0, f32x16& p1) {
            if (t >= myNT || (probe & 2)) return;
            qk_tile<12>(p0, p1, shc + L_K + sl * KSLOT, qf, r32, hi);
            if (64 * t + 63 > q0w) { const int q = q0w + r32, kb = 64 * t + 4 * hi;
#pragma unroll
                for (int r = 0; r < 16; ++r) { const int kv = kb + (r & 3) + 8 * (r >> 2); p0[r] = kv > q ? -INFINITY : p0[r]; p1[r] = kv + 32 > q ? -INFINITY : p1[r]; } }
        },
        [&](int t, int sl, f32x16& p0, f32x16& p1) {
            if (t >= myNT || (probe & 2)) return;
            softmax_tile<false>(p0, p1, st, o, t == 0, wsf, r32, hi);
            pv_tile(o, p0, p1, shc + L_V + sl * VSLOT, lane, hi);
        });
    const float lt = xhalf_sum(st.l);
    if (hi == 0) wsf[32 + r32] = lt;
    LDS_WAIT();
    const int le = lane_id(); const int r32e = le & 31, hie = le >> 5;
    bf16* op = MIX + (size_t)q0w * 2048 + h * 128 + r32e;
#pragma unroll
    for (int r = 0; r < 16; ++r) { const float rl = __builtin_amdgcn_rcpf(wsf[32 + crow(r, hie)]); bf16* orow = op + (size_t)crow(r, hie) * 2048;
#pragma unroll
        for (int d0 = 0; d0 < 4; ++d0) orow[d0 * 32] = (bf16)f2bf(o[d0][r] * rl); }
    ATT_WAIT_BAR();
}
}

namespace att {
__device__ __forceinline__ float dpp_xor1(float v) { return __builtin_bit_cast(float, __builtin_amdgcn_update_dpp(0, __builtin_bit_cast(int, v), 0xB1, 0xF, 0xF, true)); }
__device__ __forceinline__ float dpp_xor2(float v) { return __builtin_bit_cast(float, __builtin_amdgcn_update_dpp(0, __builtin_bit_cast(int, v), 0x4E, 0xF, 0xF, true)); }
__device__ __forceinline__ int t5b(int d) {
    if (d < 16) return d;
    int b = 16;
    b += d >= 19; b += d >= 21; b += d >= 24; b += d >= 27; b += d >= 31; b += d >= 35; b += d >= 40; b += d >= 46; b += d >= 52; b += d >= 59; b += d >= 67; b += d >= 77; b += d >= 87; b += d >= 99; b += d >= 113;
    return b;
}
__device__ __forceinline__ void stage_kv(const bf16* krow0, size_t kpitch, const bf16* vrow0, size_t vpitch, unsigned kdst, unsigned vdst, bool withV, int wid, int lane) {
    lane = lane_id();
    const bf16* kp = krow0 + (size_t)lane * kpitch + wid * 8;
    glds16(kp, (unsigned)__builtin_amdgcn_readfirstlane(kdst + wid * 1024));
    glds16(kp + 64, (unsigned)__builtin_amdgcn_readfirstlane(kdst + (wid + 8) * 1024));
    glds16(kp + 128, (unsigned)__builtin_amdgcn_readfirstlane(kdst + (wid + 16) * 1024));
    if (withV) {
#pragma unroll
        for (int i = 0; i < 2; ++i) { const int p = wid + 8 * i, d0 = p >> 2, ks = p & 3;
            glds16(vrow0 + (size_t)(16 * ks + (lane >> 2)) * vpitch + d0 * 32 + (lane & 3) * 8, (unsigned)__builtin_amdgcn_readfirstlane(vdst + p * 1024)); }
    }
}
__device__ __forceinline__ void stage_k(const bf16* krow0, size_t kpitch, unsigned kdst, int wid) {
    const int lane = lane_id();
    const bf16* kp = krow0 + (size_t)lane * kpitch + wid * 8;
    glds16(kp, (unsigned)__builtin_amdgcn_readfirstlane(kdst + wid * 1024));
    glds16(kp + 64, (unsigned)__builtin_amdgcn_readfirstlane(kdst + (wid + 8) * 1024));
    glds16(kp + 128, (unsigned)__builtin_amdgcn_readfirstlane(kdst + (wid + 16) * 1024));
}
__device__ __forceinline__ void stage_v(const bf16* vrow0, size_t vpitch, unsigned vdst, int wid) {
    const int lane = lane_id();
#pragma unroll
    for (int i = 0; i < 2; ++i) { const int p = wid + 8 * i, d0 = p >> 2, ks = p & 3;
        glds16(vrow0 + (size_t)(16 * ks + (lane >> 2)) * vpitch + d0 * 32 + (lane & 3) * 8, (unsigned)__builtin_amdgcn_readfirstlane(vdst + p * 1024)); }
}
struct TileP { int pbase, pstride, dmax; bool lookup, mask; };
__device__ __forceinline__ void logits(f32x16& p0, f32x16& p1, int tq, bool rowsel, const TileP tp, float cbias, const LAS float* bt, int hi) {
    if (tp.lookup || tp.mask) {
        const int dq = tq - tp.pbase - tp.pstride * 4 * hi;
#pragma unroll
        for (int r = 0; r < 16; ++r) {
            const int d0 = dq - tp.pstride * ((r & 3) + 8 * (r >> 2)), d1 = d0 - 32 * tp.pstride;
            const bool v0 = rowsel && d0 >= 0 && d0 <= tp.dmax, v1 = rowsel && d1 >= 0 && d1 <= tp.dmax;
            float b0 = cbias, b1 = cbias;
            if (tp.lookup) { b0 = bt[min(max(d0, 0), 127)]; b1 = bt[min(max(d1, 0), 127)]; }
            p0[r] = v0 ? fmaf(p0[r], C2, b0) : -INFINITY; p1[r] = v1 ? fmaf(p1[r], C2, b1) : -INFINITY;
            if ((r & 3) == 3) __builtin_amdgcn_sched_barrier(0);
        }
    } else {
#pragma unroll
        for (int r = 0; r < 16; ++r) { p0[r] = rowsel ? fmaf(p0[r], C2, cbias) : -INFINITY; p1[r] = rowsel ? fmaf(p1[r], C2, cbias) : -INFINITY; }
    }
}
__device__ __forceinline__ float rowmax32(const f32x16& p0, const f32x16& p1) {
    float a = fmaxf(p0[0], p1[0]), b = fmaxf(p0[1], p1[1]);
#pragma unroll
    for (int r = 2; r < 16; r += 2) { a = fmaxf(a, fmaxf(p0[r], p1[r])); b = fmaxf(b, fmaxf(p0[r + 1], p1[r + 1])); }
    return xhalf_max(fmaxf(a, b));
}
__device__ __forceinline__ void nsa_out(const f32x16 (&o)[4], const LAS float* wsf, int mode, float* MIXF, bf16* MIX, int trow0, int g, int lane) {
    const int le = lane_id(); const int r32e = le & 31, hie = le >> 5;
#pragma unroll
    for (int r = 0; r < 16; ++r) {
        const int q = crow(r, hie); const float sc = wsf[q];
        const size_t off = (size_t)(trow0 + (q >> 2)) * 1024 + (size_t)((4 * g + (q & 3)) * 128 + r32e);
#pragma unroll
        for (int d0 = 0; d0 < 4; ++d0) {
            const float v = o[d0][r] * sc;
            if (mode == 0) MIXF[off + d0 * 32] = v;
            else if (mode == 1) MIXF[off + d0 * 32] = __hip_atomic_load(MIXF + off + d0 * 32, __ATOMIC_RELAXED, __HIP_MEMORY_SCOPE_AGENT) + v;
            else MIX[(size_t)(trow0 + (q >> 2)) * 2048 + 1024 + (4 * g + (q & 3)) * 128 + r32e + d0 * 32] = (bf16)f2bf(__hip_atomic_load(MIXF + off + d0 * 32, __ATOMIC_RELAXED, __HIP_MEMORY_SCOPE_AGENT) + v);
        }
    }
}

template <int probe>
__device__ __forceinline__ void nsa_unit(int i, int g, const bf16* U, const bf16* KC, const bf16* VC, const float* rel_bias, float* MIXF, bf16* MIX, LAS unsigned char* shm, int wid) {
    const unsigned lds0 = (unsigned)(uintptr_t)shm; const lds_cptr shc = (lds_cptr)shm;
    LAS float* wsf = (LAS float*)(shm + L_WSF) + wid * 64; LAS float* btab = (LAS float*)(shm + L_BT); LAS float* imp = (LAS float*)(shm + L_IMP);
    LAS unsigned* selw = (LAS unsigned*)(shm + L_SEL); LAS unsigned* uni = (LAS unsigned*)(shm + L_MISC); LAS unsigned char* blist = (LAS unsigned char*)(shm + L_LIST);
    const int t0 = 64 * i, trow0 = t0 + 8 * wid; const bool g1 = wid >= 4;
    auto nsa_gate = [&](int b) -> float { const int r_ = lane_id() & 31, tq_ = trow0 + (r_ >> 2), hd_ = 4 * g + (r_ & 3);
        return 1.f / (1.f + __expf(-bf1(U[(size_t)tq_ * DINP + O_GN + hd_ * 3 + b]))); };
#define NSA_DERIVE() const int lane = lane_id(); const int r32 = lane & 31, hi = lane >> 5; const int tq = trow0 + (r32 >> 2), hd = r32 & 3, head = 4 * g + hd; \
    const float c31 = rel_bias[31 * 8 + head] * LOG2E; const LAS float* bt = btab + hd * 128; (void)tq; (void)c31; (void)bt; (void)hi
    bf16x8 qf[12];
    f32x16 o[4];
    { const int tid = wid * 64 + lane_id();
      for (int k = tid; k < 8192; k += NTHR) imp[k] = 0.f;
      { const int hh = tid >> 7, d = tid & 127; btab[tid] = rel_bias[t5b(d) * 8 + 4 * g + hh] * LOG2E; }
      if (tid < 4) uni[tid] = 0u; }
    { NSA_DERIVE();
      const bf16* qp = U + (size_t)tq * DINP + O_QN + head * 192 + hi * 8;
#pragma unroll
      for (int ks = 0; ks < 12; ++ks) qf[ks] = *(const bf16x8*)(qp + ks * 16); }
    const int nct = (4 * i + 3 + 63) >> 6;
    const bf16* kc0 = KC + g * 256; const bf16* vc0 = VC + g * 256;
    float m = 0.f, inv_lc = 0.f;
    ATT_WAIT_BAR();
    { NSA_DERIVE();
      float l = 0.f;
      tile_stream<3, 0>(nct, g1,
        [&](int ct, int sl) { if (probe & 1) return; stage_k(kc0 + (size_t)(64 * ct) * 512, 512, lds0 + L_K + sl * KSLOT, wid); },
        [&](int ct, int sl) {},
        [&](int ct, int sl, f32x16& p0, f32x16& p1) {
            if (probe & 2) return;
            qk_tile<12>(p0, p1, shc + L_K + sl * KSLOT, qf, r32, hi);
            const TileP tp{16 * 64 * ct + 31, 16, 1 << 30, ct >= nct - 2, true};
            logits(p0, p1, tq, true, tp, c31, bt, hi); },
        [&](int ct, int sl, f32x16& p0, f32x16& p1) {
            if (probe & 2) return;
            const float rm = rowmax32(p0, p1);
            if (ct == 0) m = rm > -1e30f ? rm : 0.f;
            else { const float nm = fmaxf(m, rm); l *= __builtin_amdgcn_exp2f(m - nm); m = nm; }
            float s = 0.f;
#pragma unroll
            for (int r = 0; r < 16; ++r) s += __builtin_amdgcn_exp2f(p0[r] - m) + __builtin_amdgcn_exp2f(p1[r] - m);
            l += s; });
      const float lc = xhalf_sum(l); inv_lc = lc > 0.f ? 1.f / lc : 0.f; }
    { NSA_DERIVE();
      o[0] = f32x16{}; o[1] = f32x16{}; o[2] = f32x16{}; o[3] = f32x16{};
      tile_stream<3, 2>(nct, g1,
        [&](int ct, int sl) { if (probe & 1) return; stage_k(kc0 + (size_t)(64 * ct) * 512, 512, lds0 + L_K + sl * KSLOT, wid); },
        [&](int ct, int sl) { if (probe & 1) return; stage_v(vc0 + (size_t)(64 * ct) * 512, 512, lds0 + L_V + sl * VSLOT, wid); },
        [&](int ct, int sl, f32x16& p0, f32x16& p1) {
            if (probe & 2) return;
            qk_tile<12>(p0, p1, shc + L_K + sl * KSLOT, qf, r32, hi);
            const TileP tp{16 * 64 * ct + 31, 16, 1 << 30, ct >= nct - 2, true};
            logits(p0, p1, tq, true, tp, c31, bt, hi); },
        [&](int ct, int sl, f32x16& p0, f32x16& p1) {
            if (probe & 2) return;
#pragma unroll
            for (int r = 0; r < 16; ++r) { p0[r] = __builtin_amdgcn_exp2f(p0[r] - m) * inv_lc; p1[r] = __builtin_amdgcn_exp2f(p1[r] - m) * inv_lc; }
            LAS float* iq = imp + (8 * wid + (r32 >> 2)) * 128 + 16 * ct + hi;
#pragma unroll
            for (int a = 0; a < 4; ++a) {
#pragma unroll
                for (int kh = 0; kh < 2; ++kh) {
                    const f32x16& pp = kh ? p1 : p0;
                    float s3 = pp[4 * a + 3], s4 = (pp[4 * a] + pp[4 * a + 1]) + (pp[4 * a + 2] + s3);
                    s4 += dpp_xor1(s4); s4 += dpp_xor2(s4); s3 += dpp_xor1(s3); s3 += dpp_xor2(s3);
                    const int jj = 8 * kh + 2 * a;
                    if (hd == 0) { __hip_atomic_fetch_add(iq + jj, s4, __ATOMIC_RELAXED, __HIP_MEMORY_SCOPE_WORKGROUP);
                        if (16 * ct + hi + jj + 1 < 128) __hip_atomic_fetch_add(iq + jj + 1, s3, __ATOMIC_RELAXED, __HIP_MEMORY_SCOPE_WORKGROUP); }
                }
            }
            pv_tile(o, p0, p1, shc + L_V + sl * VSLOT, lane, hi); });
      if (hi == 0) wsf[r32] = nsa_gate(0);
      LDS_WAIT();
      nsa_out(o, wsf, 0, MIXF, MIX, trow0, g, lane); }
    unsigned long long wm_lo = 0ull, wm_hi = 0ull;
    {
        const int lane = lane_id();
        const unsigned long long all_lo = (i >= 63) ? ~0ull : ((1ull << (i + 1)) - 1ull), all_hi = (i >= 64) ? ((i >= 127) ? ~0ull : ((1ull << (i - 63)) - 1ull)) : 0ull;
        for (int ql = 0; ql < 8; ++ql) {
            unsigned long long s_lo = all_lo, s_hi = all_hi;
            if (i >= 16) {
                const LAS float* iq = imp + (8 * wid + ql) * 128;
                const int j0 = lane, j1 = lane + 64;
                const unsigned b0 = (j0 >= 1 && j0 <= i - 2) ? __float_as_uint(iq[j0]) + 1u : 0u;
                const unsigned b1 = (j1 <= i - 2) ? __float_as_uint(iq[j1]) + 1u : 0u;
                unsigned T = 0u;
                for (int bit = 30; bit >= 0; --bit) {
                    const unsigned c = T | (1u << bit);
                    const int cnt = __popcll(__ballot(b0 >= c)) + __popcll(__ballot(b1 >= c));
                    if (cnt >= 13) T = c;
                }
                const unsigned long long gt0 = __ballot(b0 > T), gt1 = __ballot(b1 > T), eq0 = __ballot(b0 == T), eq1 = __ballot(b1 == T);
                int rem = 13 - (__popcll(gt0) + __popcll(gt1));
                unsigned long long e0 = eq0, e1 = eq1, k0 = 0ull, k1 = 0ull;
                while (rem > 0 && e0) { const unsigned long long low = e0 & (~e0 + 1ull); k0 |= low; e0 ^= low; --rem; }
                while (rem > 0 && e1) { const unsigned long long low = e1 & (~e1 + 1ull); k1 |= low; e1 ^= low; --rem; }
                s_lo = gt0 | k0 | 1ull; s_hi = gt1 | k1;
                if (i < 64) s_lo |= (1ull << i) | (1ull << (i - 1));
                else { s_hi |= (1ull << (i - 64)); if (i == 64) s_lo |= (1ull << 63); else s_hi |= (1ull << (i - 65)); }
            }
            if (lane == 0) { LAS unsigned* sp = selw + (8 * wid + ql) * 4; sp[0] = (unsigned)s_lo; sp[1] = (unsigned)(s_lo >> 32); sp[2] = (unsigned)s_hi; sp[3] = (unsigned)(s_hi >> 32); }
            wm_lo |= s_lo; wm_hi |= s_hi;
        }
        if (lane == 0) { __hip_atomic_fetch_or(uni + 0, (unsigned)wm_lo, __ATOMIC_RELAXED, __HIP_MEMORY_SCOPE_WORKGROUP); __hip_atomic_fetch_or(uni + 1, (unsigned)(wm_lo >> 32), __ATOMIC_RELAXED, __HIP_MEMORY_SCOPE_WORKGROUP);
                         __hip_atomic_fetch_or(uni + 2, (unsigned)wm_hi, __ATOMIC_RELAXED, __HIP_MEMORY_SCOPE_WORKGROUP); __hip_atomic_fetch_or(uni + 3, (unsigned)(wm_hi >> 32), __ATOMIC_RELAXED, __HIP_MEMORY_SCOPE_WORKGROUP); }
    }
    ATT_WAIT_BAR();
    if (wid == 0 && lane_id() == 0) {
        int n = 0;
        for (int w4 = 0; w4 < 4; ++w4) { unsigned mk = uni[w4]; while (mk) { const int b = __builtin_ctz(mk); mk &= mk - 1u; blist[n++] = (unsigned char)(32 * w4 + b); } }
        uni[4] = (unsigned)n;
    }
    ATT_WAIT_BAR();
    {
        NSA_DERIVE();
        const int nsl = __builtin_amdgcn_readfirstlane((int)uni[4]);
        const LAS unsigned* sp = selw + (8 * wid + (r32 >> 2)) * 4;
        const bf16* ks0 = U + O_KN + 384 + g * 192; const bf16* vs0 = U + O_VN + 256 + g * 128;
        Soft st; st.mhat = 0.f; st.l = 0.f;
        o[0] = f32x16{}; o[1] = f32x16{}; o[2] = f32x16{}; o[3] = f32x16{};
        auto blk = [&](int t) -> int { return __builtin_amdgcn_readfirstlane((int)blist[t]); };
        auto wsel = [&](int j) -> bool { return j < 64 ? ((wm_lo >> j) & 1ull) : ((wm_hi >> (j - 64)) & 1ull); };
        tile_stream<3, 2>(nsl, g1,
            [&](int t, int sl) { if (probe & 1) return; const int j = blk(t); stage_k(ks0 + (size_t)(64 * j) * DINP, DINP, lds0 + L_K + sl * KSLOT, wid); },
            [&](int t, int sl) { if (probe & 1) return; const int j = blk(t); stage_v(vs0 + (size_t)(64 * j) * DINP, DINP, lds0 + L_V + sl * VSLOT, wid); },
            [&](int t, int sl, f32x16& p0, f32x16& p1) {
            if (probe & 2) return;
                const int j = blk(t); if (!wsel(j)) return;
                qk_tile<12>(p0, p1, shc + L_K + sl * KSLOT, qf, r32, hi);
                const bool rowsel = (sp[j >> 5] >> (j & 31)) & 1u;
                if (j >= i - 2) { const TileP tp{64 * j, 1, 1 << 30, true, j == i}; logits(p0, p1, tq, rowsel, tp, c31, bt, hi); }
                else if (!__all(rowsel)) {
#pragma unroll
                    for (int r = 0; r < 16; ++r) { p0[r] = rowsel ? p0[r] : -INFINITY; p1[r] = rowsel ? p1[r] : -INFINITY; } } },
            [&](int t, int sl, f32x16& p0, f32x16& p1) {
            if (probe & 2) return;
                const int j = blk(t); if (!wsel(j)) return;
                if (j >= i - 2) softmax_tile<true>(p0, p1, st, o, t == 0, wsf, r32, hi);
                else softmax_tile<false>(p0, p1, st, o, t == 0, wsf, r32, hi, c31);
                pv_tile(o, p0, p1, shc + L_V + sl * VSLOT, lane, hi); });
        const float ls = xhalf_sum(st.l);
        if (hi == 0) wsf[r32] = ls > 0.f ? nsa_gate(1) / ls : 0.f;
        LDS_WAIT();
        nsa_out(o, wsf, 1, MIXF, MIX, trow0, g, lane);
    }
    {
        NSA_DERIVE();
        const bf16* kw0 = U + O_KN + 768 + g * 192; const bf16* vw0 = U + O_VN + 512 + g * 128;
        Soft st; st.mhat = 0.f; st.l = 0.f;
        o[0] = f32x16{}; o[1] = f32x16{}; o[2] = f32x16{}; o[3] = f32x16{};
        const int nw = (i >= 8 ? 8 : i) + 1;
        tile_stream<3, 2>(nw, g1,
            [&](int t, int sl) { if (probe & 1) return; stage_k(kw0 + (size_t)(64 * (i - t)) * DINP, DINP, lds0 + L_K + sl * KSLOT, wid); },
            [&](int t, int sl) { if (probe & 1) return; stage_v(vw0 + (size_t)(64 * (i - t)) * DINP, DINP, lds0 + L_V + sl * VSLOT, wid); },
            [&](int t, int sl, f32x16& p0, f32x16& p1) {
            if (probe & 2) return;
                qk_tile<12>(p0, p1, shc + L_K + sl * KSLOT, qf, r32, hi);
                if (t <= 2 || t == 8) { const TileP tp{64 * (i - t), 1, 511, t <= 2, t == 0 || t == 8}; logits(p0, p1, tq, true, tp, c31, bt, hi); } },
            [&](int t, int sl, f32x16& p0, f32x16& p1) {
            if (probe & 2) return;
                if (t <= 2 || t == 8) softmax_tile<true>(p0, p1, st, o, t == 0, wsf, r32, hi);
                else softmax_tile<false>(p0, p1, st, o, false, wsf, r32, hi, c31);
                pv_tile(o, p0, p1, shc + L_V + sl * VSLOT, lane, hi); });
        const float lw = xhalf_sum(st.l);
        if (hi == 0) wsf[r32] = lw > 0.f ? nsa_gate(2) / lw : 0.f;
        LDS_WAIT();
        nsa_out(o, wsf, 2, MIXF, MIX, trow0, g, lane);
    }
    ATT_WAIT_BAR();
#undef NSA_DERIVE
}
}

__device__ __forceinline__ int att_lane_id() { int l; asm volatile("v_mbcnt_lo_u32_b32 %0, -1, 0\n\tv_mbcnt_hi_u32_b32 %0, -1, %0" : "=v"(l)); return l; }
struct Args { const float* in[27]; float* out; unsigned char* ws; int ph_lo, ph_hi, nbar, pad; };
constexpr int NPHASE = 16;
#ifndef PG8_SP2
#define PG8_SP2 true
#endif
#ifndef PG8_ALIGN
#define PG8_ALIGN true
#endif
#ifndef PROBE_MODE
#define PROBE_MODE 0
#endif
#ifndef REP0
#define REP0 1
#endif
#ifndef REP2
#define REP2 1
#endif
#ifndef REP3
#define REP3 1
#endif
#ifndef REP10
#define REP10 1
#endif
__global__ void __launch_bounds__(NTHR, 2) mega(Args args) {
    extern __shared__ __attribute__((aligned(16))) unsigned char lds[];
    Ctx F;
    F.lds = (LAS unsigned char*)lds;
    F.wave = __builtin_amdgcn_readfirstlane((int)threadIdx.x >> 6);
#define REFRESH_CTX() do { const int l_ = att_lane_id(); F.lane = l_; F.tid = F.wave * 64 + l_; } while (0)
    REFRESH_CTX();
    F.G = gridDim.x; { const int bx = blockIdx.x; F.vcu = (F.G % 8 == 0) ? (bx % 8) * (F.G / 8) + bx / 8 : bx; }
    unsigned char* ws = args.ws;
    volatile LAS unsigned* MISC = (volatile LAS unsigned*)(F.lds + MISC_OFF);
    for (int u = F.tid; u < (LDS_BYTES - LDSCTL_OFF) / 4; u += NTHR) ((LAS unsigned*)(F.lds + LDSCTL_OFF))[u] = 0u;
    __syncthreads();
    XcdBarrier bar; bar.w0 = 0; bar.bar = (unsigned*)(ws + WS_CTL) + 4096; bar.x = 0; bar.st = nullptr;
    const int lo = args.ph_lo, hi = args.ph_hi;
    if (hi - lo > 1) bar = xcd_barrier_post((unsigned*)(ws + WS_CTL) + 4096 + args.nbar * XCD_BAR_WORDS, MISC + 8, F.wave == 0 ? 1 : 0);
#define IN(k) (lo <= (k) && (k) < hi)
#define SEAM(k) do { if (IN(k) && IN((k) + 1)) xcd_barrier(bar); } while (0)
    const P0Args pa{args.in[5], args.in[6], args.in[7], args.in[9], args.in[11], args.in[13], args.in[15], args.in[16], args.in[18], args.in[19], args.in[21], args.in[23], args.in[24], args.in[25], args.in[1], args.in[2], ws};
    LAS float* gwt = (LAS float*)(F.lds); LAS float* sht = (LAS float*)(F.lds + 8192);
    const float* x = args.in[0];
    float* X1 = (float*)(ws + WS_X1);
    const float* MOD = (const float*)(ws + WS_MOD);
    bf16* H = (bf16*)(ws + WS_H); bf16* ACT = (bf16*)(ws + WS_ACT);

    for (int rep = 0; rep < REP0; ++rep) { if (rep) xcd_barrier(bar);
    if (IN(0)) { REFRESH_CTX();
        p0_prologue(F, pa);
        if (blockIdx.x == 0) {
            LAS int* cst = (LAS int*)(F.lds + 65536);
            __syncthreads();
            { const int me = F.tid; cst[me] = me < 256 ? 400 * ((me >> 3) + 1) : 65 * (((me - 256) >> 1) + 1) + 2200; }
            __syncthreads();
            { const int me = F.tid, cm = cst[me]; int rank = 0;
              for (int k2 = 0; k2 < 512; ++k2) { const int ck = cst[k2]; rank += (ck > cm || (ck == cm && k2 < me)) ? 1 : 0; }
              ((unsigned*)(ws + WS_CTL) + 8192)[rank] = (unsigned)me; }
        }
    }
    }
    SEAM(0);
    if (IN(1)) { REFRESH_CTX(); build_mod_tables(F, ws, args.in[4], args.in[3], 0, true, gwt, sht); norm_rows_bf16(F, x, H, gwt, sht); __syncthreads(); }
    SEAM(1);
    for (int rep = 0; rep < REP2; ++rep) { if (rep) xcd_barrier(bar);
    if (IN(2)) { REFRESH_CTX(); pg8::Gemm g{H, (const bf16*)(ws + WS_WGU1), S_, 2 * FF_, D_, D_, D_}; pg8::StaticOrder S; S.init(S_, 2 * FF_, F.G, (int)blockIdx.x);
        pg8::EpiSwiglu E{ACT, FF_}; pg8::gemm_phase<pg8::EpiSwiglu, pg8::StaticOrder, PG8_ALIGN, PG8_SP2>(F.lds, g, S, E, F.wave);
        if (rep == 0) { REFRESH_CTX(); conv_tail(F, pa, 1, NIT_B, (S_ / 256) * (2 * FF_ / 256)); } }
    }
    SEAM(2);
    for (int rep = 0; rep < REP3; ++rep) { if (rep) xcd_barrier(bar);
    if (IN(3)) { REFRESH_CTX(); pg8::Gemm g{ACT, (const bf16*)(ws + WS_WD1), S_, D_, FF_, FF_, FF_}; pg8::StaticOrder S; S.init(S_, D_, F.G, (int)blockIdx.x);
        pg8::EpiResid E{x, X1, D_, MOD + 2 * D_, 0.5f}; pg8::gemm_phase<pg8::EpiResid, pg8::StaticOrder, PG8_ALIGN, PG8_SP2>(F.lds, g, S, E, F.wave); }
    }
    SEAM(3);
    if (IN(4)) { REFRESH_CTX(); build_mod_tables(F, ws, args.in[8], args.in[3], 3, false, gwt, sht); norm_rows_bf16(F, X1, H, gwt, sht); __syncthreads(); }
    SEAM(4);
    if (IN(5)) { REFRESH_CTX(); pg8::Gemm g{H, (const bf16*)(ws + WS_WIN), S_, DINP, D_, D_, D_}; pg8::StaticOrder S; S.init(S_, DINP, F.G, (int)blockIdx.x);
        pg8::EpiStore E{ACT, DINP}; pg8::gemm_phase<pg8::EpiStore, pg8::StaticOrder, PG8_ALIGN, PG8_SP2>(F.lds, g, S, E, F.wave);
        REFRESH_CTX(); conv_tail(F, pa, 2, NIT_C, (S_ / 256) * (DINP / 256)); }
    SEAM(5);
    if (IN(6)) { REFRESH_CTX(); p6_prep(F, ws, args.in[10], args.in[12], args.in[14], args.in[17]); }
    SEAM(6);
    if (IN(7)) { REFRESH_CTX();
        const int c = (int)blockIdx.x, G = F.G;
        { pg8::Gemm g{(const bf16*)(ws + WS_CQN), (const bf16*)(ws + WS_WUQ), S_, 1536, 768, 768, 768}; pg8::StaticOrder S; S.init(S_, 1536, G, c);
          pg8::EpiStore E{(bf16*)(ws + WS_Q), 1536}; pg8::gemm_phase<pg8::EpiStore, pg8::StaticOrder, PG8_ALIGN, PG8_SP2>(F.lds, g, S, E, F.wave); }
        { pg8::Gemm g{(const bf16*)(ws + WS_CKVN), (const bf16*)(ws + WS_WUKV), S_, 2048, 512, 512, 512}; pg8::StaticOrder S; S.init(S_, 2048, G, c);
          pg8::EpiStore E{(bf16*)(ws + WS_KV), 2048}; pg8::gemm_phase<pg8::EpiStore, pg8::StaticOrder, PG8_ALIGN, PG8_SP2>(F.lds, g, S, E, F.wave); }
        { pg8::Gemm g{(const bf16*)(ws + WS_FLATK), (const bf16*)(ws + WS_WCK1), 1024, 256, KCH_K, 6144, 6144}; pg8::StaticOrder S; S.init_units(4, NCH_K, G, (c + G - 192 % G) % G);
          pg8::EpiPart E{(float*)(ws + WS_PARTK), 1024}; pg8::gemm_phase<pg8::EpiPart, pg8::StaticOrder, false, PG8_SP2, true>(F.lds, g, S, E, F.wave); }
        { pg8::Gemm g{(const bf16*)(ws + WS_FLATV), (const bf16*)(ws + WS_WCV1), 1024, 256, KCH_V, 4096, 4096}; pg8::StaticOrder S; S.init_units(4, NCH_V, G, (c + G - 240 % G) % G);
          pg8::EpiPart E{(float*)(ws + WS_PARTV), 1024}; pg8::gemm_phase<pg8::EpiPart, pg8::StaticOrder, false, PG8_SP2, true>(F.lds, g, S, E, F.wave); }
    }
    SEAM(7);
    if (IN(8)) { REFRESH_CTX(); p8_prep2(F, ws); }
    SEAM(8);
    if (IN(9)) { REFRESH_CTX();
        const int c = (int)blockIdx.x, G = F.G;
        { pg8::Gemm g{(const bf16*)(ws + WS_HIDK), (const bf16*)(ws + WS_WCK2), 1024, 256, 256, 256, 256}; pg8::StaticOrder S; S.init(1024, 256, G, c);
          pg8::EpiStore E{(bf16*)(ws + WS_KC), 256}; pg8::gemm_phase<pg8::EpiStore, pg8::StaticOrder, false, PG8_SP2>(F.lds, g, S, E, F.wave); }
        { pg8::Gemm g{(const bf16*)(ws + WS_HIDV), (const bf16*)(ws + WS_WCV2), 1024, 256, 256, 256, 256}; pg8::StaticOrder S; S.init(1024, 256, G, (c + G - 8 % G) % G);
          pg8::EpiStore E{(bf16*)(ws + WS_VC), 256}; pg8::gemm_phase<pg8::EpiStore, pg8::StaticOrder, false, PG8_SP2>(F.lds, g, S, E, F.wave); }
    }
    SEAM(9);
    for (int rep = 0; rep < REP10; ++rep) { if (rep) xcd_barrier(bar);
    if (IN(10)) { REFRESH_CTX();
        gu32* ctr = (gu32*)(ws + WS_CTL) + 2048 + 64 * rep; const unsigned* order = (const unsigned*)(ws + WS_CTL) + 8192;
        for (;;) {
            int moff = MISC_OFF + 64; asm volatile("" : "+s"(moff));
            volatile LAS unsigned* mq = (volatile LAS unsigned*)(F.lds + moff);
            if (att::lane_id() == 0 && F.wave == 0) mq[0] = __hip_atomic_fetch_add(ctr, 1u, RLX_AGENT);
            __syncthreads(); const int n = __builtin_amdgcn_readfirstlane((int)mq[0]); __syncthreads();
            if (n >= 512) {
                if (rep == 0) { gu32* cc = (gu32*)(ws + WS_CTL) + 3072; LAS float* scr = (LAS float*)(F.lds + F.wave * 16384);
                    for (;;) { int it = 0; if (att::lane_id() == 0) it = (int)__hip_atomic_fetch_add(cc, 4u, RLX_AGENT); it = __builtin_amdgcn_readfirstlane(it); if (it >= NIT_D) break;
                        conv_run(3, it, 1, it + 4 < NIT_D ? it + 4 : NIT_D, pa, scr, att::lane_id()); } }
                break; }
            const int id = __builtin_amdgcn_readfirstlane((int)order[n]);
#ifdef PROBE_MLA_ONLY
            if (rep > 0 && id >= 256) continue;
#endif
#ifdef PROBE_NSA_ONLY
            if (rep > 0 && id < 256) continue;
#endif
            if (rep == 0 && PROBE_MODE != 0) {
                if (id < 256) att::mla_unit<PROBE_MODE>(id & 7, id >> 3, (const bf16*)(ws + WS_Q), (const bf16*)(ws + WS_KV), (const bf16*)(ws + WS_KR), H, F.lds, F.wave);
                else att::nsa_unit<PROBE_MODE>((id - 256) >> 1, (id - 256) & 1, (const bf16*)(ws + WS_ACT), (const bf16*)(ws + WS_KC), (const bf16*)(ws + WS_VC), args.in[20], (float*)(ws + WS_MIXF), H, F.lds, F.wave);
            } else {
                if (id < 256) att::mla_unit<0>(id & 7, id >> 3, (const bf16*)(ws + WS_Q), (const bf16*)(ws + WS_KV), (const bf16*)(ws + WS_KR), H, F.lds, F.wave);
                else att::nsa_unit<0>((id - 256) >> 1, (id - 256) & 1, (const bf16*)(ws + WS_ACT), (const bf16*)(ws + WS_KC), (const bf16*)(ws + WS_VC), args.in[20], (float*)(ws + WS_MIXF), H, F.lds, F.wave);
            }
        }
    }
    }
    SEAM(10);
    if (IN(11)) { REFRESH_CTX(); pg8::Gemm g{H, (const bf16*)(ws + WS_WOUT), S_, D_, D_, D_, D_}; pg8::StaticOrder S; S.init(S_, D_, F.G, (int)blockIdx.x);
        pg8::EpiResid E{X1, X1, D_, MOD + 5 * D_, 1.0f}; pg8::gemm_phase<pg8::EpiResid, pg8::StaticOrder, PG8_ALIGN, PG8_SP2>(F.lds, g, S, E, F.wave); }
    SEAM(11);
    if (IN(12)) { REFRESH_CTX(); build_mod_tables(F, ws, args.in[22], args.in[3], 6, false, gwt, sht); norm_rows_bf16(F, X1, H, gwt, sht); __syncthreads(); }
    SEAM(12);
    if (IN(13)) { REFRESH_CTX(); pg8::Gemm g{H, (const bf16*)(ws + WS_WGU2), S_, 2 * FF_, D_, D_, D_}; pg8::StaticOrder S; S.init(S_, 2 * FF_, F.G, (int)blockIdx.x);
        pg8::EpiSwiglu E{ACT, FF_}; pg8::gemm_phase<pg8::EpiSwiglu, pg8::StaticOrder, PG8_ALIGN, PG8_SP2>(F.lds, g, S, E, F.wave); }
    SEAM(13);
    if (IN(14)) { REFRESH_CTX(); pg8::Gemm g{ACT, (const bf16*)(ws + WS_WD2), S_, D_, FF_, FF_, FF_}; pg8::StaticOrder S; S.init(S_, D_, F.G, (int)blockIdx.x);
        pg8::EpiResid E{X1, args.out, D_, MOD + 8 * D_, 0.5f}; pg8::gemm_phase<pg8::EpiResid, pg8::StaticOrder, PG8_ALIGN, PG8_SP2>(F.lds, g, S, E, F.wave); }
    SEAM(14);
    if (IN(15)) { REFRESH_CTX(); final_norm(F, args.out, args.in[26]); }
#undef IN
#undef SEAM
}

extern "C" void kernel_launch(void* const* d_in, const int* in_sizes, int n_in, void* d_out, int out_size, void* d_ws, size_t ws_size, hipStream_t stream) {
    static int grid = 0;
    if (grid == 0) {
        if (n_in != 27 || out_size != S_ * D_ || ws_size < WS_END) { fprintf(stderr, "kernel_launch: unexpected shapes (n_in %d out %d ws %zu)\n", n_in, out_size, ws_size); grid = -1; return; }
        int dev = 0, cus = 0;
        if (hipGetDevice(&dev) != hipSuccess || hipDeviceGetAttribute(&cus, hipDeviceAttributeMultiprocessorCount, dev) != hipSuccess) { grid = -1; return; }
        if (hipFuncSetAttribute((const void*)mega, hipFuncAttributeMaxDynamicSharedMemorySize, LDS_BYTES) != hipSuccess) { fprintf(stderr, "hipFuncSetAttribute failed\n"); grid = -1; return; }
        grid = cus;
    }
    if (grid < 0) return;
    (void)hipMemsetAsync((char*)d_ws + WS_CTL, 0, 1 * MiB, stream);
    Args a{};
    for (int i = 0; i < 27; ++i) a.in[i] = (const float*)d_in[i];
    a.out = (float*)d_out; a.ws = (unsigned char*)d_ws;
    unsigned char* ws = (unsigned char*)d_ws;
    auto run = [&](int lo, int hi, int nbar) { a.ph_lo = lo; a.ph_hi = hi; a.nbar = nbar; hipLaunchKernelGGL(mega, dim3(grid), dim3(NTHR), LDS_BYTES, stream, a); };
    run(0, 16, 0);
}
```

```cpp
#include <hip/hip_runtime.h>
#include <cstdio>
#include <cstdint>
#include <cmath>
namespace pg8 {
#define PG8_LAS __attribute__((address_space(3)))
typedef unsigned short bf16_t;
typedef short bf16x8 __attribute__((ext_vector_type(8)));
typedef float f32x4 __attribute__((ext_vector_type(4)));
typedef unsigned u32x4 __attribute__((ext_vector_type(4)));
constexpr int BM = 256, BK = 64, HALF = 128, HTB = HALF * BK * 2  , STAGE_BYTES = 8 * HTB, NXCD = 8, WGM = 8;

__host__ __device__ __forceinline__ int lds_byte(int r, int c) { const int st = (r >> 4) * 2 + (c >> 5), rr = r & 15, cc = c & 31, ob = rr * 64 + cc * 2; return st * 1024 + (ob ^ (((ob >> 9) & 1) << 5)); }
__host__ __device__ __forceinline__ void stage_rc(int b, int& R, int& C) { const int st = b / 1024, sb = b % 1024, swz = sb ^ (((sb >> 9) & 1) << 5); R = (st >> 1) * 16 + swz / 64; C = (st & 1) * 32 + (swz % 64) / 2; }
__host__ __device__ __forceinline__ int perm32(int rho) { const int n = rho >> 4, i = rho & 15; return 8 * (i >> 2) + 4 * n + (i & 3); }

struct Unit { int pm, pn, mh; };
struct Gemm { const bf16_t* A; const bf16_t* Bt; int M, N, K, lda, ldb; };

struct StaticOrder {
    int nM, nN, nwg, G, c;
    __host__ __device__ void init(int M, int N, int G_, int c_) { nM = M / BM; nN = N / BM; nwg = nM * nN; G = G_; c = c_; }
    __host__ __device__ void init_units(int nM_, int nN_, int G_, int c_) { nM = nM_; nN = nN_; nwg = nM * nN; G = G_; c = c_; }
    int r0 = 0, r1 = 1 << 30, half = 0;
    __host__ __device__ bool next(int i, Unit& u) const {
        if (r0 + i >= r1) return false;
        const long L = (long)(r0 + i) * G + (half ? (c >> 1) : c); if (L >= nwg) return false;
        u.mh = half ? (c & 1) : -1;
        int wgid = (int)L; { const int q = nwg / NXCD, r = nwg % NXCD, xcd = wgid % NXCD, off = wgid / NXCD; wgid = (xcd < r ? xcd * (q + 1) : r * (q + 1) + (xcd - r) * q) + off; }
        const int nig = WGM * nN, gid = wgid / nig, fm = gid * WGM, gsz = (nM - fm) < WGM ? (nM - fm) : WGM;
        u.pm = fm + ((wgid % nig) % gsz); u.pn = (wgid % nig) / gsz; return true;
    }
    __device__ __forceinline__ void a_ready(const Unit&) const {}
    __device__ __forceinline__ void done(const Unit&) const {}
};
__device__ __forceinline__ unsigned cvt_pk_bf16(float lo, float hi) { unsigned r; asm volatile("v_cvt_pk_bf16_f32 %0, %1, %2" : "=v"(r) : "v"(lo), "v"(hi)); return r; }
typedef unsigned u32x4 __attribute__((ext_vector_type(4)));
__device__ __forceinline__ float silu_f(float v) { return v * __builtin_amdgcn_rcpf(1.0f + __builtin_amdgcn_exp2f(-1.4426950408889634f * v)); }
struct EpiSwiglu {
    static constexpr bool PERM = true, AFTER_DRAIN = false;
    bf16_t* O; int ldc;
    __device__ __forceinline__ void operator()(const f32x4 (&acc)[2][2][4][2], const Unit& u, int wr, int wc, int fr, int fq) const {
        const int row0 = u.pm * BM + wr * 64 + fr + (u.mh > 0 ? HALF : 0), col0 = u.pn * 128 + wc * 32 + 8 * fq;
#pragma unroll
        for (int ai = 0; ai < 2; ++ai)
#pragma unroll
            for (int m = 0; m < 4; ++m) {
                if (ai == 1 && u.mh >= 0) continue;
                bf16_t* rowp = O + (size_t)(row0 + ai * HALF + m * 16) * ldc + col0;
                const f32x4 g0 = acc[ai][0][m][0], g1 = acc[ai][0][m][1], u0 = acc[ai][1][m][0], u1 = acc[ai][1][m][1];
                u32x4 w;
                w.x = cvt_pk_bf16(silu_f(g0[0]) * u0[0], silu_f(g0[1]) * u0[1]); w.y = cvt_pk_bf16(silu_f(g0[2]) * u0[2], silu_f(g0[3]) * u0[3]);
                w.z = cvt_pk_bf16(silu_f(g1[0]) * u1[0], silu_f(g1[1]) * u1[1]); w.w = cvt_pk_bf16(silu_f(g1[2]) * u1[2], silu_f(g1[3]) * u1[3]);
                *(u32x4*)rowp = w;
            }
    }
};
struct EpiStore {
    static constexpr bool PERM = true, AFTER_DRAIN = false;
    bf16_t* O; int ldc;
    __device__ __forceinline__ void operator()(const f32x4 (&acc)[2][2][4][2], const Unit& u, int wr, int wc, int fr, int fq) const {
        const int row0 = u.pm * BM + wr * 64 + fr, col0 = u.pn * BM + wc * 32 + 8 * fq;
#pragma unroll
        for (int ai = 0; ai < 2; ++ai)
#pragma unroll
            for (int m = 0; m < 4; ++m) {
                bf16_t* rowp = O + (size_t)(row0 + ai * HALF + m * 16) * ldc + col0;
#pragma unroll
                for (int bj = 0; bj < 2; ++bj) {
                    const f32x4 v0 = acc[ai][bj][m][0], v1 = acc[ai][bj][m][1];
                    u32x4 w; w.x = cvt_pk_bf16(v0[0], v0[1]); w.y = cvt_pk_bf16(v0[2], v0[3]); w.z = cvt_pk_bf16(v1[0], v1[1]); w.w = cvt_pk_bf16(v1[2], v1[3]);
                    *(u32x4*)(rowp + bj * HALF) = w;
                }
            }
    }
};
struct EpiResid {
    static constexpr bool PERM = false, AFTER_DRAIN = false;
    const float* base; float* out; int ldc; const float* gv; float coef;
    __device__ __forceinline__ void operator()(const f32x4 (&acc)[2][2][4][2], const Unit& u, int wr, int wc, int fr, int fq) const {
        const int col0 = u.pn * BM + wc * 32 + 4 * fq;
        f32x4 gg[2][2];
#pragma unroll
        for (int bj = 0; bj < 2; ++bj)
#pragma unroll
            for (int n = 0; n < 2; ++n) gg[bj][n] = *(const f32x4*)(gv + col0 + bj * HALF + n * 16) * coef;
#pragma unroll
        for (int ai = 0; ai < 2; ++ai) {
            f32x4 bs[4][2][2];
#pragma unroll
            for (int m = 0; m < 4; ++m) { const size_t off = (size_t)(u.pm * BM + ai * HALF + wr * 64 + m * 16 + fr) * ldc + col0;
#pragma unroll
                for (int bj = 0; bj < 2; ++bj)
#pragma unroll
                    for (int n = 0; n < 2; ++n) bs[m][bj][n] = *(const f32x4*)(base + off + bj * HALF + n * 16); }
            asm volatile("" ::: "memory");
#pragma unroll
            for (int m = 0; m < 4; ++m) { const size_t off = (size_t)(u.pm * BM + ai * HALF + wr * 64 + m * 16 + fr) * ldc + col0;
#pragma unroll
                for (int bj = 0; bj < 2; ++bj)
#pragma unroll
                    for (int n = 0; n < 2; ++n) *(f32x4*)(out + off + bj * HALF + n * 16) = bs[m][bj][n] + gg[bj][n] * acc[ai][bj][m][n]; }
            asm volatile("" ::: "memory");
        }
    }
};
struct EpiPart {
    static constexpr bool PERM = false, AFTER_DRAIN = false;
    float* P; int rows;
    __device__ __forceinline__ void operator()(const f32x4 (&acc)[2][2][4][2], const Unit& u, int wr, int wc, int fr, int fq) const {
        const int col0 = wc * 32 + 4 * fq;
#pragma unroll
        for (int ai = 0; ai < 2; ++ai)
#pragma unroll
            for (int m = 0; m < 4; ++m) {
                float* rowp = P + ((size_t)u.pn * rows + (u.pm * BM + ai * HALF + wr * 64 + m * 16 + fr)) * 256 + col0;
#pragma unroll
                for (int bj = 0; bj < 2; ++bj)
#pragma unroll
                    for (int n = 0; n < 2; ++n) *(f32x4*)(rowp + bj * HALF + n * 16) = acc[ai][bj][m][n];
            }
    }
};
template <int FINAL>
struct EpiResidNorm {
    static constexpr bool PERM = false, AFTER_DRAIN = true; static constexpr int ldc = 2048;
    const float* base; float* xout; bf16_t* hout; const float* gv;
    const float* gw;
    float* xbuf; unsigned* cnt;
    __device__ __forceinline__ void fused(f32x4 (&acc)[2][2][4][2], const Unit& u, int wr, int wc, int fr, int fq, PG8_LAS unsigned char* lds, int wid, int lane) const {
        const float* const base = this->base; float* const xout = this->xout; bf16_t* const hout = this->hout; const float* const gv = this->gv;
        const float* const gw = this->gw; const float* const sh = gw + 2048; float* const xbuf = this->xbuf; unsigned* const cnt = this->cnt;
        PG8_LAS float* P = (PG8_LAS float*)lds;
        PG8_LAS float* S = (PG8_LAS float*)(lds + 4096);
        PG8_LAS unsigned* flag = (PG8_LAS unsigned*)(lds + 4096 + 1024);
        const int col0 = u.pn * BM + wc * 32 + 4 * fq;
        float s8[2][4];
#pragma unroll
        for (int ai = 0; ai < 2; ++ai)
#pragma unroll
            for (int m = 0; m < 4; ++m) s8[ai][m] = 0.f;
#pragma unroll
        for (int bj = 0; bj < 2; ++bj)
#pragma unroll
            for (int n = 0; n < 2; ++n) {
                const f32x4 gg = *(const f32x4*)(gv + col0 + bj * HALF + n * 16);
#pragma unroll
                for (int ai = 0; ai < 2; ++ai)
#pragma unroll
                    for (int m = 0; m < 4; ++m) {
                        const int rl = ai * HALF + wr * 64 + m * 16 + fr; const size_t off = (size_t)(u.pm * BM + rl) * ldc + col0 + bj * HALF + n * 16;
                        const f32x4 bs = *(const f32x4*)(base + off); const f32x4 v = bs + gg * acc[ai][bj][m][n]; *(f32x4*)(xout + off) = v;
                        s8[ai][m] += (v[0] * v[0] + v[1] * v[1]) + (v[2] * v[2] + v[3] * v[3]);
                    }
                asm volatile("" ::: "memory");
            }
#pragma unroll
        for (int ai = 0; ai < 2; ++ai)
#pragma unroll
            for (int m = 0; m < 4; ++m) { float s = s8[ai][m]; s += __shfl_xor(s, 16); s += __shfl_xor(s, 32);
                if (fq == 0) P[(ai * HALF + wr * 64 + m * 16 + fr) * 4 + wc] = s; }
        asm volatile("s_waitcnt lgkmcnt(0)" ::: "memory"); __builtin_amdgcn_s_barrier(); asm volatile("" ::: "memory");
        const int row = wid * 32 + (lane & 31);
        if (lane < 32) { const float t = (P[row * 4 + 0] + P[row * 4 + 1]) + (P[row * 4 + 2] + P[row * 4 + 3]);
            __hip_atomic_store(xbuf + (size_t)(u.pm * BM + row) * 8 + u.pn, t, __ATOMIC_RELAXED, __HIP_MEMORY_SCOPE_AGENT); }
        asm volatile("s_waitcnt vmcnt(0)" ::: "memory");
        if (lane == 0) __hip_atomic_fetch_add(cnt + 64 * u.pm, 1u, __ATOMIC_RELAXED, __HIP_MEMORY_SCOPE_AGENT);
        if (wid == 0) {
            unsigned bad = 0u; const unsigned long long t0 = __builtin_amdgcn_s_memrealtime();
            for (;;) {
                if ((unsigned)__builtin_amdgcn_readfirstlane(__hip_atomic_load(cnt + 64 * u.pm, __ATOMIC_RELAXED, __HIP_MEMORY_SCOPE_AGENT)) >= 64u) break;
                if (__builtin_amdgcn_s_memrealtime() - t0 > 2000000ull) { bad = 1u; break; }
                __builtin_amdgcn_s_sleep(2);
            }
            __builtin_amdgcn_fence(__ATOMIC_ACQUIRE, "agent");
            if (lane == 0) flag[0] = bad;
        }
        asm volatile("s_waitcnt vmcnt(0) lgkmcnt(0)" ::: "memory"); __builtin_amdgcn_s_barrier(); asm volatile("" ::: "memory");
        if (lane < 32) { const float* sl = xbuf + (size_t)(u.pm * BM + row) * 8; float q = 0.f;
#pragma unroll
            for (int t = 0; t < 8; ++t) q += __hip_atomic_load(sl + t, __ATOMIC_RELAXED, __HIP_MEMORY_SCOPE_AGENT);
            S[row] = 1.0f / sqrtf(q * (1.0f / 2048.0f) + 1e-6f); }
        asm volatile("s_waitcnt lgkmcnt(0)" ::: "memory"); __builtin_amdgcn_s_barrier(); asm volatile("" ::: "memory");
        typedef unsigned u32x2v __attribute__((ext_vector_type(2)));
#pragma unroll
        for (int bj = 0; bj < 2; ++bj)
#pragma unroll
            for (int n = 0; n < 2; ++n) {
                const f32x4 gwv = *(const f32x4*)(gw + col0 + bj * HALF + n * 16);
                f32x4 shv = (f32x4){0.f, 0.f, 0.f, 0.f}; if (FINAL == 0) shv = *(const f32x4*)(sh + col0 + bj * HALF + n * 16);
#pragma unroll
                for (int ai = 0; ai < 2; ++ai)
#pragma unroll
                    for (int m = 0; m < 4; ++m) {
                        const int rl = ai * HALF + wr * 64 + m * 16 + fr; const size_t off = (size_t)(u.pm * BM + rl) * ldc + col0 + bj * HALF + n * 16;
                        const f32x4 v = *(const f32x4*)(xout + off); const float rs = S[rl];
                        const f32x4 y = v * rs * gwv + shv;
                        if (FINAL) *(f32x4*)(xout + off) = y;
                        else { u32x2v w; w.x = cvt_pk_bf16(y[0], y[1]); w.y = cvt_pk_bf16(y[2], y[3]); *(u32x2v*)(hout + off) = w; }
                    }
            }
    }
};

struct EpiResidG {
    static constexpr bool PERM = false, AFTER_DRAIN = false; static constexpr int ldc = 2048;
    const float* base; float* out; bf16_t* xg; const float* gv; const float* gw; float* rsq;
    __device__ __forceinline__ void operator()(const f32x4 (&acc)[2][2][4][2], const Unit& u, int wr, int wc, int fr, int fq) const {
        typedef unsigned u32x2v __attribute__((ext_vector_type(2)));
        const int col0 = u.pn * BM + wc * 32 + 4 * fq;
        f32x4 gg[2][2], gwv[2][2];
#pragma unroll
        for (int bj = 0; bj < 2; ++bj)
#pragma unroll
            for (int n = 0; n < 2; ++n) { gg[bj][n] = *(const f32x4*)(gv + col0 + bj * HALF + n * 16); gwv[bj][n] = *(const f32x4*)(gw + col0 + bj * HALF + n * 16); }
#pragma unroll
        for (int ai = 0; ai < 2; ++ai)
#pragma unroll
            for (int m = 0; m < 4; ++m) {
                const int row = u.pm * BM + ai * HALF + wr * 64 + m * 16 + fr; const size_t off = (size_t)row * ldc + col0;
                float s = 0.f;
#pragma unroll
                for (int bj = 0; bj < 2; ++bj)
#pragma unroll
                    for (int n = 0; n < 2; ++n) {
                        const f32x4 bs = *(const f32x4*)(base + off + bj * HALF + n * 16); const f32x4 v = bs + gg[bj][n] * acc[ai][bj][m][n];
                        *(f32x4*)(out + off + bj * HALF + n * 16) = v; s += (v[0] * v[0] + v[1] * v[1]) + (v[2] * v[2] + v[3] * v[3]);
                        const f32x4 y = v * gwv[bj][n]; u32x2v w; w.x = cvt_pk_bf16(y[0], y[1]); w.y = cvt_pk_bf16(y[2], y[3]); *(u32x2v*)(xg + off + bj * HALF + n * 16) = w;
                    }
                s += __shfl_xor(s, 16); s += __shfl_xor(s, 32);
                if (fq == 0) atomicAdd(rsq + row, s);
            }
    }
};
struct EpiStoreN {
    static constexpr bool PERM = true, AFTER_DRAIN = false;
    bf16_t* O; int ldc; const float* rsq; const float* cb;
    __device__ __forceinline__ void operator()(const f32x4 (&acc)[2][2][4][2], const Unit& u, int wr, int wc, int fr, int fq) const {
        const int row0 = u.pm * BM + wr * 64 + fr, col0 = u.pn * BM + wc * 32 + 8 * fq;
        f32x4 c0[2], c1[2];
#pragma unroll
        for (int bj = 0; bj < 2; ++bj) { c0[bj] = *(const f32x4*)(cb + col0 + bj * HALF); c1[bj] = *(const f32x4*)(cb + col0 + bj * HALF + 4); }
#pragma unroll
        for (int ai = 0; ai < 2; ++ai)
#pragma unroll
            for (int m = 0; m < 4; ++m) {
                const int row = row0 + ai * HALF + m * 16; const float rs = 1.0f / sqrtf(rsq[row] * (1.0f / 2048.0f) + 1e-6f);
                bf16_t* rowp = O + (size_t)row * ldc + col0;
#pragma unroll
                for (int bj = 0; bj < 2; ++bj) {
                    const f32x4 v0 = acc[ai][bj][m][0] * rs + c0[bj], v1 = acc[ai][bj][m][1] * rs + c1[bj];
                    u32x4 w; w.x = cvt_pk_bf16(v0[0], v0[1]); w.y = cvt_pk_bf16(v0[2], v0[3]); w.z = cvt_pk_bf16(v1[0], v1[1]); w.w = cvt_pk_bf16(v1[2], v1[3]);
                    *(u32x4*)(rowp + bj * HALF) = w;
                }
            }
    }
};
struct EpiSwigluN {
    static constexpr bool PERM = true, AFTER_DRAIN = false;
    bf16_t* O; int ldc; const float* rsq; const float* cb;
    __device__ __forceinline__ void operator()(const f32x4 (&acc)[2][2][4][2], const Unit& u, int wr, int wc, int fr, int fq) const {
        const int row0 = u.pm * BM + wr * 64 + fr + (u.mh > 0 ? HALF : 0), col0 = u.pn * 128 + wc * 32 + 8 * fq, cc0 = u.pn * BM + wc * 32 + 8 * fq;
        const f32x4 cg0 = *(const f32x4*)(cb + cc0), cg1 = *(const f32x4*)(cb + cc0 + 4), cu0 = *(const f32x4*)(cb + cc0 + HALF), cu1 = *(const f32x4*)(cb + cc0 + HALF + 4);
#pragma unroll
        for (int ai = 0; ai < 2; ++ai)
#pragma unroll
            for (int m = 0; m < 4; ++m) {
                if (ai == 1 && u.mh >= 0) continue;
                const int row = row0 + ai * HALF + m * 16; const float rs = 1.0f / sqrtf(rsq[row] * (1.0f / 2048.0f) + 1e-6f);
                bf16_t* rowp = O + (size_t)row * ldc + col0;
                const f32x4 g0 = acc[ai][0][m][0] * rs + cg0, g1 = acc[ai][0][m][1] * rs + cg1, u0 = acc[ai][1][m][0] * rs + cu0, u1 = acc[ai][1][m][1] * rs + cu1;
                u32x4 w;
                w.x = cvt_pk_bf16(silu_f(g0[0]) * u0[0], silu_f(g0[1]) * u0[1]); w.y = cvt_pk_bf16(silu_f(g0[2]) * u0[2], silu_f(g0[3]) * u0[3]);
                w.z = cvt_pk_bf16(silu_f(g1[0]) * u1[0], silu_f(g1[1]) * u1[1]); w.w = cvt_pk_bf16(silu_f(g1[2]) * u1[2], silu_f(g1[3]) * u1[3]);
                *(u32x4*)rowp = w;
            }
    }
};

template <class Epi, class Sched, bool ALIGN_EPI = false, bool SP2 = false, bool SPLITK = false, bool HALF_M = false>
__device__ __forceinline__ void gemm_phase(PG8_LAS unsigned char* lds, const Gemm g, const Sched& S, const Epi& E, int wave_id) {
    int lane_; asm volatile("v_mbcnt_lo_u32_b32 %0, -1, 0\n\tv_mbcnt_hi_u32_b32 %0, -1, %0" : "=v"(lane_));
    const int wid = wave_id, lane = lane_, tid = wid * 64 + lane, wr = wid >> 2, wc = wid & 3, fr = lane & 15, fq = lane >> 4;
    static_assert(!HALF_M || SP2, "HALF_M is implemented on the SP2 loop only");
    const int K = g.K, nt = K / BK;
    unsigned voffA[2], voffB[2];
#pragma unroll
    for (int i = 0; i < 2; ++i) { int R, C; stage_rc(tid * 16 + i * 8192, R, C); const int Rb = Epi::PERM ? ((R & ~31) + perm32(R & 31)) : R;
        voffA[i] = (unsigned)(R * g.lda + C) * 2u; voffB[i] = (unsigned)(Rb * g.ldb + C) * 2u; }
    const size_t kstep = (size_t)(BK * 2);
    const size_t hstepA = (size_t)HALF * g.lda * 2, hstepB = (size_t)HALF * g.ldb * 2;
    const size_t tstepA = 2 * hstepA, tstepB = 2 * hstepB; const size_t kchunk = (size_t)K * 2;
    const unsigned ldsw = (unsigned)wid * 1024u;
    const int aoff = lds_byte(wr * 64 + fr, fq * 8), boff = lds_byte(wc * 32 + fr, fq * 8);
#define PG8_SA(b, h) (((b) * 2 + (h)) * HTB)
#define PG8_SB(b, h) ((4 + (b) * 2 + (h)) * HTB)
#define PG8_STAGE(bufoff, gbase, voff) do { _Pragma("unroll") for (int _i = 0; _i < 2; ++_i) \
        __builtin_amdgcn_global_load_lds((const unsigned*)((const char*)(gbase) + (voff)[_i]), (PG8_LAS unsigned*)(lds + (bufoff) + ldsw + _i * 8192), 16, 0, 0); } while (0)
#define PG8_LDA(dst, b, h) do { _Pragma("unroll") for (int m = 0; m < 4; ++m) _Pragma("unroll") for (int k = 0; k < 2; ++k) dst[m][k] = *(const PG8_LAS bf16x8*)(lds + PG8_SA(b, h) + aoff + m * 2048 + k * 1024); } while (0)
#define PG8_LDB(dst, b, h) do { _Pragma("unroll") for (int n = 0; n < 2; ++n) _Pragma("unroll") for (int k = 0; k < 2; ++k) dst[n][k] = *(const PG8_LAS bf16x8*)(lds + PG8_SB(b, h) + boff + n * 2048 + k * 1024); } while (0)
#define PG8_MMA(ai, bj, At, Bt) do { __builtin_amdgcn_s_setprio(1); _Pragma("unroll") for (int m = 0; m < 4; ++m) _Pragma("unroll") for (int n = 0; n < 2; ++n) _Pragma("unroll") for (int k = 0; k < 2; ++k) \
        acc[ai][bj][m][n] = __builtin_amdgcn_mfma_f32_16x16x32_bf16(Bt[n][k], At[m][k], acc[ai][bj][m][n], 0, 0, 0); __builtin_amdgcn_s_setprio(0); } while (0)
#define PG8_WAIT_V(n) asm volatile("s_waitcnt vmcnt(" #n ")" ::: "memory")
#define PG8_WAIT_L(n) asm volatile("s_waitcnt lgkmcnt(" #n ")" ::: "memory")
#define PG8_BAR __builtin_amdgcn_s_barrier()
#define PG8_SCHED __builtin_amdgcn_sched_barrier(0)
    Unit cur, nxt; int ui = 0;
    if (!S.next(0, cur)) return;
    f32x4 acc[2][2][4][2];
#pragma unroll
    for (int a = 0; a < 2; ++a)
#pragma unroll
        for (int b = 0; b < 2; ++b)
#pragma unroll
            for (int m = 0; m < 4; ++m)
#pragma unroll
                for (int n = 0; n < 2; ++n) acc[a][b][m][n] = (f32x4){0.f, 0.f, 0.f, 0.f};
    bf16x8 At[4][2], B0[2][2], B1[2][2];
    const char* cA = (const char*)g.A + (size_t)cur.pm * tstepA + (SPLITK ? (size_t)cur.pn * kchunk : 0) + ((HALF_M && cur.mh > 0) ? hstepA : 0); const char* cB = (const char*)g.Bt + (SPLITK ? (size_t)cur.pn * kchunk : (size_t)cur.pn * tstepB);
    S.a_ready(cur);
    if constexpr (SP2) {
        PG8_STAGE(PG8_SB(0, 0), cB, voffB); PG8_STAGE(PG8_SB(0, 1), cB + hstepB, voffB); PG8_STAGE(PG8_SA(0, 0), cA, voffA); PG8_STAGE(PG8_SA(0, 1), cA + hstepA, voffA);
        if (wr == 1) PG8_BAR;
        PG8_WAIT_V(2); PG8_BAR;
        PG8_STAGE(PG8_SB(1, 0), cB + kstep, voffB); PG8_STAGE(PG8_SA(1, 0), cA + kstep, voffA); PG8_STAGE(PG8_SB(1, 1), cB + hstepB + kstep, voffB);
        PG8_WAIT_V(6); PG8_BAR;
    } else {
        PG8_STAGE(PG8_SB(0, 0), cB, voffB); PG8_STAGE(PG8_SA(0, 0), cA, voffA); PG8_STAGE(PG8_SB(0, 1), cB + hstepB, voffB); PG8_STAGE(PG8_SA(0, 1), cA + hstepA, voffA);
        if (wr == 1) PG8_BAR;
        PG8_WAIT_V(4); PG8_BAR;
        PG8_STAGE(PG8_SB(1, 0), cB + kstep, voffB); PG8_STAGE(PG8_SA(1, 0), cA + kstep, voffA); PG8_STAGE(PG8_SB(1, 1), cB + hstepB + kstep, voffB);
        PG8_WAIT_V(6); PG8_BAR;
    }
    for (;;) {
        const bool has_next = S.next(ui + 1, nxt);
        const char* nA = has_next ? (const char*)g.A + (size_t)nxt.pm * tstepA + (SPLITK ? (size_t)nxt.pn * kchunk : 0) + ((HALF_M && nxt.mh > 0) ? hstepA : 0) : cA; const char* nB = has_next ? (const char*)g.Bt + (SPLITK ? (size_t)nxt.pn * kchunk : (size_t)nxt.pn * tstepB) : cB;
        for (int t = 0; t < nt; t += 2) {
            const bool last = (t == nt - 2);
            const char* a1 = cA + (size_t)(t + 1) * kstep;
            const char* a2 = last ? nA : cA + (size_t)(t + 2) * kstep; const char* b2 = last ? nB : cB + (size_t)(t + 2) * kstep;
            const char* a3 = a2 + kstep; const char* b3 = b2 + kstep;
            if (last && has_next) S.a_ready(nxt);
            if constexpr (SP2) {
            PG8_LDB(B0, 0, 0); PG8_LDB(B1, 0, 1); PG8_SCHED; PG8_LDA(At, 0, 0); PG8_STAGE(PG8_SA(1, 1), a1 + hstepA, voffA);
            PG8_WAIT_V(8); PG8_WAIT_L(0); PG8_BAR; PG8_MMA(0, 0, At, B0); PG8_MMA(0, 1, At, B1); PG8_BAR; PG8_SCHED;
            if constexpr (!HALF_M) { PG8_LDA(At, 0, 1); } PG8_STAGE(PG8_SB(0, 0), b2, voffB); PG8_STAGE(PG8_SB(0, 1), b2 + hstepB, voffB); PG8_STAGE(PG8_SA(0, 0), a2, voffA);
            PG8_WAIT_V(8); PG8_WAIT_L(0); PG8_BAR; if constexpr (!HALF_M) { PG8_MMA(1, 0, At, B0); PG8_MMA(1, 1, At, B1); } PG8_BAR; PG8_SCHED;
            PG8_LDB(B0, 1, 0); PG8_LDB(B1, 1, 1); PG8_SCHED; PG8_LDA(At, 1, 0); PG8_STAGE(PG8_SA(0, 1), a2 + hstepA, voffA);
            PG8_WAIT_V(8); PG8_WAIT_L(0); PG8_BAR; PG8_MMA(0, 0, At, B0); PG8_MMA(0, 1, At, B1); PG8_BAR; PG8_SCHED;
            if constexpr (!HALF_M) { PG8_LDA(At, 1, 1); } PG8_STAGE(PG8_SB(1, 0), b3, voffB); PG8_STAGE(PG8_SB(1, 1), b3 + hstepB, voffB); PG8_STAGE(PG8_SA(1, 0), a3, voffA);
            PG8_WAIT_V(8); PG8_WAIT_L(0); PG8_BAR; if constexpr (!HALF_M) { PG8_MMA(1, 0, At, B0); PG8_MMA(1, 1, At, B1); } PG8_BAR; PG8_SCHED;
            } else {
            PG8_LDB(B0, 0, 0); PG8_SCHED; PG8_LDA(At, 0, 0); PG8_STAGE(PG8_SA(1, 1), a1 + hstepA, voffA);
            PG8_WAIT_L(8); PG8_BAR; PG8_WAIT_L(0); PG8_MMA(0, 0, At, B0); PG8_BAR; PG8_SCHED;
            PG8_LDB(B1, 0, 1); PG8_STAGE(PG8_SB(0, 0), b2, voffB);
            PG8_BAR; PG8_WAIT_L(0); PG8_MMA(0, 1, At, B1); PG8_BAR;
            PG8_LDA(At, 0, 1); PG8_STAGE(PG8_SA(0, 0), a2, voffA);
            PG8_BAR; PG8_WAIT_L(0); PG8_MMA(1, 0, At, B0); PG8_BAR; PG8_SCHED;
            PG8_STAGE(PG8_SB(0, 1), b2 + hstepB, voffB);
            PG8_WAIT_V(6); PG8_BAR; PG8_MMA(1, 1, At, B1); PG8_BAR;
            PG8_LDB(B0, 1, 0); PG8_SCHED; PG8_LDA(At, 1, 0); PG8_STAGE(PG8_SA(0, 1), a2 + hstepA, voffA);
            PG8_WAIT_L(8); PG8_BAR; PG8_WAIT_L(0); PG8_MMA(0, 0, At, B0); PG8_BAR; PG8_SCHED;
            PG8_LDB(B1, 1, 1); PG8_STAGE(PG8_SB(1, 0), b3, voffB);
            PG8_BAR; PG8_WAIT_L(0); PG8_MMA(0, 1, At, B1); PG8_BAR;
            PG8_LDA(At, 1, 1); PG8_STAGE(PG8_SA(1, 0), a3, voffA);
            PG8_BAR; PG8_WAIT_L(0); PG8_MMA(1, 0, At, B0); PG8_BAR; PG8_SCHED;
            PG8_STAGE(PG8_SB(1, 1), b3 + hstepB, voffB);
            PG8_WAIT_V(6); PG8_BAR; PG8_MMA(1, 1, At, B1); PG8_BAR;
            }
        }
        if constexpr (ALIGN_EPI) { if (wr == 0) PG8_BAR; }
        if constexpr (!Epi::AFTER_DRAIN) { E(acc, cur, wr, wc, fr, fq); S.done(cur); }
        if (!has_next) break;
#pragma unroll
        for (int a = 0; a < 2; ++a)
#pragma unroll
            for (int b = 0; b < 2; ++b)
#pragma unroll
                for (int m = 0; m < 4; ++m)
#pragma unroll
                    for (int n = 0; n < 2; ++n) acc[a][b][m][n] = (f32x4){0.f, 0.f, 0.f, 0.f};
        cur = nxt; cA = nA; cB = nB; ++ui;
        if constexpr (ALIGN_EPI) { if (wr == 1) PG8_BAR; }
    }
    PG8_WAIT_V(0);
    if constexpr (!ALIGN_EPI) { if (wr == 0) PG8_BAR; }
    PG8_BAR;
    if constexpr (Epi::AFTER_DRAIN) { E.fused(acc, cur, wr, wc, fr, fq, lds, wid, lane); S.done(cur); }
#undef PG8_SA
#undef PG8_SB
#undef PG8_STAGE
#undef PG8_LDA
#undef PG8_LDB
#undef PG8_MMA
#undef PG8_WAIT_V
#undef PG8_WAIT_L
#undef PG8_BAR
#undef PG8_SCHED
}
}

constexpr int S_ = 8192, D_ = 2048, FF_ = 5632, DIN = 4824, DINP = 4864;
constexpr int O_CQ = 0, O_CKV = 768, O_KR = 1280, O_QN = 1344, O_KN = 2880, O_VN = 4032, O_GN = 4800;
constexpr int NWAVES = 8, NTHR = 512;
constexpr size_t MiB = 1u << 20;
constexpr size_t WS_CTL = 0;
constexpr size_t WS_MODP = 507 * MiB;
constexpr size_t WS_MOD = 2 * MiB;
constexpr size_t WS_ROPE = 3 * MiB;
constexpr size_t WS_WGU1 = 6 * MiB;
constexpr size_t WS_WD1 = 50 * MiB;
constexpr size_t WS_WIN = 72 * MiB;
constexpr size_t WS_WUQ = 91 * MiB;
constexpr size_t WS_WUKV = 94 * MiB;
constexpr size_t WS_WCK1 = 96 * MiB;
constexpr size_t WS_WCV1 = 99 * MiB;
constexpr size_t WS_WCK2 = 101 * MiB;
constexpr size_t WS_WCV2 = 101 * MiB + 512 * 1024;
constexpr size_t WS_WOUT = 102 * MiB;
constexpr size_t WS_WGU2 = 110 * MiB;
constexpr size_t WS_WD2 = 154 * MiB;
constexpr size_t WS_H = 176 * MiB;
constexpr size_t WS_ACT = 208 * MiB;
constexpr size_t WS_X1 = 296 * MiB;
constexpr size_t WS_Q = 360 * MiB;
constexpr size_t WS_KV = 384 * MiB;
constexpr size_t WS_KR = 416 * MiB;
constexpr size_t WS_CQN = 417 * MiB;
constexpr size_t WS_CKVN = 429 * MiB;
constexpr size_t WS_FLATK = 437 * MiB;
constexpr size_t WS_FLATV = 449 * MiB;
constexpr size_t WS_PARTK = 457 * MiB;
constexpr size_t WS_PARTV = 469 * MiB;
constexpr size_t WS_HIDK = 473 * MiB;
constexpr size_t WS_HIDV = 473 * MiB + 512 * 1024;
constexpr size_t WS_KC = 474 * MiB;
constexpr size_t WS_VC = 474 * MiB + 512 * 1024;
constexpr size_t WS_MIXF = 475 * MiB;
constexpr size_t WS_H2 = 509 * MiB;
constexpr size_t WS_XBUF = 541 * MiB;
constexpr size_t WS_GW = 542 * MiB;
constexpr size_t WS_END = 543 * MiB;
constexpr int KCH_K = 512, NCH_K = 12, KCH_V = 1024, NCH_V = 4;

constexpr int RING_BYTES = 131072, LDSCTL_OFF = RING_BYTES, MISC_OFF = LDSCTL_OFF + 320, LDS_BYTES = 147456;

#define GAS __attribute__((address_space(1)))
#define LAS __attribute__((address_space(3)))
typedef unsigned short bf16;
typedef unsigned v4u __attribute__((ext_vector_type(4)));
typedef unsigned v2u __attribute__((ext_vector_type(2)));
typedef float f32x4 __attribute__((ext_vector_type(4)));
typedef GAS unsigned gu32;
#define RLX_AGENT __ATOMIC_RELAXED, __HIP_MEMORY_SCOPE_AGENT
#define LDS_WAIT() asm volatile("s_waitcnt lgkmcnt(0)" ::: "memory")
#define VM_WAIT() asm volatile("s_waitcnt vmcnt(0)" ::: "memory")
__device__ __forceinline__ unsigned f2bf(float f) { unsigned u = __builtin_bit_cast(unsigned, f); return (u + 0x7fffu + ((u >> 16) & 1u)) >> 16; }
__device__ __forceinline__ unsigned pk2(float lo, float hi) { return f2bf(lo) | (f2bf(hi) << 16); }
__device__ __forceinline__ float bflo(unsigned w) { return __builtin_bit_cast(float, w << 16); }
__device__ __forceinline__ float bfhi(unsigned w) { return __builtin_bit_cast(float, w & 0xffff0000u); }
__device__ __forceinline__ float bf1(bf16 b) { return __builtin_bit_cast(float, (unsigned)b << 16); }
__device__ __forceinline__ float wave_sum(float v) {
#pragma unroll
    for (int o = 1; o < 64; o <<= 1) v += __shfl_xor(v, o);
    return v;
}

#define XB_TMO      128
#define XB_XCNT(j)  (256  + 64 * (j))
#define XB_XSUB(j)  (1280 + 64 * (j))
#define XB_XGEN(j)  (2304 + 64 * (j))
#define XB_TOP      3328
#define XB_TOPGEN   3392
#define XCD_BAR_WORDS 3456
#define XB_SPIN_CAP (1u << 18)

__device__ __forceinline__ unsigned xb_ld(unsigned* p)              { return __hip_atomic_load(p, __ATOMIC_RELAXED, __HIP_MEMORY_SCOPE_AGENT); }
__device__ __forceinline__ unsigned xb_add(unsigned* p, unsigned v) { return __hip_atomic_fetch_add(p, v, __ATOMIC_RELAXED, __HIP_MEMORY_SCOPE_AGENT); }
__device__ __forceinline__ unsigned xb_xcc_id() { return (unsigned)__builtin_amdgcn_s_getreg((3 << 11) | 20) & 0xFu; }
#define XB_SPIN(cond, bar) do { unsigned _sp = 0; while (cond) { __builtin_amdgcn_s_sleep(1); \
    if ((++_sp & 255u) == 0u) { if (xb_ld(&(bar)[XB_TMO])) break; if (_sp > XB_SPIN_CAP) { atomicAdd(&(bar)[XB_TMO], 1u); break; } } } } while (0)

struct XcdBarrier {
    int w0;
    unsigned* bar; unsigned x;
    volatile LAS unsigned* st;
};

__device__ __forceinline__ int xb_lane() { int l; asm volatile("v_mbcnt_lo_u32_b32 %0, -1, 0\n\tv_mbcnt_hi_u32_b32 %0, -1, %0" : "=v"(l)); return l; }
__device__ __forceinline__ XcdBarrier xcd_barrier_post(unsigned* bar, volatile LAS unsigned* st, int w0) {
    XcdBarrier b; b.w0 = w0; b.bar = bar; b.x = xb_xcc_id(); b.st = st;
    if (w0 && xb_lane() == 0) (void)xb_add(&bar[XB_XCNT(b.x)], 1u);
    return b;
}
__device__ __forceinline__ void xcd_barrier_complete(unsigned* bar, unsigned x, unsigned& nloc, unsigned& nx) {
    const unsigned G = gridDim.x * gridDim.y * gridDim.z;
    unsigned sum, cnt, mine, sp = 0u;
    for (;;) {
        sum = 0u; cnt = 0u; mine = 0u;
#pragma unroll
        for (unsigned j = 0; j < 16; ++j) { const unsigned c = xb_ld(&bar[XB_XCNT(j)]); sum += c; cnt += (c > 0u) ? 1u : 0u; mine = (j == x) ? c : mine; }
        if (sum == G) break;
        __builtin_amdgcn_s_sleep(1);
        if ((++sp & 255u) == 0u) { if (xb_ld(&bar[XB_TMO])) break; if (sp > XB_SPIN_CAP) { atomicAdd(&bar[XB_TMO], 1u); break; } }
    }
    nloc = mine > 0u ? mine : 1u; nx = cnt > 0u ? cnt : 1u;
}

__device__ __forceinline__ void xcd_barrier(const XcdBarrier& b) {
    asm volatile("s_waitcnt vmcnt(0)" ::: "memory");
    __syncthreads();
    if (b.w0 && xb_lane() == 0) {
        unsigned* bar = b.bar;
        __builtin_amdgcn_s_waitcnt(0);
        unsigned nloc = b.st[0], nx = b.st[1];
        if (nloc == 0u) { xcd_barrier_complete(bar, b.x, nloc, nx); b.st[0] = nloc; b.st[1] = nx; }
        const unsigned old = xb_add(&bar[XB_XSUB(b.x)], 1u);
        const unsigned gen = old / nloc;
        if (old + 1u == (gen + 1u) * nloc) {
            __builtin_amdgcn_fence(__ATOMIC_RELEASE, "agent");
            asm volatile("s_waitcnt vmcnt(0)" ::: "memory");
            const unsigned og = xb_add(&bar[XB_TOP], 1u);
            const unsigned tg = og / nx;
            if (og + 1u == (tg + 1u) * nx) xb_add(&bar[XB_TOPGEN], 1u);
            else XB_SPIN(xb_ld(&bar[XB_TOPGEN]) == tg, bar);
            __builtin_amdgcn_fence(__ATOMIC_ACQUIRE, "agent");
            xb_add(&bar[XB_XGEN(b.x)], 1u);
            asm volatile("s_waitcnt vmcnt(0)" ::: "memory");
        } else {
            XB_SPIN(xb_ld(&bar[XB_XGEN(b.x)]) == gen, bar);
            __builtin_amdgcn_fence(__ATOMIC_ACQUIRE, "agent");
            asm volatile("s_waitcnt vmcnt(0)" ::: "memory");
        }
    }
    __syncthreads();
}

struct Ctx { LAS unsigned char* lds; int tid, lane, wave, vcu, G; };

struct TD { const float* W; bf16* WT; int K, Nreal, nblk, mode, item; };
__device__ __forceinline__ void tr_load(const TD& d, f32x4 (&v)[8], int lane) {
    const int kb = d.item / d.nblk, nb = d.item % d.nblk, k0 = 64 * kb, n0 = 32 * nb;
    const int n4 = (lane & 7) * 4, kr = lane >> 3; const bool ok = n0 + n4 < d.Nreal;
#pragma unroll
    for (int i = 0; i < 8; ++i) v[i] = ok ? __builtin_nontemporal_load((const f32x4*)(d.W + (size_t)(k0 + kr + 8 * i) * d.Nreal + n0 + n4)) : (f32x4){0.f, 0.f, 0.f, 0.f};
}
__device__ __forceinline__ void tr_store(const TD& d, const f32x4 (&v)[8], LAS float* scr, int lane) {
    const int kb = d.item / d.nblk, nb = d.item % d.nblk, k0 = 64 * kb, n0 = 32 * nb;
    const int n4 = (lane & 7) * 4, kr = lane >> 3;
#pragma unroll
    for (int i = 0; i < 8; ++i) { LAS float* p = scr + (kr + 8 * i) * 33 + n4; p[0] = v[i].x; p[1] = v[i].y; p[2] = v[i].z; p[3] = v[i].w; }
    LDS_WAIT(); asm volatile("" ::: "memory");
    const int c = lane & 7;
    const int drow0 = d.mode == 0 ? n0 : ((n0 >> 7) * 256 + (n0 & 127) + (d.mode == 2 ? 128 : 0));
#pragma unroll
    for (int j = 0; j < 4; ++j) { const int n = (lane >> 3) + 8 * j; const LAS float* s = scr + (8 * c) * 33 + n;
        v4u o; o.x = pk2(s[0 * 33], s[1 * 33]); o.y = pk2(s[2 * 33], s[3 * 33]); o.z = pk2(s[4 * 33], s[5 * 33]); o.w = pk2(s[6 * 33], s[7 * 33]);
        *(GAS v4u*)(d.WT + (size_t)(drow0 + n) * d.K + k0 + 8 * c) = o; }
    LDS_WAIT(); asm volatile("" ::: "memory");
}

struct P0Args { const float *w1g, *w1u, *w1d, *win, *wuq, *wukv, *ck1, *ck2, *cv1, *cv2, *wout, *w2g, *w2u, *w2d, *c, *wada; unsigned char* ws; };
constexpr int I_GU = 32 * 176, I_DN = 88 * 64, I_IN = 32 * 152, I_UQ = 12 * 48, I_UKV = 8 * 64, I_CK1 = 96 * 8, I_CK2 = 4 * 8, I_CV1 = 64 * 8, I_CV2 = 4 * 8, I_OUT = 32 * 64;
constexpr int NIT_A = 2 * I_GU, NIT_B = I_DN + I_IN, NIT_C = I_UQ + I_UKV + I_CK1 + I_CK2 + I_CV1 + I_CV2 + I_OUT + I_DN, NIT_D = 2 * I_GU;
__device__ __forceinline__ TD conv_desc(int grp, int r, const P0Args& a) {
    unsigned char* ws = a.ws;
    if (grp == 0) {
        if (r < I_GU) return TD{a.w1g, (bf16*)(ws + WS_WGU1), 2048, 5632, 176, 1, r}; r -= I_GU;
        return TD{a.w1u, (bf16*)(ws + WS_WGU1), 2048, 5632, 176, 2, r};
    } else if (grp == 1) {
        if (r < I_DN) return TD{a.w1d, (bf16*)(ws + WS_WD1), 5632, 2048, 64, 0, r}; r -= I_DN;
        return TD{a.win, (bf16*)(ws + WS_WIN), 2048, DIN, 152, 0, r};
    } else if (grp == 2) {
        if (r < I_UQ) return TD{a.wuq, (bf16*)(ws + WS_WUQ), 768, 1536, 48, 0, r}; r -= I_UQ;
        if (r < I_UKV) return TD{a.wukv, (bf16*)(ws + WS_WUKV), 512, 2048, 64, 0, r}; r -= I_UKV;
        if (r < I_CK1) return TD{a.ck1, (bf16*)(ws + WS_WCK1), 6144, 256, 8, 0, r}; r -= I_CK1;
        if (r < I_CK2) return TD{a.ck2, (bf16*)(ws + WS_WCK2), 256, 192, 8, 0, r}; r -= I_CK2;
        if (r < I_CV1) return TD{a.cv1, (bf16*)(ws + WS_WCV1), 4096, 256, 8, 0, r}; r -= I_CV1;
        if (r < I_CV2) return TD{a.cv2, (bf16*)(ws + WS_WCV2), 256, 128, 8, 0, r}; r -= I_CV2;
        if (r < I_OUT) return TD{a.wout, (bf16*)(ws + WS_WOUT), 2048, 2048, 64, 0, r}; r -= I_OUT;
        return TD{a.w2d, (bf16*)(ws + WS_WD2), 5632, 2048, 64, 0, r};
    }
    if (r < I_GU) return TD{a.w2g, (bf16*)(ws + WS_WGU2), 2048, 5632, 176, 1, r}; r -= I_GU;
    return TD{a.w2u, (bf16*)(ws + WS_WGU2), 2048, 5632, 176, 2, r};
}
__device__ __forceinline__ void conv_run(int grp, int first, int step, int nitems, const P0Args& a, LAS float* scr, int lane) {
    if (first >= nitems) return;
    f32x4 va[8], vb[8];
    TD da = conv_desc(grp, first, a); tr_load(da, va, lane);
    for (int it = first; it < nitems; it += 2 * step) {
        const bool hb = it + step < nitems; TD db = da;
        if (hb) { db = conv_desc(grp, it + step, a); tr_load(db, vb, lane); }
        tr_store(da, va, scr, lane);
        if (!hb) break;
        const bool ha = it + 2 * step < nitems;
        if (ha) { da = conv_desc(grp, it + 2 * step, a); tr_load(da, va, lane); }
        tr_store(db, vb, scr, lane);
        if (!ha) break;
    }
}
__device__ __forceinline__ void conv_tail(const Ctx& F, const P0Args& a, int grp, int nitems, int nwg) {
    const int G = F.G, rem = nwg % G, c = (int)blockIdx.x;
    int rank, nidle;
    if (rem == 0) { rank = c; nidle = G; } else { if (c < rem) return; rank = c - rem; nidle = G - rem; }
    LAS float* scr = (LAS float*)(F.lds + F.wave * 16384);
    conv_run(grp, rank * NWAVES + F.wave, nidle * NWAVES, nitems, a, scr, F.lane);
}
#ifndef GEMV_NT
#define GEMV_NT 1
#endif
#if GEMV_NT
#define GEMV_LD(p) __builtin_nontemporal_load(p)
#else
#define GEMV_LD(p) (*(p))
#endif
template <int NC>
__device__ __forceinline__ void gemv_block(const Ctx& F, const P0Args& a, int kc, int col0) {
    constexpr int NJ = (NC + 255) / 256;
    float* modp = (float*)(a.ws + WS_MODP);
    const float* wp = a.wada + (size_t)(kc * 128 + F.wave * 16) * 18432 + col0 + F.lane * 4; const float* cp = a.c + kc * 128 + F.wave * 16;
    f32x4 acc[NJ];
#pragma unroll
    for (int j = 0; j < NJ; ++j) acc[j] = (f32x4){0.f, 0.f, 0.f, 0.f};
#pragma unroll 4
    for (int i = 0; i < 16; ++i) { const float ci = cp[i]; const float sl = ci / (1.f + __expf(-ci)); const float* rp = wp + (size_t)i * 18432;
#pragma unroll
        for (int j = 0; j < NJ; ++j) if (256 * j + 256 <= NC || F.lane * 4 < NC - 256 * j) acc[j] += GEMV_LD((const f32x4*)(rp + 256 * j)) * sl; }
    __syncthreads();
    LAS float* red = (LAS float*)F.lds + F.wave * NC;
#pragma unroll
    for (int j = 0; j < NJ; ++j) if (256 * j + 256 <= NC || F.lane * 4 < NC - 256 * j) *(LAS f32x4*)(red + 256 * j + F.lane * 4) = acc[j];
    LDS_WAIT(); __syncthreads();
    for (int c = F.tid; c < NC; c += NTHR) { float s = 0.f;
#pragma unroll
        for (int w = 0; w < 8; ++w) s += ((const LAS float*)F.lds)[w * NC + c];
        modp[kc * 18432 + col0 + c] = s; }
    __syncthreads();
}
template <int NC>
__device__ __forceinline__ void gemv_tail(const Ctx& F, const P0Args& a, int cbase, int nblk, int nwg) {
    const int G = F.G, rem = nwg % G, c = (int)blockIdx.x;
    int rank, nidle;
    if (rem == 0) { rank = c; nidle = G; } else { if (c < rem) return; rank = c - rem; nidle = G - rem; }
    for (int r = rank; r < nblk; r += nidle) gemv_block<NC>(F, a, r & 15, cbase + (r >> 4) * NC);
}
__device__ __forceinline__ void mod_finalize(const Ctx& F, unsigned char* ws, const float* b_ada, int c0, int c1) {
    const float* modp = (const float*)(ws + WS_MODP); float* mod = (float*)(ws + WS_MOD);
    for (int col = c0 + (int)blockIdx.x * NTHR + F.tid; col < c1; col += F.G * NTHR) { float a = b_ada[col];
#pragma unroll
        for (int k = 0; k < 16; ++k) a += modp[k * 18432 + col]; mod[col] = a; }
}
__device__ __forceinline__ void p0_prologue(const Ctx& F, const P0Args& a, int parts = 7) {
    LAS float* scr = (LAS float*)(F.lds + F.wave * 16384);
    const int gw = F.vcu * NWAVES + F.wave, NGW = F.G * NWAVES;
    unsigned char* ws = a.ws;
    if (parts & 1) conv_run(0, gw, NGW, NIT_A, a, scr, F.lane);
    if (parts & 2) for (int b = (int)blockIdx.x; b < 256; b += F.G) gemv_block<1152>(F, a, b & 15, (b >> 4) * 1152);
    float* cs = (float*)(ws + WS_ROPE); float* sn = cs + 8192 * 32;
    if (parts & 4) for (int idx = (F.vcu * NTHR + F.tid); idx < 8192 * 32; idx += F.G * NTHR) {
        const int t = idx >> 5, i = idx & 31;
        const float inv = powf(10000.0f, -(float)(2 * i) / 64.0f); const float ang = (float)t * inv;
        cs[idx] = cosf(ang); sn[idx] = sinf(ang);
    }
}

__device__ __forceinline__ void norm_rows_bf16(const Ctx& F, const float* X, bf16* O, const LAS float* gwt, const LAS float* sht) {
    const int gw = F.vcu * NWAVES + F.wave, NGW = F.G * NWAVES;
    f32x4 v[8], nx[8];
    if (gw < S_) { const GAS f32x4* xr = (const GAS f32x4*)(X + (size_t)gw * D_) + F.lane;
#pragma unroll
        for (int j = 0; j < 8; ++j) v[j] = xr[64 * j]; }
    for (int m = gw; m < S_; m += NGW) {
        if (m + NGW < S_) { const GAS f32x4* xn = (const GAS f32x4*)(X + (size_t)(m + NGW) * D_) + F.lane;
#pragma unroll
            for (int j = 0; j < 8; ++j) nx[j] = xn[64 * j]; }
        float s = 0.f;
#pragma unroll
        for (int j = 0; j < 8; ++j) s += (v[j].x * v[j].x + v[j].y * v[j].y) + (v[j].z * v[j].z + v[j].w * v[j].w);
        const float rstd = 1.f / sqrtf(wave_sum(s) * (1.f / D_) + 1e-6f);
        GAS v2u* o8 = (GAS v2u*)(O + (size_t)m * D_) + F.lane;
#pragma unroll
        for (int j = 0; j < 8; ++j) { const f32x4 g = *(const LAS f32x4*)(gwt + 4 * (F.lane + 64 * j)), sh = *(const LAS f32x4*)(sht + 4 * (F.lane + 64 * j));
            const f32x4 y = v[j] * rstd * g + sh; v2u w; w.x = pk2(y.x, y.y); w.y = pk2(y.z, y.w); o8[64 * j] = w; }
#pragma unroll
        for (int j = 0; j < 8; ++j) v[j] = nx[j];
    }
}
__device__ __forceinline__ void build_mod_tables(const Ctx& F, unsigned char* ws, const float* nw, const float* b_ada, int chunk_sh, bool first, LAS float* gwt, LAS float* sht) {
    const float* modp = (const float*)(ws + WS_MODP); float* mod = (float*)(ws + WS_MOD);
    if (first) {
        for (int col = blockIdx.x * NTHR + F.tid; col < 18432; col += F.G * NTHR) { { float a = b_ada[col];
#pragma unroll
            for (int k = 0; k < 16; ++k) a += modp[k * 18432 + col]; mod[col] = a; } }
    }
    for (int c = F.tid; c < D_; c += NTHR) {
        float sh, sc;
        if (first) { sh = b_ada[chunk_sh * D_ + c]; sc = b_ada[(chunk_sh + 1) * D_ + c];
#pragma unroll
            for (int k = 0; k < 16; ++k) { sh += modp[k * 18432 + chunk_sh * D_ + c]; sc += modp[k * 18432 + (chunk_sh + 1) * D_ + c]; } }
        else { sh = mod[chunk_sh * D_ + c]; sc = mod[(chunk_sh + 1) * D_ + c]; }
        gwt[c] = nw[c] * (1.f + sc); sht[c] = sh;
    }
    LDS_WAIT(); __syncthreads();
}

__device__ __forceinline__ void p6_prep(const Ctx& F, unsigned char* ws, const float* qn_w, const float* kvn_w, const float* pe_k, const float* pe_v) {
    const bf16* U = (const bf16*)(ws + WS_ACT);
    bf16* CQN = (bf16*)(ws + WS_CQN); bf16* CKVN = (bf16*)(ws + WS_CKVN); bf16* KR = (bf16*)(ws + WS_KR);
    const float* cs = (const float*)(ws + WS_ROPE); const float* sn = cs + 8192 * 32;
    const int gw = F.vcu * NWAVES + F.wave, NGW = F.G * NWAVES;
    bf16* FK = (bf16*)(ws + WS_FLATK); bf16* FV = (bf16*)(ws + WS_FLATV);
    const int gt = F.vcu * NTHR + F.tid, NGT = F.G * NTHR;
    for (int t0 = gw; t0 < S_; t0 += 4 * NGW) {
        v2u a[4][3], b[4][2]; bf16 k1[4], k2[4]; float cc[4], ss[4];
        const int i = F.lane & 31;
#pragma unroll
        for (int k = 0; k < 4; ++k) { const int t = t0 + k * NGW; if (t < S_) { const bf16* ur = U + (size_t)t * DINP;
#pragma unroll
            for (int j = 0; j < 3; ++j) a[k][j] = *(const GAS v2u*)(ur + O_CQ + 4 * (F.lane + 64 * j));
#pragma unroll
            for (int j = 0; j < 2; ++j) b[k][j] = *(const GAS v2u*)(ur + O_CKV + 4 * (F.lane + 64 * j));
            k1[k] = ur[O_KR + i]; k2[k] = ur[O_KR + i + 32]; cc[k] = cs[t * 32 + i]; ss[k] = sn[t * 32 + i]; } }
        v4u uk[6];
        if (t0 == gw) {
#pragma unroll
            for (int q = 0; q < 6; ++q) { const int e = gt + q * NGT; const int r = e / 768, c8 = e % 768, l = c8 / 24, d0 = (c8 % 24) * 8, n = r >> 1, g = r & 1;
                uk[q] = (v4u){0u, 0u, 0u, 0u}; if (e < 1024 * 768 && r < 1022) uk[q] = *(const GAS v4u*)(U + (size_t)(16 * n + l) * DINP + O_KN + g * 192 + d0); }
        }
#pragma unroll
        for (int k = 0; k < 4; ++k) { const int t = t0 + k * NGW; if (t < S_) {
            float s = 0.f;
#pragma unroll
            for (int j = 0; j < 3; ++j) { const float x0 = bflo(a[k][j].x), x1 = bfhi(a[k][j].x), x2 = bflo(a[k][j].y), x3 = bfhi(a[k][j].y); s += (x0 * x0 + x1 * x1) + (x2 * x2 + x3 * x3); }
            float rstd = 1.f / sqrtf(wave_sum(s) * (1.f / 768.f) + 1e-6f);
#pragma unroll
            for (int j = 0; j < 3; ++j) { const int c0 = 4 * (F.lane + 64 * j); const f32x4 g = *(const f32x4*)(qn_w + c0);
                v2u w; w.x = pk2(bflo(a[k][j].x) * rstd * g.x, bfhi(a[k][j].x) * rstd * g.y); w.y = pk2(bflo(a[k][j].y) * rstd * g.z, bfhi(a[k][j].y) * rstd * g.w); *(GAS v2u*)(CQN + (size_t)t * 768 + c0) = w; }
            s = 0.f;
#pragma unroll
            for (int j = 0; j < 2; ++j) { const float x0 = bflo(b[k][j].x), x1 = bfhi(b[k][j].x), x2 = bflo(b[k][j].y), x3 = bfhi(b[k][j].y); s += (x0 * x0 + x1 * x1) + (x2 * x2 + x3 * x3); }
            rstd = 1.f / sqrtf(wave_sum(s) * (1.f / 512.f) + 1e-6f);
#pragma unroll
            for (int j = 0; j < 2; ++j) { const int c0 = 4 * (F.lane + 64 * j); const f32x4 g = *(const f32x4*)(kvn_w + c0);
                v2u w; w.x = pk2(bflo(b[k][j].x) * rstd * g.x, bfhi(b[k][j].x) * rstd * g.y); w.y = pk2(bflo(b[k][j].y) * rstd * g.z, bfhi(b[k][j].y) * rstd * g.w); *(GAS v2u*)(CKVN + (size_t)t * 512 + c0) = w; }
            if (F.lane < 32) { const float t1 = bf1(k1[k]), t2 = bf1(k2[k]);
                KR[(size_t)t * 64 + i] = (bf16)f2bf(t1 * cc[k] - t2 * ss[k]); KR[(size_t)t * 64 + i + 32] = (bf16)f2bf(t1 * ss[k] + t2 * cc[k]); } } }
        if (t0 == gw) {
            v4u uv[4];
#pragma unroll
            for (int q = 0; q < 4; ++q) { const int e = gt + q * NGT; const int r = e / 512, c8 = e % 512, l = c8 / 16, d0 = (c8 % 16) * 8, n = r >> 1, g = r & 1;
                uv[q] = (v4u){0u, 0u, 0u, 0u}; if (e < 1024 * 512 && r < 1022) uv[q] = *(const GAS v4u*)(U + (size_t)(16 * n + l) * DINP + O_VN + g * 128 + d0); }
#pragma unroll
            for (int q = 0; q < 6; ++q) { const int e = gt + q * NGT; if (e < 1024 * 768) { const int r = e / 768, c8 = e % 768, l = c8 / 24, d0 = (c8 % 24) * 8;
                v4u o = (v4u){0u, 0u, 0u, 0u}; const v4u u = uk[q];
                if (r < 1022) { const f32x4 p0 = *(const f32x4*)(pe_k + l * 192 + d0), p1 = *(const f32x4*)(pe_k + l * 192 + d0 + 4);
                    o.x = pk2(bflo(u.x) + p0.x, bfhi(u.x) + p0.y); o.y = pk2(bflo(u.y) + p0.z, bfhi(u.y) + p0.w); o.z = pk2(bflo(u.z) + p1.x, bfhi(u.z) + p1.y); o.w = pk2(bflo(u.w) + p1.z, bfhi(u.w) + p1.w); }
                *(GAS v4u*)(FK + (size_t)r * 6144 + c8 * 8) = o; } }
#pragma unroll
            for (int q = 0; q < 4; ++q) { const int e = gt + q * NGT; if (e < 1024 * 512) { const int r = e / 512, c8 = e % 512, l = c8 / 16, d0 = (c8 % 16) * 8;
                v4u o = (v4u){0u, 0u, 0u, 0u}; const v4u u = uv[q];
                if (r < 1022) { const f32x4 p0 = *(const f32x4*)(pe_v + l * 128 + d0), p1 = *(const f32x4*)(pe_v + l * 128 + d0 + 4);
                    o.x = pk2(bflo(u.x) + p0.x, bfhi(u.x) + p0.y); o.y = pk2(bflo(u.y) + p0.z, bfhi(u.y) + p0.w); o.z = pk2(bflo(u.z) + p1.x, bfhi(u.z) + p1.y); o.w = pk2(bflo(u.w) + p1.z, bfhi(u.w) + p1.w); }
                *(GAS v4u*)(FV + (size_t)r * 4096 + c8 * 8) = o; } }
        }
    }
    for (int e = gt + 6 * NGT; e < 1024 * 768; e += NGT) {
        const int r = e / 768, c8 = e % 768, l = c8 / 24, d0 = (c8 % 24) * 8, n = r >> 1, g = r & 1;
        v4u o = (v4u){0u, 0u, 0u, 0u};
        if (r < 1022) { const v4u u = *(const GAS v4u*)(U + (size_t)(16 * n + l) * DINP + O_KN + g * 192 + d0); const f32x4 p0 = *(const f32x4*)(pe_k + l * 192 + d0), p1 = *(const f32x4*)(pe_k + l * 192 + d0 + 4);
            o.x = pk2(bflo(u.x) + p0.x, bfhi(u.x) + p0.y); o.y = pk2(bflo(u.y) + p0.z, bfhi(u.y) + p0.w); o.z = pk2(bflo(u.z) + p1.x, bfhi(u.z) + p1.y); o.w = pk2(bflo(u.w) + p1.z, bfhi(u.w) + p1.w); }
        *(GAS v4u*)(FK + (size_t)r * 6144 + c8 * 8) = o;
    }
    for (int e = gt + 4 * NGT; e < 1024 * 512; e += NGT) {
        const int r = e / 512, c8 = e % 512, l = c8 / 16, d0 = (c8 % 16) * 8, n = r >> 1, g = r & 1;
        v4u o = (v4u){0u, 0u, 0u, 0u};
        if (r < 1022) { const v4u u = *(const GAS v4u*)(U + (size_t)(16 * n + l) * DINP + O_VN + g * 128 + d0); const f32x4 p0 = *(const f32x4*)(pe_v + l * 128 + d0), p1 = *(const f32x4*)(pe_v + l * 128 + d0 + 4);
            o.x = pk2(bflo(u.x) + p0.x, bfhi(u.x) + p0.y); o.y = pk2(bflo(u.y) + p0.z, bfhi(u.y) + p0.w); o.z = pk2(bflo(u.z) + p1.x, bfhi(u.z) + p1.y); o.w = pk2(bflo(u.w) + p1.z, bfhi(u.w) + p1.w); }
        *(GAS v4u*)(FV + (size_t)r * 4096 + c8 * 8) = o;
    }
}

__device__ __forceinline__ void p8_prep2(const Ctx& F, unsigned char* ws) {
    const int gt = F.vcu * NTHR + F.tid, NGT = F.G * NTHR;
    const float* PK = (const float*)(ws + WS_PARTK); const float* PV = (const float*)(ws + WS_PARTV);
    bf16* HK = (bf16*)(ws + WS_HIDK); bf16* HV = (bf16*)(ws + WS_HIDV);
    for (int e = gt; e < 2 * 65536; e += NGT) {
        const int which = e >> 16, q4 = e & 65535; const float* P = which ? PV : PK; const int nch = which ? NCH_V : NCH_K;
        f32x4 pv[12];
#pragma unroll
        for (int s = 0; s < 12; ++s) { pv[s] = (f32x4){0.f, 0.f, 0.f, 0.f}; if (s < nch) pv[s] = *(const f32x4*)(P + (size_t)s * 262144 + q4 * 4); }
        f32x4 a = pv[0];
#pragma unroll
        for (int s = 1; s < 12; ++s) a += pv[s];
        v2u w; w.x = pk2(a.x / (1.f + __expf(-a.x)), a.y / (1.f + __expf(-a.y))); w.y = pk2(a.z / (1.f + __expf(-a.z)), a.w / (1.f + __expf(-a.w)));
        *(GAS v2u*)((which ? HV : HK) + q4 * 4) = w;
    }
}

__device__ __forceinline__ void bias_gemv(const Ctx& F, const bf16* WT, int N, const float* sh, float* cb) {
    const int gw = F.vcu * NWAVES + F.wave, NGW = F.G * NWAVES;
    f32x4 s[8];
#pragma unroll
    for (int j = 0; j < 8; ++j) s[j] = *(const f32x4*)(sh + 4 * (F.lane + 64 * j));
    for (int n = gw; n < N; n += NGW) {
        const GAS v2u* wr_ = (const GAS v2u*)(WT + (size_t)n * 2048) + F.lane; float a = 0.f;
#pragma unroll
        for (int j = 0; j < 8; ++j) { const v2u w = wr_[64 * j]; a += (bflo(w.x) * s[j].x + bfhi(w.x) * s[j].y) + (bflo(w.y) * s[j].z + bfhi(w.y) * s[j].w); }
        a = wave_sum(a);
        if (F.lane == 0) cb[n] = a;
    }
}

__device__ __forceinline__ void final_norm(const Ctx& F, float* out, const float* nw) {
    const int gw = F.vcu * NWAVES + F.wave, NGW = F.G * NWAVES;
    f32x4 v[8], nx[8];
    if (gw < S_) { const GAS f32x4* xr = (const GAS f32x4*)(out + (size_t)gw * D_) + F.lane;
#pragma unroll
        for (int j = 0; j < 8; ++j) v[j] = xr[64 * j]; }
    for (int m = gw; m < S_; m += NGW) {
        if (m + NGW < S_) { const GAS f32x4* xn = (const GAS f32x4*)(out + (size_t)(m + NGW) * D_) + F.lane;
#pragma unroll
            for (int j = 0; j < 8; ++j) nx[j] = xn[64 * j]; }
        GAS f32x4* xr = (GAS f32x4*)(out + (size_t)m * D_) + F.lane;
        float s = 0.f;
#pragma unroll
        for (int j = 0; j < 8; ++j) s += (v[j].x * v[j].x + v[j].y * v[j].y) + (v[j].z * v[j].z + v[j].w * v[j].w);
        const float rstd = 1.f / sqrtf(wave_sum(s) * (1.f / D_) + 1e-6f);
#pragma unroll
        for (int j = 0; j < 8; ++j) { const f32x4 g = *(const f32x4*)(nw + 4 * (F.lane + 64 * j)); xr[64 * j] = v[j] * rstd * g; }
#pragma unroll
        for (int j = 0; j < 8; ++j) v[j] = nx[j];
    }
}

#ifndef PROBE_A1
#define PROBE_A1 0.f
#endif
#ifndef PROBE_A2
#define PROBE_A2 0.f
#endif
#ifndef PROBE_A3
#define PROBE_A3 0.f
#endif
namespace att {
typedef short bf16x8 __attribute__((ext_vector_type(8)));
typedef short s16x4 __attribute__((ext_vector_type(4)));
typedef short v4i16_t __attribute__((ext_vector_type(4)));
typedef float f32x16 __attribute__((ext_vector_type(16)));
typedef LAS const char* lds_cptr;
typedef unsigned u32x4 __attribute__((ext_vector_type(4)));
constexpr int KSLOT = 24576, VSLOT = 16384;
constexpr int L_K = 0, L_V = 2 * KSLOT, L_WSF = L_V + 2 * VSLOT, L_BT = L_WSF + 2048, L_IMP = L_BT + 2048, L_SEL = L_IMP + 32768, L_LIST = L_SEL + 1024, L_MISC = L_LIST + 512, L_END = L_MISC + 256;
static_assert(L_END <= RING_BYTES, "attention LDS map");
constexpr float LOG2E = 1.4426950408889634f;
constexpr float C2 = 0.07216878364870322f * LOG2E;
constexpr float THR = 8.0f;
#ifndef ATT_RESCALE
#define ATT_RESCALE 0
#endif
#ifndef ATT_STAGGER
#define ATT_STAGGER 0
#endif
__device__ __forceinline__ int lane_id() { int l; asm volatile("v_mbcnt_lo_u32_b32 %0, -1, 0\n\tv_mbcnt_hi_u32_b32 %0, -1, %0" : "=v"(l)); return l; }
__device__ __forceinline__ int crow(int r, int hi) { return (r & 3) + 8 * (r >> 2) + 4 * hi; }
__device__ __forceinline__ void glds16(const void* gsrc, unsigned lds_dst) { unsigned keep;
    asm volatile("s_mov_b32 %0, m0\n\ts_mov_b32 m0, %2\n\ts_nop 0\n\tglobal_load_lds_dwordx4 %1, off\n\ts_mov_b32 m0, %0" : "=&s"(keep) : "v"(gsrc), "s"(lds_dst) : "memory"); }
#define ATT_WAIT_BAR() asm volatile("s_waitcnt vmcnt(0) lgkmcnt(0)\n\ts_barrier" ::: "memory")
__device__ __forceinline__ unsigned cvtpk(float lo, float hi) { typedef float f2 __attribute__((ext_vector_type(2))); typedef __bf16 b2 __attribute__((ext_vector_type(2))); f2 v = {lo, hi}; b2 b = __builtin_convertvector(v, b2); return __builtin_bit_cast(unsigned, b); }
__device__ __forceinline__ s16x4 vtr(lds_cptr p) { return __builtin_bit_cast(s16x4, __builtin_amdgcn_ds_read_tr16_b64_v4i16((LAS v4i16_t*)p)); }
__device__ __forceinline__ float xhalf_max(float m) { auto rr = __builtin_amdgcn_permlane32_swap(__float_as_uint(m), __float_as_uint(m), false, false); return fmaxf(__uint_as_float(rr[0]), __uint_as_float(rr[1])); }
__device__ __forceinline__ float xhalf_sum(float m) { auto rr = __builtin_amdgcn_permlane32_swap(__float_as_uint(m), __float_as_uint(m), false, false); return __uint_as_float(rr[0]) + __uint_as_float(rr[1]); }

template <int NKS, bool NOMMA = false>
__device__ __forceinline__ void qk_tile(f32x16& p0, f32x16& p1, lds_cptr kslot, const bf16x8* qf, int r32, int hi) {
    const lds_cptr kb = kslot + hi * 1024 + r32 * 16;
    p0 = f32x16{}; p1 = f32x16{};
    bf16x8 fa[3], fb[3];
#define QK_LD(ks) do { fa[(ks) % 3] = *(const LAS bf16x8*)(kb + (ks) * 2048); fb[(ks) % 3] = *(const LAS bf16x8*)(kb + (ks) * 2048 + 512); } while (0)
    QK_LD(0); QK_LD(1);
#pragma unroll
    for (int ks = 0; ks < NKS; ++ks) {
        if (ks + 2 < NKS) QK_LD(ks + 2);
        if (NOMMA) { asm volatile("" :: "v"(fa[ks % 3]), "v"(fb[ks % 3])); }
        else { p0 = __builtin_amdgcn_mfma_f32_32x32x16_bf16(fa[ks % 3], qf[ks], p0, 0, 0, 0);
        p1 = __builtin_amdgcn_mfma_f32_32x32x16_bf16(fb[ks % 3], qf[ks], p1, 0, 0, 0); }
        __builtin_amdgcn_sched_barrier(0);
    }
#undef QK_LD
}
struct Soft { float mhat, l; };
template <bool SCALED>
__device__ __forceinline__ void softmax_tile(f32x16& p0, f32x16& p1, Soft& st, f32x16 (&o)[4], bool first, LAS float* wsf, int r32, int hi, float cb = 0.f) {
#if !ATT_RESCALE
    if (first) {
#endif
    float a = fmaxf(p0[0], p1[0]), b = fmaxf(p0[1], p1[1]);
#pragma unroll
    for (int r = 2; r < 16; r += 2) { a = fmaxf(a, fmaxf(p0[r], p1[r])); b = fmaxf(b, fmaxf(p0[r + 1], p1[r + 1])); }
    float rm = xhalf_max(fmaxf(a, b));
    if (!SCALED) rm = fmaf(rm, C2, cb);
    if (first) { st.mhat = rm > -1e30f ? rm : 0.f; }
#if !ATT_RESCALE
    }
#endif
#if ATT_RESCALE
    else if (__any(rm > st.mhat + THR)) {
        const float nm = fmaxf(st.mhat, rm); const float f = __builtin_amdgcn_exp2f(st.mhat - nm); st.l *= f; st.mhat = nm;
        if (hi == 0) wsf[r32] = f;
        LDS_WAIT();
        LAS float* wb = wsf + 4 * hi; asm volatile("" : "+v"(wb));
#pragma unroll
        for (int r = 0; r < 16; ++r) { const float fr = wb[(r & 3) + 8 * (r >> 2)];
#pragma unroll
            for (int d = 0; d < 4; ++d) o[d][r] *= fr;
            asm volatile("" ::: "memory"); }
    }
#endif
    float s = 0.f; const float nb = SCALED ? -st.mhat : cb - st.mhat;
#pragma unroll
    for (int r = 0; r < 16; ++r) {
        if (SCALED) { p0[r] = __builtin_amdgcn_exp2f(p0[r] + nb); p1[r] = __builtin_amdgcn_exp2f(p1[r] + nb); }
        else { p0[r] = __builtin_amdgcn_exp2f(fmaf(p0[r], C2, nb)); p1[r] = __builtin_amdgcn_exp2f(fmaf(p1[r], C2, nb)); }
        s += p0[r] + p1[r]; }
    st.l += s;
}
__device__ __forceinline__ float rowmax32(const f32x16& p0, const f32x16& p1) {
    float a = fmaxf(p0[0], p1[0]), b = fmaxf(p0[1], p1[1]);
#pragma unroll
    for (int r = 2; r < 16; r += 2) { a = fmaxf(a, fmaxf(p0[r], p1[r])); b = fmaxf(b, fmaxf(p0[r + 1], p1[r + 1])); }
    return xhalf_max(fmaxf(a, b));
}
template <int NKS, bool NOMMA, int MODE = 0, bool NOEXP = false, bool NOLDS = false>
__device__ __forceinline__ float qk_tile_x(f32x16& p0, f32x16& p1, lds_cptr kslot, const bf16x8* qf, int r32, int hi, float nb, int kd = 0) {
    const lds_cptr kb = kslot + hi * 1024 + r32 * 16;
    p0 = f32x16{}; p1 = f32x16{};
    bf16x8 fr[6]; float ls = 0.f;
#define QX_LD(s_) do { if (NOLDS) { fr[(s_) % 6] = qf[(s_) % NKS]; } else fr[(s_) % 6] = *(const LAS bf16x8*)(kb + ((s_) % NKS) * 2048 + ((s_) / NKS) * 512); } while (0)
#define QX_EXP(e_) do { if (NOEXP) break; const float nb_ = (MODE == 1 && (((e_) & 3) + 8 * ((e_) >> 2)) > kd) ? -INFINITY : nb; p0[e_] = __builtin_amdgcn_exp2f(fmaf(p0[e_], C2, nb_)); ls += p0[e_]; } while (0)
    QX_LD(0); QX_LD(1); QX_LD(2); QX_LD(3); QX_LD(4);
#pragma unroll
    for (int s_ = 0; s_ < 2 * NKS; ++s_) {
        if (s_ + 5 < 2 * NKS) QX_LD(s_ + 5);
        if (s_ < NKS) { if (!NOMMA) p0 = __builtin_amdgcn_mfma_f32_32x32x16_bf16(fr[s_ % 6], qf[s_], p0, 0, 0, 0); else asm volatile("" :: "v"(fr[s_ % 6])); }
        else {
            if (!NOMMA) p1 = __builtin_amdgcn_mfma_f32_32x32x16_bf16(fr[s_ % 6], qf[s_ - NKS], p1, 0, 0, 0); else asm volatile("" :: "v"(fr[s_ % 6]));
            const int g_ = s_ - NKS - 2;
            if (g_ >= 0 && g_ < 6) { QX_EXP(2 * g_); QX_EXP(2 * g_ + 1); }
            else if (g_ >= 6) { QX_EXP(6 + g_); }
        }
        __builtin_amdgcn_sched_barrier(0);
    }
#undef QX_LD
#undef QX_EXP
    return ls;
}
template <bool NOMMA, int MODE = 0, bool NOEXP = false, bool NOLDS = false>
__device__ __forceinline__ float pv_tile_x(f32x16 (&o)[4], const f32x16& p0, f32x16& p1, float nb, lds_cptr vslot, int lane, int hi, int kd = 0) {
    const lds_cptr vp = vslot + ((lane >> 4) & 1) * 32 + (lane & 3) * 8 + (4 * hi + ((lane & 15) >> 2)) * 64;
    u32x4 pw[4]; float ls = 0.f;
    pw[0] = (u32x4){cvtpk(p0[0], p0[1]), cvtpk(p0[2], p0[3]), cvtpk(p0[4], p0[5]), cvtpk(p0[6], p0[7])};
    pw[1] = (u32x4){cvtpk(p0[8], p0[9]), cvtpk(p0[10], p0[11]), cvtpk(p0[12], p0[13]), cvtpk(p0[14], p0[15])};
    s16x4 vlo[5], vhi[5];
#define PX_LD(st_) do { if (NOLDS) { vlo[(st_) % 5] = __builtin_bit_cast(s16x4, (unsigned long long)(st_) * 0x0101010101010101ull + (unsigned long long)lane); vhi[(st_) % 5] = vlo[(st_) % 5]; } else { vlo[(st_) % 5] = vtr(vp + ((st_) & 3) * 4096 + ((st_) >> 2) * 1024); vhi[(st_) % 5] = vtr(vp + ((st_) & 3) * 4096 + ((st_) >> 2) * 1024 + 512); } } while (0)
    PX_LD(0); PX_LD(1); PX_LD(2); PX_LD(3);
#pragma unroll
    for (int st_ = 0; st_ < 16; ++st_) {
        if (st_ + 4 < 16) PX_LD(st_ + 4);
        if (st_ == 8) { pw[2] = (u32x4){cvtpk(p1[0], p1[1]), cvtpk(p1[2], p1[3]), cvtpk(p1[4], p1[5]), cvtpk(p1[6], p1[7])};
                        pw[3] = (u32x4){cvtpk(p1[8], p1[9]), cvtpk(p1[10], p1[11]), cvtpk(p1[12], p1[13]), cvtpk(p1[14], p1[15])}; }
        const s16x4 lo = vlo[st_ % 5], hh = vhi[st_ % 5];
        const bf16x8 vf = (bf16x8){lo[0], lo[1], lo[2], lo[3], hh[0], hh[1], hh[2], hh[3]};
        if (!NOMMA) o[st_ & 3] = __builtin_amdgcn_mfma_f32_32x32x16_bf16(__builtin_bit_cast(bf16x8, pw[st_ >> 2]), vf, o[st_ & 3], 0, 0, 0); else asm volatile("" :: "v"(vf), "v"(pw[st_ >> 2]));
        if (NOEXP) { } else if (st_ < 8) {
#define PX_NB(e_) ((MODE == 1 && (((e_) & 3) + 8 * ((e_) >> 2) + 32) > kd) ? -INFINITY : nb)
            p1[2 * st_] = __builtin_amdgcn_exp2f(fmaf(p1[2 * st_], C2, PX_NB(2 * st_))); p1[2 * st_ + 1] = __builtin_amdgcn_exp2f(fmaf(p1[2 * st_ + 1], C2, PX_NB(2 * st_ + 1)));
#undef PX_NB
        }
        else { ls += p1[2 * (st_ - 8)] + p1[2 * (st_ - 8) + 1]; }
        __builtin_amdgcn_sched_barrier(0);
    }
#undef PX_LD
    return ls;
}
template <bool NOBAR = false>
__device__ __forceinline__ void wait_bar_n(int n) {
    if (NOBAR) { asm volatile("s_waitcnt vmcnt(0) lgkmcnt(0)" ::: "memory"); return; }
    if (n == 3) asm volatile("s_waitcnt vmcnt(3) lgkmcnt(0)\n\ts_barrier" ::: "memory");
    else if (n == 2) asm volatile("s_waitcnt vmcnt(2) lgkmcnt(0)\n\ts_barrier" ::: "memory");
    else asm volatile("s_waitcnt vmcnt(0) lgkmcnt(0)\n\ts_barrier" ::: "memory");
}
template <bool G1, int NKP, int NVP, bool NOBAR, class SK, class SV, class FA, class FB>
__device__ __forceinline__ void tile_stream_g(int nt, SK stageK, SV stageV, FA fa, FB fb) {
    if (nt <= 0) return;
    stageK(0, 0); stageV(0, 0);
    if (nt > 1) { stageK(1, 1); stageV(1, 1); }
    int pend = 0;
    if (G1) { wait_bar_n<NOBAR>(0); }
    for (int t = 0; t < nt; ++t) {
        f32x16 p0 = f32x16{}, p1 = f32x16{};
        wait_bar_n<NOBAR>(pend); pend = 0;
        if (G1) { if (t >= 1 && t + 1 < nt) { stageV(t + 1, (t + 1) & 1); pend = NVP; } } else { if (t >= 1 && t + 1 < nt) { stageK(t + 1, (t + 1) & 1); pend = NKP; } }
        fa(t, t & 1, p0, p1);
        wait_bar_n<NOBAR>(pend); pend = 0;
        if (G1) { if (t + 2 < nt) { stageK(t + 2, t & 1); pend = NKP; } } else { if (t >= 1 && t + 1 < nt) { stageV(t + 1, (t + 1) & 1); pend = NVP; } }
        fb(t, t & 1, p0, p1);
    }
    if (!G1) { wait_bar_n<NOBAR>(pend); }
}
template <bool NOBAR, class SK, class SV, class FA, class FB>
__device__ __forceinline__ void tile_stream_1(int nt, SK stageK, SV stageV, FA fa, FB fb) {
    if (nt <= 0) return;
    stageK(0, 0); stageV(0, 0);
    for (int t = 0; t < nt; ++t) {
        f32x16 p0 = f32x16{}, p1 = f32x16{};
        wait_bar_n<NOBAR>(0);
        if (t + 1 < nt) { stageK(t + 1, (t + 1) & 1); stageV(t + 1, (t + 1) & 1); }
        fa(t, t & 1, p0, p1);
        fb(t, t & 1, p0, p1);
    }
    wait_bar_n<NOBAR>(0);
}
template <bool NOBAR, class GI, class SK, class SV, class FA, class FB>
__device__ __forceinline__ void tile_stream_id(int nt, GI getid, SK stageK, SV stageV, FA fa, FB fb) {
    if (nt <= 0) return;
    int idn = getid(0);
    stageK(0, 0, idn); stageV(0, 0, idn);
    for (int t = 0; t < nt; ++t) {
        const int idc = idn;
        if (t + 1 < nt) idn = getid(t + 1);
        f32x16 p0 = f32x16{}, p1 = f32x16{};
        wait_bar_n<NOBAR>(0);
        if (t + 1 < nt) { stageK(t + 1, (t + 1) & 1, idn); stageV(t + 1, (t + 1) & 1, idn); }
        fa(t, t & 1, idc, p0, p1);
        fb(t, t & 1, idc, p0, p1);
    }
    wait_bar_n<NOBAR>(0);
}
template <int NKP, int NVP, bool NOBAR = false, class SK, class SV, class FA, class FB>
__device__ __forceinline__ void tile_stream(int nt, bool g1, SK stageK, SV stageV, FA fa, FB fb) {
#if ATT_STAGGER
    if (g1) tile_stream_g<true, NKP, NVP, NOBAR>(nt, stageK, stageV, fa, fb); else tile_stream_g<false, NKP, NVP, NOBAR>(nt, stageK, stageV, fa, fb);
#else
    tile_stream_1<NOBAR>(nt, stageK, stageV, fa, fb);
#endif
}
template <bool NOMMA = false>
__device__ __forceinline__ void pv_tile(f32x16 (&o)[4], const f32x16& p0, const f32x16& p1, lds_cptr vslot, int lane, int hi) {
    const lds_cptr vp = vslot + ((lane >> 4) & 1) * 32 + (lane & 3) * 8 + (4 * hi + ((lane & 15) >> 2)) * 64;
    u32x4 pw[4];
    pw[0] = (u32x4){cvtpk(p0[0], p0[1]), cvtpk(p0[2], p0[3]), cvtpk(p0[4], p0[5]), cvtpk(p0[6], p0[7])};
    pw[1] = (u32x4){cvtpk(p0[8], p0[9]), cvtpk(p0[10], p0[11]), cvtpk(p0[12], p0[13]), cvtpk(p0[14], p0[15])};
    pw[2] = (u32x4){cvtpk(p1[0], p1[1]), cvtpk(p1[2], p1[3]), cvtpk(p1[4], p1[5]), cvtpk(p1[6], p1[7])};
    pw[3] = (u32x4){cvtpk(p1[8], p1[9]), cvtpk(p1[10], p1[11]), cvtpk(p1[12], p1[13]), cvtpk(p1[14], p1[15])};
    s16x4 vlo[5], vhi[5];
#define PV_LD(st_) do { vlo[(st_) % 5] = vtr(vp + ((st_) >> 2) * 4096 + ((st_) & 3) * 1024); vhi[(st_) % 5] = vtr(vp + ((st_) >> 2) * 4096 + ((st_) & 3) * 1024 + 512); } while (0)
    PV_LD(0); PV_LD(1); PV_LD(2); PV_LD(3);
#pragma unroll
    for (int st_ = 0; st_ < 16; ++st_) {
        if (st_ + 4 < 16) PV_LD(st_ + 4);
        const s16x4 lo = vlo[st_ % 5], hh = vhi[st_ % 5];
        const bf16x8 vf = (bf16x8){lo[0], lo[1], lo[2], lo[3], hh[0], hh[1], hh[2], hh[3]};
        if (NOMMA) { asm volatile("" :: "v"(vf), "v"(pw[st_ & 3])); } else
        o[st_ >> 2] = __builtin_amdgcn_mfma_f32_32x32x16_bf16(__builtin_bit_cast(bf16x8, pw[st_ & 3]), vf, o[st_ >> 2], 0, 0, 0);
        __builtin_amdgcn_sched_barrier(0);
    }
#undef PV_LD
}
__device__ __forceinline__ void mla_stage_k(int tl, int h, const bf16* KV, const bf16* KR, unsigned kdst, int wid) {
    const int lane = lane_id();
    const size_t row = (size_t)(64 * tl + lane);
    glds16(KV + row * 2048 + h * 256 + wid * 8, (unsigned)__builtin_amdgcn_readfirstlane(kdst + wid * 1024));
    glds16(KV + row * 2048 + h * 256 + (wid + 8) * 8, (unsigned)__builtin_amdgcn_readfirstlane(kdst + (wid + 8) * 1024));
    glds16(KR + row * 64 + wid * 8, (unsigned)__builtin_amdgcn_readfirstlane(kdst + (wid + 16) * 1024));
}
__device__ __forceinline__ void mla_stage_v(int tl, int h, const bf16* KV, unsigned vdst, int wid) {
    const int lane = lane_id();
#pragma unroll
    for (int i = 0; i < 2; ++i) { const int p = wid + 8 * i, d0 = p >> 2, ks = p & 3;
        glds16(KV + (size_t)(64 * tl + 16 * ks + (lane >> 2)) * 2048 + h * 256 + 128 + d0 * 32 + (lane & 3) * 8, (unsigned)__builtin_amdgcn_readfirstlane(vdst + p * 1024)); }
}
template <int probe>
__device__ __forceinline__ void mla_unit(int h, int qb, const bf16* Q, const bf16* KV, const bf16* KR, const float* rope_cs, bf16* MIX, LAS unsigned char* shm, int wid) {
    const unsigned lds0 = (unsigned)(uintptr_t)shm;
    const lds_cptr shc = (lds_cptr)shm; LAS float* wsf = (LAS float*)(shm + L_WSF) + wid * 64;
    const int q0w = qb * 256 + wid * 32;
    bf16x8 qf[12];
    { const int lane = lane_id(); const int r32 = lane & 31, hi = lane >> 5; const bf16* qp = Q + (size_t)(q0w + r32) * 1536 + h * 192 + hi * 8;
#pragma unroll
      for (int ks = 0; ks < 12; ++ks) qf[ks] = *(const bf16x8*)(qp + ks * 16);
      const float* cp = rope_cs + (size_t)(q0w + r32) * 32 + hi * 8; const float* sp = cp + 8192 * 32;
#pragma unroll
      for (int kk = 0; kk < 2; ++kk) {
          const f32x4 c0 = *(const f32x4*)(cp + 16 * kk), c1 = *(const f32x4*)(cp + 16 * kk + 4), s0 = *(const f32x4*)(sp + 16 * kk), s1 = *(const f32x4*)(sp + 16 * kk + 4);
          const float cc[8] = {c0[0], c0[1], c0[2], c0[3], c1[0], c1[1], c1[2], c1[3]}, ss[8] = {s0[0], s0[1], s0[2], s0[3], s1[0], s1[1], s1[2], s1[3]};
          bf16x8 a = qf[8 + kk], b = qf[10 + kk];
#pragma unroll
          for (int j = 0; j < 8; ++j) { const float x1 = bf1((bf16)a[j]), x2 = bf1((bf16)b[j]);
              a[j] = (short)f2bf(x1 * cc[j] - x2 * ss[j]); b[j] = (short)f2bf(x1 * ss[j] + x2 * cc[j]); }
          qf[8 + kk] = a; qf[10 + kk] = b;
      } }
    const int NT = 4 * qb + 4, myNT = (q0w + 31) / 64 + 1, NF = 4 * qb;
    Soft st; st.mhat = 0.f; st.l = 0.f; f32x16 o[4]; o[0] = f32x16{}; o[1] = f32x16{}; o[2] = f32x16{}; o[3] = f32x16{};
    {
        const int lane = lane_id(); const int r32 = lane & 31, hi = lane >> 5;
        f32x16 p0, p1;
        if (!(probe & 1)) mla_stage_k(0, h, KV, KR, lds0 + L_K, wid);
        ATT_WAIT_BAR();
        if (!(probe & 2)) {
            qk_tile<12, (probe & 8) != 0>(p0, p1, shc + L_K, qf, r32, hi);
            if (qb == 0) { const int q = q0w + r32, kb = 4 * hi;
#pragma unroll
                for (int r = 0; r < 16; ++r) { const int kv = kb + (r & 3) + 8 * (r >> 2); p0[r] = kv > q ? -INFINITY : p0[r]; p1[r] = kv + 32 > q ? -INFINITY : p1[r]; } }
            st.mhat = rowmax32(p0, p1) * C2;
        }
        ATT_WAIT_BAR();
    }
    {
        const int lane = lane_id(); const int r32 = lane & 31, hi = lane >> 5;
        tile_stream<3, 2, (probe & 4) != 0>(NF, wid >= 4,
            [&](int t, int sl) { if (probe & 1) return; mla_stage_k(t, h, KV, KR, lds0 + L_K + sl * KSLOT, wid); },
            [&](int t, int sl) { if (probe & 1) return; mla_stage_v(t, h, KV, lds0 + L_V + sl * VSLOT, wid); },
            [&](int t, int sl, f32x16& p0, f32x16& p1) {
                if (probe & 2) return;
                st.l += qk_tile_x<12, (probe & 8) != 0, 0, (probe & 16) != 0, (probe & 32) != 0>(p0, p1, shc + L_K + sl * KSLOT, qf, r32, hi, -st.mhat); },
            [&](int t, int sl, f32x16& p0, f32x16& p1) {
                if (probe & 2) return;
                st.l += pv_tile_x<(probe & 8) != 0, 0, (probe & 16) != 0, (probe & 32) != 0>(o, p0, p1, -st.mhat, shc + L_V + sl * VSLOT, lane, hi); });
    }
    {
        const int lane = lane_id(); const int r32 = lane & 31, hi = lane >> 5;
        tile_stream<3, 2, (probe & 4) != 0>(4, wid >= 4,
            [&](int t, int sl) { if (probe & 1) return; mla_stage_k(NF + t, h, KV, KR, lds0 + L_K + sl * KSLOT, wid); },
            [&](int t, int sl) { if (probe & 1) return; mla_stage_v(NF + t, h, KV, lds0 + L_V + sl * VSLOT, wid); },
            [&](int t, int sl, f32x16& p0, f32x16& p1) {
                if (NF + t >= myNT || (probe & 2)) return;
                st.l += qk_tile_x<12, (probe & 8) != 0, 1>(p0, p1, shc + L_K + sl * KSLOT, qf, r32, hi, -st.mhat, q0w + r32 - 64 * (NF + t) - 4 * hi); },
            [&](int t, int sl, f32x16& p0, f32x16& p1) {
                if (NF + t >= myNT || (probe & 2)) return;
                st.l += pv_tile_x<(probe & 8) != 0, 1>(o, p0, p1, -st.mhat, shc + L_V + sl * VSLOT, lane, hi, q0w + r32 - 64 * (NF + t) - 4 * hi); });
    }
    const int lane = lane_id(); const int r32 = lane & 31, hi = lane >> 5;
    const float lt = xhalf_sum(st.l);
    if (hi == 0) wsf[32 + r32] = lt;
    LDS_WAIT();
    const int le = lane_id(); const int r32e = le & 31, hie = le >> 5;
    bf16* op = MIX + (size_t)q0w * 2048 + h * 128 + r32e;
#pragma unroll
    for (int r = 0; r < 16; ++r) { const float rl = __builtin_amdgcn_rcpf(wsf[32 + crow(r, hie)]); bf16* orow = op + (size_t)crow(r, hie) * 2048;
#pragma unroll
        for (int d0 = 0; d0 < 4; ++d0) orow[d0 * 32] = (bf16)f2bf(o[d0][r] * rl * (1.f + PROBE_A2)); }
    ATT_WAIT_BAR();
}
}

namespace att {
__device__ __forceinline__ float dpp_xor1(float v) { return __builtin_bit_cast(float, __builtin_amdgcn_update_dpp(0, __builtin_bit_cast(int, v), 0xB1, 0xF, 0xF, true)); }
__device__ __forceinline__ float dpp_xor2(float v) { return __builtin_bit_cast(float, __builtin_amdgcn_update_dpp(0, __builtin_bit_cast(int, v), 0x4E, 0xF, 0xF, true)); }
__device__ __forceinline__ int t5b(int d) {
    if (d < 16) return d;
    int b = 16;
    b += d >= 19; b += d >= 21; b += d >= 24; b += d >= 27; b += d >= 31; b += d >= 35; b += d >= 40; b += d >= 46; b += d >= 52; b += d >= 59; b += d >= 67; b += d >= 77; b += d >= 87; b += d >= 99; b += d >= 113;
    return b;
}
__device__ __forceinline__ void stage_kv(const bf16* krow0, size_t kpitch, const bf16* vrow0, size_t vpitch, unsigned kdst, unsigned vdst, bool withV, int wid, int lane) {
    lane = lane_id();
    const bf16* kp = krow0 + (size_t)lane * kpitch + wid * 8;
    glds16(kp, (unsigned)__builtin_amdgcn_readfirstlane(kdst + wid * 1024));
    glds16(kp + 64, (unsigned)__builtin_amdgcn_readfirstlane(kdst + (wid + 8) * 1024));
    glds16(kp + 128, (unsigned)__builtin_amdgcn_readfirstlane(kdst + (wid + 16) * 1024));
    if (withV) {
#pragma unroll
        for (int i = 0; i < 2; ++i) { const int p = wid + 8 * i, d0 = p >> 2, ks = p & 3;
            glds16(vrow0 + (size_t)(16 * ks + (lane >> 2)) * vpitch + d0 * 32 + (lane & 3) * 8, (unsigned)__builtin_amdgcn_readfirstlane(vdst + p * 1024)); }
    }
}
__device__ __forceinline__ void stage_k(const bf16* krow0, size_t kpitch, unsigned kdst, int wid) {
    const int lane = lane_id();
    const bf16* kp = krow0 + (size_t)lane * kpitch + wid * 8;
    glds16(kp, (unsigned)__builtin_amdgcn_readfirstlane(kdst + wid * 1024));
    glds16(kp + 64, (unsigned)__builtin_amdgcn_readfirstlane(kdst + (wid + 8) * 1024));
    glds16(kp + 128, (unsigned)__builtin_amdgcn_readfirstlane(kdst + (wid + 16) * 1024));
}
__device__ __forceinline__ void stage_v(const bf16* vrow0, size_t vpitch, unsigned vdst, int wid) {
    const int lane = lane_id();
#pragma unroll
    for (int i = 0; i < 2; ++i) { const int p = wid + 8 * i, d0 = p >> 2, ks = p & 3;
        glds16(vrow0 + (size_t)(16 * ks + (lane >> 2)) * vpitch + d0 * 32 + (lane & 3) * 8, (unsigned)__builtin_amdgcn_readfirstlane(vdst + p * 1024)); }
}
struct TileP { int pbase, pstride, dmax; bool lookup, mask; };
__device__ __forceinline__ void logits(f32x16& p0, f32x16& p1, int tq, bool rowsel, const TileP tp, float cbias, const LAS float* bt, int hi) {
    if (tp.lookup || tp.mask) {
        const int dq = tq - tp.pbase - tp.pstride * 4 * hi;
#pragma unroll
        for (int r = 0; r < 16; ++r) {
            const int d0 = dq - tp.pstride * ((r & 3) + 8 * (r >> 2)), d1 = d0 - 32 * tp.pstride;
            const bool v0 = rowsel && d0 >= 0 && d0 <= tp.dmax, v1 = rowsel && d1 >= 0 && d1 <= tp.dmax;
            float b0 = cbias, b1 = cbias;
            if (tp.lookup) { b0 = bt[min(max(d0, 0), 127)]; b1 = bt[min(max(d1, 0), 127)]; }
            p0[r] = v0 ? fmaf(p0[r], C2, b0) : -INFINITY; p1[r] = v1 ? fmaf(p1[r], C2, b1) : -INFINITY;
            if ((r & 3) == 3) __builtin_amdgcn_sched_barrier(0);
        }
    } else {
#pragma unroll
        for (int r = 0; r < 16; ++r) { p0[r] = rowsel ? fmaf(p0[r], C2, cbias) : -INFINITY; p1[r] = rowsel ? fmaf(p1[r], C2, cbias) : -INFINITY; }
    }
}
__device__ __forceinline__ void nsa_out(const f32x16 (&o)[4], const LAS float* wsf, int mode, float* MIXF, float* MIXF1, bf16* MIX, int trow0, int g, int lane) {
    const int le = lane_id(); const int r32e = le & 31, hie = le >> 5;
#pragma unroll
    for (int rb = 0; rb < 16; rb += 4) {
        float pa[4][4], pb[4][4];
        if (mode == 2) {
#pragma unroll
            for (int r = rb; r < rb + 4; ++r) { const int q = crow(r, hie); const size_t off = (size_t)(trow0 + (q >> 2)) * 1024 + (size_t)((4 * g + (q & 3)) * 128 + r32e);
#pragma unroll
                for (int d0 = 0; d0 < 4; ++d0) { pa[r - rb][d0] = __builtin_nontemporal_load(MIXF + off + d0 * 32); pb[r - rb][d0] = __builtin_nontemporal_load(MIXF1 + off + d0 * 32); } }
        }
#pragma unroll
        for (int r = rb; r < rb + 4; ++r) {
            const int q = crow(r, hie); const float sc = wsf[q];
            const size_t off = (size_t)(trow0 + (q >> 2)) * 1024 + (size_t)((4 * g + (q & 3)) * 128 + r32e);
#pragma unroll
            for (int d0 = 0; d0 < 4; ++d0) {
                const float v = o[d0][r] * sc;
                if (mode == 0) MIXF[off + d0 * 32] = v;
                else if (mode == 1) MIXF1[off + d0 * 32] = v;
                else MIX[(size_t)(trow0 + (q >> 2)) * 2048 + 1024 + (4 * g + (q & 3)) * 128 + r32e + d0 * 32] = (bf16)f2bf(((pa[r - rb][d0] + pb[r - rb][d0]) + v) * (1.f + PROBE_A3));
            }
        }
    }
}

template <int probe>
__device__ __forceinline__ void nsa_unit(int i, int g, const bf16* U, const bf16* KC, const bf16* VC, const float* rel_bias, float* MIXF, float* MIXF1, bf16* MIX, LAS unsigned char* shm, int wid) {
    const unsigned lds0 = (unsigned)(uintptr_t)shm; const lds_cptr shc = (lds_cptr)shm;
    LAS float* wsf = (LAS float*)(shm + L_WSF) + wid * 64; LAS float* btab = (LAS float*)(shm + L_BT); LAS float* imp = (LAS float*)(shm + L_IMP);
    LAS unsigned* selw = (LAS unsigned*)(shm + L_SEL); LAS unsigned* uni = (LAS unsigned*)(shm + L_MISC); LAS unsigned char* blist = (LAS unsigned char*)(shm + L_LIST);
    const int t0 = 64 * i, trow0 = t0 + 8 * wid; const bool g1 = wid >= 4;
    auto nsa_gate = [&](int b) -> float { const int r_ = lane_id() & 31, tq_ = trow0 + (r_ >> 2), hd_ = 4 * g + (r_ & 3);
        return 1.f / (1.f + __expf(-bf1(U[(size_t)tq_ * DINP + O_GN + hd_ * 3 + b]))); };
#define NSA_DERIVE() const int lane = lane_id(); const int r32 = lane & 31, hi = lane >> 5; const int tq = trow0 + (r32 >> 2), hd = r32 & 3, head = 4 * g + hd; \
    const LAS float* bt = btab + hd * 128; const float c31 = bt[127]; (void)tq; (void)c31; (void)bt; (void)hi; (void)head
    bf16x8 qf[12];
    f32x16 o[4];
    { const int tid = wid * 64 + lane_id();
      for (int k = tid; k < 8192; k += NTHR) imp[k] = 0.f;
      { const int hh = tid >> 7, d = tid & 127; btab[tid] = rel_bias[t5b(d) * 8 + 4 * g + hh] * LOG2E; }
      if (tid < 4) uni[tid] = 0u; }
    { NSA_DERIVE();
      const bf16* qp = U + (size_t)tq * DINP + O_QN + head * 192 + hi * 8;
#pragma unroll
      for (int ks = 0; ks < 12; ++ks) qf[ks] = *(const bf16x8*)(qp + ks * 16); }
    const int nct = (4 * i + 3 + 63) >> 6;
    const bf16* kc0 = KC + g * 256; const bf16* vc0 = VC + g * 256;
    float m = 0.f, inv_lc = 0.f;
    ATT_WAIT_BAR();
    { NSA_DERIVE();
      float l = 0.f;
      tile_stream<3, 0, (probe & 4) != 0>(nct, g1,
        [&](int ct, int sl) { if (probe & 1) return; stage_k(kc0 + (size_t)(64 * ct) * 512, 512, lds0 + L_K + sl * KSLOT, wid); },
        [&](int ct, int sl) {},
        [&](int ct, int sl, f32x16& p0, f32x16& p1) {
            if (probe & 2) return;
            qk_tile<12, (probe & 8) != 0>(p0, p1, shc + L_K + sl * KSLOT, qf, r32, hi);
            const TileP tp{16 * 64 * ct + 31, 16, 1 << 30, ct >= nct - 2, true};
            logits(p0, p1, tq, true, tp, c31, bt, hi); },
        [&](int ct, int sl, f32x16& p0, f32x16& p1) {
            if (probe & 2) return;
            const float rm = rowmax32(p0, p1);
            if (ct == 0) m = rm > -1e30f ? rm : 0.f;
            else { const float nm = fmaxf(m, rm); l *= __builtin_amdgcn_exp2f(m - nm); m = nm; }
            float s = 0.f;
#pragma unroll
            for (int r = 0; r < 16; ++r) s += __builtin_amdgcn_exp2f(p0[r] - m) + __builtin_amdgcn_exp2f(p1[r] - m);
            l += s; });
      const float lc = xhalf_sum(l); inv_lc = lc > 0.f ? 1.f / lc : 0.f; }
    { NSA_DERIVE();
      o[0] = f32x16{}; o[1] = f32x16{}; o[2] = f32x16{}; o[3] = f32x16{};
      tile_stream<3, 2, (probe & 4) != 0>(nct, g1,
        [&](int ct, int sl) { if (probe & 1) return; stage_k(kc0 + (size_t)(64 * ct) * 512, 512, lds0 + L_K + sl * KSLOT, wid); },
        [&](int ct, int sl) { if (probe & 1) return; stage_v(vc0 + (size_t)(64 * ct) * 512, 512, lds0 + L_V + sl * VSLOT, wid); },
        [&](int ct, int sl, f32x16& p0, f32x16& p1) {
            if (probe & 2) return;
            qk_tile<12, (probe & 8) != 0>(p0, p1, shc + L_K + sl * KSLOT, qf, r32, hi);
            const TileP tp{16 * 64 * ct + 31, 16, 1 << 30, ct >= nct - 2, true};
            logits(p0, p1, tq, true, tp, c31, bt, hi); },
        [&](int ct, int sl, f32x16& p0, f32x16& p1) {
            if (probe & 2) return;
#pragma unroll
            for (int r = 0; r < 16; ++r) { p0[r] = __builtin_amdgcn_exp2f(p0[r] - m) * inv_lc; p1[r] = __builtin_amdgcn_exp2f(p1[r] - m) * inv_lc; }
            LAS float* iq = imp + (8 * wid + (r32 >> 2)) * 128 + 16 * ct + hi;
#pragma unroll
            for (int a = 0; a < 4; ++a) {
#pragma unroll
                for (int kh = 0; kh < 2; ++kh) {
                    const f32x16& pp = kh ? p1 : p0;
                    float s3 = pp[4 * a + 3], s4 = (pp[4 * a] + pp[4 * a + 1]) + (pp[4 * a + 2] + s3);
                    s4 += dpp_xor1(s4); s4 += dpp_xor2(s4); s3 += dpp_xor1(s3); s3 += dpp_xor2(s3);
                    const int jj = 8 * kh + 2 * a;
                    if (hd == 0) { __hip_atomic_fetch_add(iq + jj, s4, __ATOMIC_RELAXED, __HIP_MEMORY_SCOPE_WORKGROUP);
                        if (16 * ct + hi + jj + 1 < 128) __hip_atomic_fetch_add(iq + jj + 1, s3, __ATOMIC_RELAXED, __HIP_MEMORY_SCOPE_WORKGROUP); }
                }
            }
            pv_tile<(probe & 8) != 0>(o, p0, p1, shc + L_V + sl * VSLOT, lane, hi); });
      if (hi == 0) wsf[r32] = nsa_gate(0);
      LDS_WAIT();
      nsa_out(o, wsf, 0, MIXF, MIXF1, MIX, trow0, g, lane); }
    unsigned long long wm_lo = 0ull, wm_hi = 0ull;
    {
        const int lane = lane_id();
        const unsigned long long all_lo = (i >= 63) ? ~0ull : ((1ull << (i + 1)) - 1ull), all_hi = (i >= 64) ? ((i >= 127) ? ~0ull : ((1ull << (i - 63)) - 1ull)) : 0ull;
        unsigned long long s_lo[8], s_hi[8];
#pragma unroll
        for (int ql = 0; ql < 8; ++ql) { s_lo[ql] = all_lo; s_hi[ql] = all_hi; }
        if (i >= 16) {
            unsigned b0[8], b1[8], T[8];
            const int j0 = lane, j1 = lane + 64;
#pragma unroll
            for (int ql = 0; ql < 8; ++ql) { const LAS float* iq = imp + (8 * wid + ql) * 128;
                b0[ql] = (j0 >= 1 && j0 <= i - 2) ? __float_as_uint(iq[j0]) + 1u : 0u;
                b1[ql] = (j1 <= i - 2) ? __float_as_uint(iq[j1]) + 1u : 0u; T[ql] = 0u; }
            for (int bit = 30; bit >= 0; --bit) {
#pragma unroll
                for (int ql = 0; ql < 8; ++ql) { const unsigned c = T[ql] | (1u << bit);
                    const int cnt = __popcll(__ballot(b0[ql] >= c)) + __popcll(__ballot(b1[ql] >= c));
                    T[ql] = cnt >= 13 ? c : T[ql]; }
            }
#pragma unroll
            for (int ql = 0; ql < 8; ++ql) {
                const unsigned long long gt0 = __ballot(b0[ql] > T[ql]), gt1 = __ballot(b1[ql] > T[ql]), eq0 = __ballot(b0[ql] == T[ql]), eq1 = __ballot(b1[ql] == T[ql]);
                int rem = 13 - (__popcll(gt0) + __popcll(gt1));
                unsigned long long e0 = eq0, e1 = eq1, k0 = 0ull, k1 = 0ull;
                while (rem > 0 && e0) { const unsigned long long low = e0 & (~e0 + 1ull); k0 |= low; e0 ^= low; --rem; }
                while (rem > 0 && e1) { const unsigned long long low = e1 & (~e1 + 1ull); k1 |= low; e1 ^= low; --rem; }
                unsigned long long a_lo = gt0 | k0 | 1ull, a_hi = gt1 | k1;
                if (i < 64) a_lo |= (1ull << i) | (1ull << (i - 1));
                else { a_hi |= (1ull << (i - 64)); if (i == 64) a_lo |= (1ull << 63); else a_hi |= (1ull << (i - 65)); }
                s_lo[ql] = a_lo; s_hi[ql] = a_hi;
            }
        }
#pragma unroll
        for (int ql = 0; ql < 8; ++ql) {
            if (lane == 0) { LAS unsigned* sp = selw + (8 * wid + ql) * 4; sp[0] = (unsigned)s_lo[ql]; sp[1] = (unsigned)(s_lo[ql] >> 32); sp[2] = (unsigned)s_hi[ql]; sp[3] = (unsigned)(s_hi[ql] >> 32); }
            wm_lo |= s_lo[ql]; wm_hi |= s_hi[ql];
        }
        if (lane == 0) { __hip_atomic_fetch_or(uni + 0, (unsigned)wm_lo, __ATOMIC_RELAXED, __HIP_MEMORY_SCOPE_WORKGROUP); __hip_atomic_fetch_or(uni + 1, (unsigned)(wm_lo >> 32), __ATOMIC_RELAXED, __HIP_MEMORY_SCOPE_WORKGROUP);
                         __hip_atomic_fetch_or(uni + 2, (unsigned)wm_hi, __ATOMIC_RELAXED, __HIP_MEMORY_SCOPE_WORKGROUP); __hip_atomic_fetch_or(uni + 3, (unsigned)(wm_hi >> 32), __ATOMIC_RELAXED, __HIP_MEMORY_SCOPE_WORKGROUP); }
    }
    ATT_WAIT_BAR();
    if (wid == 0) {
        const int l = lane_id();
        const unsigned long long ulo = ((unsigned long long)uni[1] << 32) | uni[0], uhi = ((unsigned long long)uni[3] << 32) | uni[2];
        const unsigned long long below = (1ull << l) - 1ull;
        const int nlo = __popcll(ulo);
        if ((ulo >> l) & 1ull) blist[__popcll(ulo & below)] = (unsigned char)l;
        if ((uhi >> l) & 1ull) blist[nlo + __popcll(uhi & below)] = (unsigned char)(64 + l);
        if (l == 0) { const int im3 = i - 2;
            const unsigned long long flo = im3 <= 0 ? 0ull : (im3 >= 64 ? ~0ull : ((1ull << im3) - 1ull)), fhi = im3 <= 64 ? 0ull : (im3 >= 128 ? ~0ull : ((1ull << (im3 - 64)) - 1ull));
            uni[4] = (unsigned)(nlo + __popcll(uhi)); uni[5] = (unsigned)(__popcll(ulo & flo) + __popcll(uhi & fhi)); }
    }
    ATT_WAIT_BAR();
    {
        const int nsl = __builtin_amdgcn_readfirstlane((int)uni[4]); const int nfar = i >= 3 ? __builtin_amdgcn_readfirstlane((int)uni[5]) : 0;
        const bf16* ks0 = U + O_KN + 384 + g * 192; const bf16* vs0 = U + O_VN + 256 + g * 128;
        Soft st; st.mhat = 0.f; st.l = 0.f;
        o[0] = f32x16{}; o[1] = f32x16{}; o[2] = f32x16{}; o[3] = f32x16{};
        auto blk = [&](int t) -> int { return __builtin_amdgcn_readfirstlane((int)blist[t]); };
        auto wsel = [&](int j) -> bool { return j < 64 ? ((wm_lo >> j) & 1ull) : ((wm_hi >> (j - 64)) & 1ull); };
        auto getj = [&](int t) -> int { return (int)blist[t]; };
        if (nfar > 0) {
            {
                NSA_DERIVE();
                f32x16 p0, p1;
                if (!(probe & 1)) stage_k(ks0, DINP, lds0 + L_K, wid);
                ATT_WAIT_BAR();
                if (!(probe & 2)) { qk_tile<12, (probe & 8) != 0>(p0, p1, shc + L_K, qf, r32, hi); st.mhat = fmaf(rowmax32(p0, p1), C2, c31); }
                ATT_WAIT_BAR();
            }
            {
                NSA_DERIVE();
                const LAS unsigned* sp = selw + (8 * wid + (r32 >> 2)) * 4;
                const unsigned long long my_lo = ((unsigned long long)sp[1] << 32) | sp[0], my_hi = ((unsigned long long)sp[3] << 32) | sp[2];
                tile_stream_id<(probe & 4) != 0>(nfar, getj,
                    [&](int t, int sl, int jv) { if (probe & 1) return; const int j = __builtin_amdgcn_readfirstlane(jv); stage_k(ks0 + (size_t)(64 * j) * DINP, DINP, lds0 + L_K + sl * KSLOT, wid); },
                    [&](int t, int sl, int jv) { if (probe & 1) return; const int j = __builtin_amdgcn_readfirstlane(jv); stage_v(vs0 + (size_t)(64 * j) * DINP, DINP, lds0 + L_V + sl * VSLOT, wid); },
                    [&](int t, int sl, int jv, f32x16& p0, f32x16& p1) {
                        if (probe & 2) return;
                        const int j = __builtin_amdgcn_readfirstlane(jv); if (!wsel(j)) return;
                        const bool rowsel = ((j < 64 ? my_lo : my_hi) >> (j & 63)) & 1ull;
                        st.l += qk_tile_x<12, (probe & 8) != 0, 0, (probe & 16) != 0, (probe & 32) != 0>(p0, p1, shc + L_K + sl * KSLOT, qf, r32, hi, rowsel ? c31 - st.mhat : -INFINITY); },
                    [&](int t, int sl, int jv, f32x16& p0, f32x16& p1) {
                        if (probe & 2) return;
                        const int j = __builtin_amdgcn_readfirstlane(jv); if (!wsel(j)) return;
                        const bool rowsel = ((j < 64 ? my_lo : my_hi) >> (j & 63)) & 1ull;
                        st.l += pv_tile_x<(probe & 8) != 0, 0, (probe & 16) != 0, (probe & 32) != 0>(o, p0, p1, rowsel ? c31 - st.mhat : -INFINITY, shc + L_V + sl * VSLOT, lane, hi); });
            }
        }
        {
            NSA_DERIVE();
            const LAS unsigned* sp = selw + (8 * wid + (r32 >> 2)) * 4;
            ATT_WAIT_BAR();
            tile_stream<3, 2, (probe & 4) != 0>(nsl - nfar, g1,
                [&](int t, int sl) { if (probe & 1) return; const int j = blk(nfar + t); stage_k(ks0 + (size_t)(64 * j) * DINP, DINP, lds0 + L_K + sl * KSLOT, wid); },
                [&](int t, int sl) { if (probe & 1) return; const int j = blk(nfar + t); stage_v(vs0 + (size_t)(64 * j) * DINP, DINP, lds0 + L_V + sl * VSLOT, wid); },
                [&](int t, int sl, f32x16& p0, f32x16& p1) {
                    if (probe & 2) return;
                    const int j = blk(nfar + t); if (!wsel(j)) return;
                    qk_tile<12, (probe & 8) != 0>(p0, p1, shc + L_K + sl * KSLOT, qf, r32, hi);
                    const bool rowsel = (sp[j >> 5] >> (j & 31)) & 1u;
                    const TileP tp{64 * j, 1, 1 << 30, true, j == i}; logits(p0, p1, tq, rowsel, tp, c31, bt, hi); },
                [&](int t, int sl, f32x16& p0, f32x16& p1) {
                    if (probe & 2) return;
                    const int j = blk(nfar + t); if (!wsel(j)) return;
                    softmax_tile<true>(p0, p1, st, o, nfar == 0 && t == 0, wsf, r32, hi);
                    pv_tile<(probe & 8) != 0>(o, p0, p1, shc + L_V + sl * VSLOT, lane, hi); });
        }
        {
            NSA_DERIVE();
            const float ls = xhalf_sum(st.l);
            if (hi == 0) wsf[r32] = ls > 0.f ? nsa_gate(1) / ls : 0.f;
            LDS_WAIT();
            nsa_out(o, wsf, 1, MIXF, MIXF1, MIX, trow0, g, lane);
        }
    }
    {
        NSA_DERIVE();
        const bf16* kw0 = U + O_KN + 768 + g * 192; const bf16* vw0 = U + O_VN + 512 + g * 128;
        Soft st; st.mhat = 0.f; st.l = 0.f;
        o[0] = f32x16{}; o[1] = f32x16{}; o[2] = f32x16{}; o[3] = f32x16{};
        const int nw = (i >= 8 ? 8 : i) + 1;
        ATT_WAIT_BAR();
        tile_stream<3, 2, (probe & 4) != 0>(nw, g1,
            [&](int t, int sl) { if (probe & 1) return; stage_k(kw0 + (size_t)(64 * (i - t)) * DINP, DINP, lds0 + L_K + sl * KSLOT, wid); },
            [&](int t, int sl) { if (probe & 1) return; stage_v(vw0 + (size_t)(64 * (i - t)) * DINP, DINP, lds0 + L_V + sl * VSLOT, wid); },
            [&](int t, int sl, f32x16& p0, f32x16& p1) {
            if (probe & 2) return;
                qk_tile<12, (probe & 8) != 0>(p0, p1, shc + L_K + sl * KSLOT, qf, r32, hi);
                if (t <= 2 || t == 8) { const TileP tp{64 * (i - t), 1, 511, t <= 2, t == 0 || t == 8}; logits(p0, p1, tq, true, tp, c31, bt, hi); } },
            [&](int t, int sl, f32x16& p0, f32x16& p1) {
            if (probe & 2) return;
                if (t <= 2 || t == 8) softmax_tile<true>(p0, p1, st, o, t == 0, wsf, r32, hi);
                else softmax_tile<false>(p0, p1, st, o, false, wsf, r32, hi, c31);
                pv_tile<(probe & 8) != 0>(o, p0, p1, shc + L_V + sl * VSLOT, lane, hi); });
        const float lw = xhalf_sum(st.l);
        if (hi == 0) wsf[r32] = lw > 0.f ? nsa_gate(2) / lw : 0.f;
        LDS_WAIT();
        nsa_out(o, wsf, 2, MIXF, MIXF1, MIX, trow0, g, lane);
    }
    ATT_WAIT_BAR();
#undef NSA_DERIVE
}
}

__device__ __forceinline__ int att_lane_id() { int l; asm volatile("v_mbcnt_lo_u32_b32 %0, -1, 0\n\tv_mbcnt_hi_u32_b32 %0, -1, %0" : "=v"(l)); return l; }
struct Args { const float* in[27]; float* out; unsigned char* ws; int ph_lo, ph_hi, nbar, pad; };
constexpr int NPHASE = 16;
#ifndef PG8_SP2
#define PG8_SP2 true
#endif
#ifndef PG8_ALIGN
#define PG8_ALIGN true
#endif
#ifndef PROBE_MODE
#define PROBE_MODE 0
#endif
#ifndef PROBE_A1
#define PROBE_A1 0.f
#endif
#ifndef PROBE_A2
#define PROBE_A2 0.f
#endif
#ifndef PROBE_A3
#define PROBE_A3 0.f
#endif
#ifndef PROBE_CLOCK
#define PROBE_CLOCK -1
#endif
#ifndef HALF_TAIL
#define HALF_TAIL 0
#endif
#ifndef DEFER_NORM
#define DEFER_NORM 0
#endif
#ifndef FUSE_NORM
#define FUSE_NORM 0
#endif
#ifndef FUSE_FINAL
#define FUSE_FINAL 0
#endif
#ifndef REPA
#define REPA 1
#endif
#ifndef REPB
#define REPB 1
#endif
#ifndef REPC
#define REPC 1
#endif
#ifndef REP0
#define REP0 1
#endif
#ifndef REP2
#define REP2 1
#endif
#ifndef P0_PARTS
#define P0_PARTS 7
#endif
#ifndef REP3
#define REP3 1
#endif
#ifndef PROBE_STAMP
#define PROBE_STAMP -1
#endif
#ifndef STAMP_END
#define STAMP_END PROBE_STAMP
#endif
#ifndef STAMP_MULT
#define STAMP_MULT 8
#endif
#ifndef REP10
#define REP10 1
#endif
__global__ void __launch_bounds__(NTHR, 2) mega(Args args) {
    extern __shared__ __attribute__((aligned(16))) unsigned char lds[];
    Ctx F;
    F.lds = (LAS unsigned char*)lds;
    F.wave = __builtin_amdgcn_readfirstlane((int)threadIdx.x >> 6);
#define REFRESH_CTX() do { const int l_ = att_lane_id(); F.lane = l_; F.tid = F.wave * 64 + l_; } while (0)
    REFRESH_CTX();
    F.G = gridDim.x; { const int bx = blockIdx.x; F.vcu = (F.G % 8 == 0) ? (bx % 8) * (F.G / 8) + bx / 8 : bx; }
    unsigned char* ws = args.ws;
    volatile LAS unsigned* MISC = (volatile LAS unsigned*)(F.lds + MISC_OFF);
    for (int u = F.tid; u < (LDS_BYTES - LDSCTL_OFF) / 4; u += NTHR) ((LAS unsigned*)(F.lds + LDSCTL_OFF))[u] = 0u;
    __syncthreads();
    XcdBarrier bar; bar.w0 = 0; bar.bar = (unsigned*)(ws + WS_CTL) + 4096; bar.x = 0; bar.st = nullptr;
    const int lo = args.ph_lo, hi = args.ph_hi;
    if (hi - lo > 1) bar = xcd_barrier_post((unsigned*)(ws + WS_CTL) + 4096 + args.nbar * XCD_BAR_WORDS, MISC + 8, F.wave == 0 ? 1 : 0);
#define IN(k) (lo <= (k) && (k) < hi)
#if PROBE_STAMP >= 0
    unsigned long long ts_a = __builtin_amdgcn_s_memrealtime(), ts_b = 0;
#define STAMP_AT(k) do { if ((k) + 1 == PROBE_STAMP) ts_a = __builtin_amdgcn_s_memrealtime(); if ((k) == STAMP_END) ts_b = __builtin_amdgcn_s_memrealtime(); } while (0)
#else
#define STAMP_AT(k) do {} while (0)
#endif
#define SEAM(k) do { if (IN(k) && IN((k) + 1)) xcd_barrier(bar); STAMP_AT(k); } while (0)
    const P0Args pa{args.in[5], args.in[6], args.in[7], args.in[9], args.in[11], args.in[13], args.in[15], args.in[16], args.in[18], args.in[19], args.in[21], args.in[23], args.in[24], args.in[25], args.in[1], args.in[2], ws};
#define CLK_BEGIN(ph) unsigned long long ct0_ = 0, cr0_ = 0; if (PROBE_CLOCK == (ph) && blockIdx.x == 0) { ct0_ = __builtin_amdgcn_s_memtime(); cr0_ = __builtin_amdgcn_s_memrealtime(); }
#define CLK_END(ph) if (PROBE_CLOCK == (ph) && blockIdx.x == 0) { const unsigned long long ct1_ = __builtin_amdgcn_s_memtime(), cr1_ = __builtin_amdgcn_s_memrealtime(); \
        const unsigned long long ticks_ = 1000ull * (ct1_ - ct0_) / (cr1_ - cr0_ + 1ull);     \
        while (__builtin_amdgcn_s_memrealtime() - cr1_ < ticks_) __builtin_amdgcn_s_sleep(8); }
    LAS float* gwt = (LAS float*)(F.lds); LAS float* sht = (LAS float*)(F.lds + 8192);
    const float* x = args.in[0];
    float* X1 = (float*)(ws + WS_X1);
    const float* MOD = (const float*)(ws + WS_MOD);
    bf16* H = (bf16*)(ws + WS_H); bf16* ACT = (bf16*)(ws + WS_ACT); bf16* H2 = (bf16*)(ws + WS_H2); float* X2 = (float*)(ws + WS_Q);
    float* const GWT = (float*)(ws + WS_GW); float* const RSQ = (float*)(ws + WS_CTL) + 32768;
    const bool fuse_final = (F.G == 256) && FUSE_FINAL;
    const bool fuse_norm = (F.G == 256) && FUSE_NORM;

    for (int rep = 0; rep < REP0; ++rep) { if (rep) xcd_barrier(bar);
    if (IN(0)) { REFRESH_CTX();
        p0_prologue(F, pa, rep == 0 ? 7 : P0_PARTS);
        if (blockIdx.x == 0) {
            LAS int* cst = (LAS int*)(F.lds + 65536);
            __syncthreads();
            { const int me = F.tid; cst[me] = me < 256 ? 400 * ((me >> 3) + 1) : 108 * (((me - 256) >> 1) + 1) + 2700;     }
            __syncthreads();
            { const int me = F.tid, cm = cst[me]; int rank = 0;
              for (int k2 = 0; k2 < 512; ++k2) { const int ck = cst[k2]; rank += (ck > cm || (ck == cm && k2 < me)) ? 1 : 0; }
              ((unsigned*)(ws + WS_CTL) + 8192)[rank] = (unsigned)me; }
        }
    }
    }
    SEAM(0);
    if (IN(1)) { REFRESH_CTX(); build_mod_tables(F, ws, args.in[4], args.in[3], 0, true, gwt, sht);
        if (FUSE_NORM || DEFER_NORM || FUSE_FINAL) { const float* modp = (const float*)(ws + WS_MODP); float* gwo = (float*)(ws + WS_GW);
          for (int c = (int)blockIdx.x * NTHR + F.tid; c < 7 * D_; c += F.G * NTHR) { const int which = c / D_, cc = c % D_;
              const int chunk = which == 0 ? 4 : which == 1 ? 3 : which == 2 ? 7 : which == 3 ? 6 : which == 4 ? 2 : which == 5 ? 5 : 8;
              float v = args.in[3][chunk * D_ + cc];
              for (int k2 = 0; k2 < 16; ++k2) v += modp[k2 * 18432 + chunk * D_ + cc];
              if (which == 0) v = args.in[8][cc] * (1.f + v); else if (which == 2) v = args.in[22][cc] * (1.f + v); else if (which == 4) v *= 0.5f * (1.f + PROBE_A1); else if (which == 6) v *= 0.5f;
              gwo[c] = v; } }
        norm_rows_bf16(F, x, H, gwt, sht); __syncthreads(); }
    SEAM(1);
    for (int rep = 0; rep < REP2; ++rep) { if (rep) xcd_barrier(bar);
    if (IN(2)) { REFRESH_CTX(); CLK_BEGIN(2); pg8::Gemm g{H, (const bf16*)(ws + WS_WGU1), S_, 2 * FF_, D_, D_, D_}; pg8::StaticOrder S; S.init(S_, 2 * FF_, F.G, (int)blockIdx.x);
        pg8::EpiSwiglu E{ACT, FF_}; pg8::gemm_phase<pg8::EpiSwiglu, pg8::StaticOrder, PG8_ALIGN, PG8_SP2>(F.lds, g, S, E, F.wave);
        CLK_END(2);
        if (rep == 0) { REFRESH_CTX(); conv_tail(F, pa, 1, NIT_B, (S_ / 256) * (2 * FF_ / 256)); } }
    }
    SEAM(2);
    for (int rep = 0; rep < REP3; ++rep) { if (rep) xcd_barrier(bar);
    if (IN(3)) { REFRESH_CTX(); pg8::Gemm g{ACT, (const bf16*)(ws + WS_WD1), S_, D_, FF_, FF_, FF_}; pg8::StaticOrder S; S.init(S_, D_, F.G, (int)blockIdx.x);
        if (fuse_norm) { pg8::EpiResidNorm<0> E{x, X1, H, (const float*)(ws + WS_GW) + 8192, (const float*)(ws + WS_GW), (float*)(ws + WS_XBUF), (unsigned*)(ws + WS_CTL) + 16384};
            pg8::gemm_phase<pg8::EpiResidNorm<0>, pg8::StaticOrder, false, PG8_SP2>(F.lds, g, S, E, F.wave); }
        else if (DEFER_NORM) { bias_gemv(F, (const bf16*)(ws + WS_WIN), DINP, GWT + 2048, GWT + 14336);
            pg8::EpiResidG E{x, X1, H, GWT + 8192, GWT, RSQ}; pg8::gemm_phase<pg8::EpiResidG, pg8::StaticOrder, PG8_ALIGN, PG8_SP2>(F.lds, g, S, E, F.wave); }
        else { pg8::EpiResid E{x, X1, D_, MOD + 2 * D_, 0.5f * (1.f + PROBE_A1)}; pg8::gemm_phase<pg8::EpiResid, pg8::StaticOrder, PG8_ALIGN, PG8_SP2>(F.lds, g, S, E, F.wave); } }
    }
    SEAM(3);
    for (int rp_ = 0; rp_ < REPA; ++rp_) { if (rp_) xcd_barrier(bar);
    if (IN(4) && !fuse_norm && !DEFER_NORM) { REFRESH_CTX(); build_mod_tables(F, ws, args.in[8], args.in[3], 3, false, gwt, sht); norm_rows_bf16(F, X1, H, gwt, sht); __syncthreads(); }
    }
    if (!fuse_norm && !DEFER_NORM) SEAM(4);
    for (int rp_ = 0; rp_ < REPB; ++rp_) { if (rp_) xcd_barrier(bar);
    if (IN(5)) { REFRESH_CTX(); pg8::Gemm g{H, (const bf16*)(ws + WS_WIN), S_, DINP, D_, D_, D_}; pg8::StaticOrder S; S.init(S_, DINP, F.G, (int)blockIdx.x);
        if (DEFER_NORM && !fuse_norm) { pg8::EpiStoreN E{ACT, DINP, RSQ, GWT + 14336}; pg8::gemm_phase<pg8::EpiStoreN, pg8::StaticOrder, PG8_ALIGN, PG8_SP2>(F.lds, g, S, E, F.wave); }
        else { pg8::EpiStore E{ACT, DINP}; pg8::gemm_phase<pg8::EpiStore, pg8::StaticOrder, PG8_ALIGN, PG8_SP2>(F.lds, g, S, E, F.wave); }
        REFRESH_CTX(); conv_tail(F, pa, 2, NIT_C, (S_ / 256) * (DINP / 256)); }
    }
    SEAM(5);
    for (int rp_ = 0; rp_ < REPC; ++rp_) { if (rp_) xcd_barrier(bar);
    if (IN(6)) { REFRESH_CTX(); p6_prep(F, ws, args.in[10], args.in[12], args.in[14], args.in[17]); }
    }
    SEAM(6);
    for (int rp_ = 0; rp_ < REPC; ++rp_) { if (rp_) xcd_barrier(bar);
    if (IN(7)) { REFRESH_CTX();
        const int c = (int)blockIdx.x, G = F.G;
        { pg8::Gemm g{(const bf16*)(ws + WS_CQN), (const bf16*)(ws + WS_WUQ), S_, 1536, 768, 768, 768}; pg8::StaticOrder S; S.init(S_, 1536, G, c);
          pg8::EpiStore E{(bf16*)(ws + WS_Q), 1536}; pg8::gemm_phase<pg8::EpiStore, pg8::StaticOrder, PG8_ALIGN, PG8_SP2>(F.lds, g, S, E, F.wave); }
        { pg8::Gemm g{(const bf16*)(ws + WS_CKVN), (const bf16*)(ws + WS_WUKV), S_, 2048, 512, 512, 512}; pg8::StaticOrder S; S.init(S_, 2048, G, c);
          pg8::EpiStore E{(bf16*)(ws + WS_KV), 2048}; pg8::gemm_phase<pg8::EpiStore, pg8::StaticOrder, PG8_ALIGN, PG8_SP2>(F.lds, g, S, E, F.wave); }
        { pg8::Gemm g{(const bf16*)(ws + WS_FLATK), (const bf16*)(ws + WS_WCK1), 1024, 256, KCH_K, 6144, 6144}; pg8::StaticOrder S; S.init_units(4, NCH_K, G, (c + G - 192 % G) % G);
          pg8::EpiPart E{(float*)(ws + WS_PARTK), 1024}; pg8::gemm_phase<pg8::EpiPart, pg8::StaticOrder, false, PG8_SP2, true>(F.lds, g, S, E, F.wave); }
        { pg8::Gemm g{(const bf16*)(ws + WS_FLATV), (const bf16*)(ws + WS_WCV1), 1024, 256, KCH_V, 4096, 4096}; pg8::StaticOrder S; S.init_units(4, NCH_V, G, (c + G - 240 % G) % G);
          pg8::EpiPart E{(float*)(ws + WS_PARTV), 1024}; pg8::gemm_phase<pg8::EpiPart, pg8::StaticOrder, false, PG8_SP2, true>(F.lds, g, S, E, F.wave); }
    }
    }
    SEAM(7);
    if (IN(8)) { REFRESH_CTX(); p8_prep2(F, ws); }
    SEAM(8);
    for (int rp_ = 0; rp_ < REPC; ++rp_) { if (rp_) xcd_barrier(bar);
    if (IN(9)) { REFRESH_CTX();
        const int c = (int)blockIdx.x, G = F.G;
        { pg8::Gemm g{(const bf16*)(ws + WS_HIDK), (const bf16*)(ws + WS_WCK2), 1024, 256, 256, 256, 256}; pg8::StaticOrder S; S.init(1024, 256, G, c);
          pg8::EpiStore E{(bf16*)(ws + WS_KC), 256}; pg8::gemm_phase<pg8::EpiStore, pg8::StaticOrder, false, PG8_SP2>(F.lds, g, S, E, F.wave); }
        { pg8::Gemm g{(const bf16*)(ws + WS_HIDV), (const bf16*)(ws + WS_WCV2), 1024, 256, 256, 256, 256}; pg8::StaticOrder S; S.init(1024, 256, G, (c + G - 8 % G) % G);
          pg8::EpiStore E{(bf16*)(ws + WS_VC), 256}; pg8::gemm_phase<pg8::EpiStore, pg8::StaticOrder, false, PG8_SP2>(F.lds, g, S, E, F.wave); }
    }
    }
    SEAM(9);
    for (int rep = 0; rep < REP10; ++rep) { if (rep) xcd_barrier(bar);
    if (IN(10)) { REFRESH_CTX(); CLK_BEGIN(10);
        gu32* ctr = (gu32*)(ws + WS_CTL) + 2048 + 64 * rep; const unsigned* order = (const unsigned*)(ws + WS_CTL) + 8192;
        for (;;) {
            int moff = MISC_OFF + 64; asm volatile("" : "+s"(moff));
            volatile LAS unsigned* mq = (volatile LAS unsigned*)(F.lds + moff);
            if (att::lane_id() == 0 && F.wave == 0) mq[0] = __hip_atomic_fetch_add(ctr, 1u, RLX_AGENT);
            __syncthreads(); const int n = __builtin_amdgcn_readfirstlane((int)mq[0]); __syncthreads();
            if (n >= 512) {
                if (rep == 0) { gu32* cc = (gu32*)(ws + WS_CTL) + 3072; LAS float* scr = (LAS float*)(F.lds + F.wave * 16384);
                    for (;;) { int it = 0; if (att::lane_id() == 0) it = (int)__hip_atomic_fetch_add(cc, 4u, RLX_AGENT); it = __builtin_amdgcn_readfirstlane(it); if (it >= NIT_D) break;
                        conv_run(3, it, 1, it + 4 < NIT_D ? it + 4 : NIT_D, pa, scr, att::lane_id()); } }
                break; }
            const int id = __builtin_amdgcn_readfirstlane((int)order[n]);
#ifdef PROBE_MLA_ONLY
            if (rep > 0 && id >= 256) continue;
#endif
#ifdef PROBE_NSA_ONLY
            if (rep > 0 && id < 256) continue;
#endif
            if (rep == 0 && PROBE_MODE != 0) {
                if (id < 256) att::mla_unit<PROBE_MODE>(id & 7, id >> 3, (const bf16*)(ws + WS_Q), (const bf16*)(ws + WS_KV), (const bf16*)(ws + WS_KR), (const float*)(ws + WS_ROPE), H, F.lds, F.wave);
                else att::nsa_unit<PROBE_MODE>((id - 256) >> 1, (id - 256) & 1, (const bf16*)(ws + WS_ACT), (const bf16*)(ws + WS_KC), (const bf16*)(ws + WS_VC), args.in[20], (float*)(ws + WS_MIXF), (float*)(ws + WS_CQN), H, F.lds, F.wave);
            } else {
                if (id < 256) att::mla_unit<0>(id & 7, id >> 3, (const bf16*)(ws + WS_Q), (const bf16*)(ws + WS_KV), (const bf16*)(ws + WS_KR), (const float*)(ws + WS_ROPE), H, F.lds, F.wave);
                else att::nsa_unit<0>((id - 256) >> 1, (id - 256) & 1, (const bf16*)(ws + WS_ACT), (const bf16*)(ws + WS_KC), (const bf16*)(ws + WS_VC), args.in[20], (float*)(ws + WS_MIXF), (float*)(ws + WS_CQN), H, F.lds, F.wave);
            }
        }
        CLK_END(10);
    }
    }
    SEAM(10);
    if (IN(11)) { REFRESH_CTX(); pg8::Gemm g{H, (const bf16*)(ws + WS_WOUT), S_, D_, D_, D_, D_}; pg8::StaticOrder S; S.init(S_, D_, F.G, (int)blockIdx.x);
        if (fuse_norm) { pg8::EpiResidNorm<0> E{X1, X2, H2, (const float*)(ws + WS_GW) + 10240, (const float*)(ws + WS_GW) + 4096, (float*)(ws + WS_XBUF) + 65536, (unsigned*)(ws + WS_CTL) + 16384 + 2048};
            pg8::gemm_phase<pg8::EpiResidNorm<0>, pg8::StaticOrder, false, PG8_SP2>(F.lds, g, S, E, F.wave); }
        else if (DEFER_NORM) { bias_gemv(F, (const bf16*)(ws + WS_WGU2), 2 * FF_, GWT + 6144, GWT + 20480);
            pg8::EpiResidG E{X1, X1, H2, GWT + 10240, GWT + 4096, RSQ + 8192}; pg8::gemm_phase<pg8::EpiResidG, pg8::StaticOrder, PG8_ALIGN, PG8_SP2>(F.lds, g, S, E, F.wave); }
        else { pg8::EpiResid E{X1, X1, D_, MOD + 5 * D_, 1.0f}; pg8::gemm_phase<pg8::EpiResid, pg8::StaticOrder, PG8_ALIGN, PG8_SP2>(F.lds, g, S, E, F.wave); } }
    SEAM(11);
    if (IN(12) && !fuse_norm && !DEFER_NORM) { REFRESH_CTX(); build_mod_tables(F, ws, args.in[22], args.in[3], 6, false, gwt, sht); norm_rows_bf16(F, X1, H2, gwt, sht); __syncthreads(); }
    if (!fuse_norm && !DEFER_NORM) SEAM(12);
    if (IN(13)) { REFRESH_CTX(); pg8::Gemm g{H2, (const bf16*)(ws + WS_WGU2), S_, 2 * FF_, D_, D_, D_}; pg8::StaticOrder S; S.init(S_, 2 * FF_, F.G, (int)blockIdx.x);
        const bool half_tail = HALF_TAIL && ((S.nwg % F.G) * 2 == F.G);
        if (half_tail) S.r1 = S.nwg / F.G;
        if (DEFER_NORM && !fuse_norm) { pg8::EpiSwigluN E{ACT, FF_, RSQ + 8192, GWT + 20480}; pg8::gemm_phase<pg8::EpiSwigluN, pg8::StaticOrder, PG8_ALIGN, PG8_SP2>(F.lds, g, S, E, F.wave);
            if (half_tail) { S.r0 = S.r1; S.r1 = S.r0 + 1; S.half = 1; pg8::gemm_phase<pg8::EpiSwigluN, pg8::StaticOrder, false, true, false, true>(F.lds, g, S, E, F.wave); } }
        else { pg8::EpiSwiglu E{ACT, FF_}; pg8::gemm_phase<pg8::EpiSwiglu, pg8::StaticOrder, PG8_ALIGN, PG8_SP2>(F.lds, g, S, E, F.wave);
            if (half_tail) { S.r0 = S.r1; S.r1 = S.r0 + 1; S.half = 1; pg8::gemm_phase<pg8::EpiSwiglu, pg8::StaticOrder, false, true, false, true>(F.lds, g, S, E, F.wave); } } }
    SEAM(13);
    if (IN(14)) { REFRESH_CTX(); pg8::Gemm g{ACT, (const bf16*)(ws + WS_WD2), S_, D_, FF_, FF_, FF_}; pg8::StaticOrder S; S.init(S_, D_, F.G, (int)blockIdx.x);
        if (fuse_final) { pg8::EpiResidNorm<1> E{fuse_norm ? X2 : X1, args.out, nullptr, (const float*)(ws + WS_GW) + 12288, args.in[26], (float*)(ws + WS_XBUF) + 2 * 65536, (unsigned*)(ws + WS_CTL) + 16384 + 4096};
            pg8::gemm_phase<pg8::EpiResidNorm<1>, pg8::StaticOrder, false, PG8_SP2>(F.lds, g, S, E, F.wave); }
        else { pg8::EpiResid E{X1, args.out, D_, MOD + 8 * D_, 0.5f}; pg8::gemm_phase<pg8::EpiResid, pg8::StaticOrder, PG8_ALIGN, PG8_SP2>(F.lds, g, S, E, F.wave); } }
    if (!fuse_final) SEAM(14);
    if (IN(15) && !fuse_final) { REFRESH_CTX(); final_norm(F, args.out, args.in[26]); }
#if PROBE_STAMP >= 0
    if (blockIdx.x == 0) { __syncthreads(); unsigned long long now = __builtin_amdgcn_s_memrealtime(); if (STAMP_END == 15) ts_b = now;
        const unsigned long long until = now + (unsigned long long)STAMP_MULT * (ts_b - ts_a);
        while (__builtin_amdgcn_s_memrealtime() < until) __builtin_amdgcn_s_sleep(8); }
#endif
#undef IN
#undef SEAM
}

extern "C" void kernel_launch(void* const* d_in, const int* in_sizes, int n_in, void* d_out, int out_size, void* d_ws, size_t ws_size, hipStream_t stream) {
    static int grid = 0;
    if (grid == 0) {
        if (n_in != 27 || out_size != S_ * D_ || ws_size < WS_END) { fprintf(stderr, "kernel_launch: unexpected shapes (n_in %d out %d ws %zu)\n", n_in, out_size, ws_size); grid = -1; return; }
        int dev = 0, cus = 0;
        if (hipGetDevice(&dev) != hipSuccess || hipDeviceGetAttribute(&cus, hipDeviceAttributeMultiprocessorCount, dev) != hipSuccess) { grid = -1; return; }
        if (hipFuncSetAttribute((const void*)mega, hipFuncAttributeMaxDynamicSharedMemorySize, LDS_BYTES) != hipSuccess) { fprintf(stderr, "hipFuncSetAttribute failed\n"); grid = -1; return; }
        grid = cus;
    }
    if (grid < 0) return;
    (void)hipMemsetAsync((char*)d_ws + WS_CTL, 0, 1 * MiB, stream);
    Args a{};
    for (int i = 0; i < 27; ++i) a.in[i] = (const float*)d_in[i];
    a.out = (float*)d_out; a.ws = (unsigned char*)d_ws;
    unsigned char* ws = (unsigned char*)d_ws;
    auto run = [&](int lo, int hi, int nbar) { a.ph_lo = lo; a.ph_hi = hi; a.nbar = nbar; hipLaunchKernelGGL(mega, dim3(grid), dim3(NTHR), LDS_BYTES, stream, a); };
    run(0, 16, 0);
}
```

```cpp
#include <hip/hip_runtime.h>
#include <cstdio>
#include <cstdint>
#include <cmath>
namespace pg8 {
#define PG8_LAS __attribute__((address_space(3)))
typedef unsigned short bf16_t;
typedef short bf16x8 __attribute__((ext_vector_type(8)));
typedef float f32x4 __attribute__((ext_vector_type(4)));
typedef unsigned u32x4 __attribute__((ext_vector_type(4)));
constexpr int BM = 256, BK = 64, HALF = 128, HTB = HALF * BK * 2  , STAGE_BYTES = 8 * HTB, NXCD = 8, WGM = 8;

__host__ __device__ __forceinline__ int lds_byte(int r, int c) { const int st = (r >> 4) * 2 + (c >> 5), rr = r & 15, cc = c & 31, ob = rr * 64 + cc * 2; return st * 1024 + (ob ^ (((ob >> 9) & 1) << 5)); }
__host__ __device__ __forceinline__ void stage_rc(int b, int& R, int& C) { const int st = b / 1024, sb = b % 1024, swz = sb ^ (((sb >> 9) & 1) << 5); R = (st >> 1) * 16 + swz / 64; C = (st & 1) * 32 + (swz % 64) / 2; }
__host__ __device__ __forceinline__ int perm32(int rho) { const int n = rho >> 4, i = rho & 15; return 8 * (i >> 2) + 4 * n + (i & 3); }

struct Unit { int pm, pn, mh; };
struct Gemm { const bf16_t* A; const bf16_t* Bt; int M, N, K, lda, ldb; };

struct StaticOrder {
    int nM, nN, nwg, G, c;
    __host__ __device__ void init(int M, int N, int G_, int c_) { nM = M / BM; nN = N / BM; nwg = nM * nN; G = G_; c = c_; }
    __host__ __device__ void init_units(int nM_, int nN_, int G_, int c_) { nM = nM_; nN = nN_; nwg = nM * nN; G = G_; c = c_; }
    int r0 = 0, r1 = 1 << 30, half = 0;
    __host__ __device__ bool next(int i, Unit& u) const {
        if (r0 + i >= r1) return false;
        const long L = (long)(r0 + i) * G + (half ? (c >> 1) : c); if (L >= nwg) return false;
        u.mh = half ? (c & 1) : -1;
        int wgid = (int)L; { const int q = nwg / NXCD, r = nwg % NXCD, xcd = wgid % NXCD, off = wgid / NXCD; wgid = (xcd < r ? xcd * (q + 1) : r * (q + 1) + (xcd - r) * q) + off; }
        const int nig = WGM * nN, gid = wgid / nig, fm = gid * WGM, gsz = (nM - fm) < WGM ? (nM - fm) : WGM;
        u.pm = fm + ((wgid % nig) % gsz); u.pn = (wgid % nig) / gsz; return true;
    }
    __device__ __forceinline__ void a_ready(const Unit&) const {}
    __device__ __forceinline__ void done(const Unit&) const {}
};
__device__ __forceinline__ unsigned cvt_pk_bf16(float lo, float hi) { unsigned r; asm volatile("v_cvt_pk_bf16_f32 %0, %1, %2" : "=v"(r) : "v"(lo), "v"(hi)); return r; }
typedef unsigned u32x4 __attribute__((ext_vector_type(4)));
__device__ __forceinline__ float silu_f(float v) { return v * __builtin_amdgcn_rcpf(1.0f + __builtin_amdgcn_exp2f(-1.4426950408889634f * v)); }
struct EpiSwiglu {
    static constexpr bool PERM = true, AFTER_DRAIN = false;
    bf16_t* O; int ldc;
    __device__ __forceinline__ void operator()(const f32x4 (&acc)[2][2][4][2], const Unit& u, int wr, int wc, int fr, int fq) const {
        const int row0 = u.pm * BM + wr * 64 + fr + (u.mh > 0 ? HALF : 0), col0 = u.pn * 128 + wc * 32 + 8 * fq;
#pragma unroll
        for (int ai = 0; ai < 2; ++ai)
#pragma unroll
            for (int m = 0; m < 4; ++m) {
                if (ai == 1 && u.mh >= 0) continue;
                bf16_t* rowp = O + (size_t)(row0 + ai * HALF + m * 16) * ldc + col0;
                const f32x4 g0 = acc[ai][0][m][0], g1 = acc[ai][0][m][1], u0 = acc[ai][1][m][0], u1 = acc[ai][1][m][1];
                u32x4 w;
                w.x = cvt_pk_bf16(silu_f(g0[0]) * u0[0], silu_f(g0[1]) * u0[1]); w.y = cvt_pk_bf16(silu_f(g0[2]) * u0[2], silu_f(g0[3]) * u0[3]);
                w.z = cvt_pk_bf16(silu_f(g1[0]) * u1[0], silu_f(g1[1]) * u1[1]); w.w = cvt_pk_bf16(silu_f(g1[2]) * u1[2], silu_f(g1[3]) * u1[3]);
                *(u32x4*)rowp = w;
            }
    }
};
struct EpiStore {
    static constexpr bool PERM = true, AFTER_DRAIN = false;
    bf16_t* O; int ldc;
    __device__ __forceinline__ void operator()(const f32x4 (&acc)[2][2][4][2], const Unit& u, int wr, int wc, int fr, int fq) const {
        const int row0 = u.pm * BM + wr * 64 + fr, col0 = u.pn * BM + wc * 32 + 8 * fq;
#pragma unroll
        for (int ai = 0; ai < 2; ++ai)
#pragma unroll
            for (int m = 0; m < 4; ++m) {
                bf16_t* rowp = O + (size_t)(row0 + ai * HALF + m * 16) * ldc + col0;
#pragma unroll
                for (int bj = 0; bj < 2; ++bj) {
                    const f32x4 v0 = acc[ai][bj][m][0], v1 = acc[ai][bj][m][1];
                    u32x4 w; w.x = cvt_pk_bf16(v0[0], v0[1]); w.y = cvt_pk_bf16(v0[2], v0[3]); w.z = cvt_pk_bf16(v1[0], v1[1]); w.w = cvt_pk_bf16(v1[2], v1[3]);
                    *(u32x4*)(rowp + bj * HALF) = w;
                }
            }
    }
};
template <bool OUT_BF16>
struct EpiResidP {
    static constexpr bool PERM = true, AFTER_DRAIN = false;
    const float* base; void* outp; int ldc; const float* gv; float coef;
    __device__ __forceinline__ void operator()(const f32x4 (&acc)[2][2][4][2], const Unit& u, int wr, int wc, int fr, int fq) const {
        const int col0 = u.pn * BM + wc * 32 + 8 * fq;
        f32x4 gg[2][2];
#pragma unroll
        for (int bj = 0; bj < 2; ++bj)
#pragma unroll
            for (int n = 0; n < 2; ++n) gg[bj][n] = *(const f32x4*)(gv + col0 + bj * HALF + n * 4) * coef;
#pragma unroll
        for (int ai = 0; ai < 2; ++ai) {
            f32x4 bs[4][2][2];
#pragma unroll
            for (int m = 0; m < 4; ++m) { const size_t off = (size_t)(u.pm * BM + ai * HALF + wr * 64 + m * 16 + fr) * ldc + col0;
#pragma unroll
                for (int bj = 0; bj < 2; ++bj)
#pragma unroll
                    for (int n = 0; n < 2; ++n) bs[m][bj][n] = *(const f32x4*)(base + off + bj * HALF + n * 4); }
            asm volatile("" ::: "memory");
#pragma unroll
            for (int m = 0; m < 4; ++m) { const size_t off = (size_t)(u.pm * BM + ai * HALF + wr * 64 + m * 16 + fr) * ldc + col0;
#pragma unroll
                for (int bj = 0; bj < 2; ++bj) {
                    const f32x4 v0 = bs[m][bj][0] + gg[bj][0] * acc[ai][bj][m][0], v1 = bs[m][bj][1] + gg[bj][1] * acc[ai][bj][m][1];
                    if constexpr (OUT_BF16) { u32x4 w; w.x = cvt_pk_bf16(v0[0], v0[1]); w.y = cvt_pk_bf16(v0[2], v0[3]); w.z = cvt_pk_bf16(v1[0], v1[1]); w.w = cvt_pk_bf16(v1[2], v1[3]);
                        *(u32x4*)((bf16_t*)outp + off + bj * HALF) = w; }
                    else { *(f32x4*)((float*)outp + off + bj * HALF) = v0; *(f32x4*)((float*)outp + off + bj * HALF + 4) = v1; } } }
            asm volatile("" ::: "memory");
        }
    }
};
struct EpiResid {
    static constexpr bool PERM = false, AFTER_DRAIN = false;
    const float* base; float* out; int ldc; const float* gv; float coef;
    __device__ __forceinline__ void operator()(const f32x4 (&acc)[2][2][4][2], const Unit& u, int wr, int wc, int fr, int fq) const {
        const int col0 = u.pn * BM + wc * 32 + 4 * fq;
        f32x4 gg[2][2];
#pragma unroll
        for (int bj = 0; bj < 2; ++bj)
#pragma unroll
            for (int n = 0; n < 2; ++n) gg[bj][n] = *(const f32x4*)(gv + col0 + bj * HALF + n * 16) * coef;
#pragma unroll
        for (int ai = 0; ai < 2; ++ai) {
            f32x4 bs[4][2][2];
#pragma unroll
            for (int m = 0; m < 4; ++m) { const size_t off = (size_t)(u.pm * BM + ai * HALF + wr * 64 + m * 16 + fr) * ldc + col0;
#pragma unroll
                for (int bj = 0; bj < 2; ++bj)
#pragma unroll
                    for (int n = 0; n < 2; ++n) bs[m][bj][n] = *(const f32x4*)(base + off + bj * HALF + n * 16); }
            asm volatile("" ::: "memory");
#pragma unroll
            for (int m = 0; m < 4; ++m) { const size_t off = (size_t)(u.pm * BM + ai * HALF + wr * 64 + m * 16 + fr) * ldc + col0;
#pragma unroll
                for (int bj = 0; bj < 2; ++bj)
#pragma unroll
                    for (int n = 0; n < 2; ++n) *(f32x4*)(out + off + bj * HALF + n * 16) = bs[m][bj][n] + gg[bj][n] * acc[ai][bj][m][n]; }
            asm volatile("" ::: "memory");
        }
    }
};
struct EpiPart {
    static constexpr bool PERM = false, AFTER_DRAIN = false;
    float* P; int rows;
    __device__ __forceinline__ void operator()(const f32x4 (&acc)[2][2][4][2], const Unit& u, int wr, int wc, int fr, int fq) const {
        const int col0 = wc * 32 + 4 * fq;
#pragma unroll
        for (int ai = 0; ai < 2; ++ai)
#pragma unroll
            for (int m = 0; m < 4; ++m) {
                float* rowp = P + ((size_t)u.pn * rows + (u.pm * BM + ai * HALF + wr * 64 + m * 16 + fr)) * 256 + col0;
#pragma unroll
                for (int bj = 0; bj < 2; ++bj)
#pragma unroll
                    for (int n = 0; n < 2; ++n) *(f32x4*)(rowp + bj * HALF + n * 16) = acc[ai][bj][m][n];
            }
    }
};
template <int FINAL>
struct EpiResidNorm {
    static constexpr bool PERM = false, AFTER_DRAIN = true; static constexpr int ldc = 2048;
    const float* base; float* xout; bf16_t* hout; const float* gv;
    const float* gw;
    float* xbuf; unsigned* cnt;
    __device__ __forceinline__ void fused(f32x4 (&acc)[2][2][4][2], const Unit& u, int wr, int wc, int fr, int fq, PG8_LAS unsigned char* lds, int wid, int lane) const {
        const float* const base = this->base; float* const xout = this->xout; bf16_t* const hout = this->hout; const float* const gv = this->gv;
        const float* const gw = this->gw; const float* const sh = gw + 2048; float* const xbuf = this->xbuf; unsigned* const cnt = this->cnt;
        PG8_LAS float* P = (PG8_LAS float*)lds;
        PG8_LAS float* S = (PG8_LAS float*)(lds + 4096);
        PG8_LAS unsigned* flag = (PG8_LAS unsigned*)(lds + 4096 + 1024);
        const int col0 = u.pn * BM + wc * 32 + 4 * fq;
        float s8[2][4];
#pragma unroll
        for (int ai = 0; ai < 2; ++ai)
#pragma unroll
            for (int m = 0; m < 4; ++m) s8[ai][m] = 0.f;
#pragma unroll
        for (int bj = 0; bj < 2; ++bj)
#pragma unroll
            for (int n = 0; n < 2; ++n) {
                const f32x4 gg = *(const f32x4*)(gv + col0 + bj * HALF + n * 16);
#pragma unroll
                for (int ai = 0; ai < 2; ++ai)
#pragma unroll
                    for (int m = 0; m < 4; ++m) {
                        const int rl = ai * HALF + wr * 64 + m * 16 + fr; const size_t off = (size_t)(u.pm * BM + rl) * ldc + col0 + bj * HALF + n * 16;
                        const f32x4 bs = *(const f32x4*)(base + off); const f32x4 v = bs + gg * acc[ai][bj][m][n]; *(f32x4*)(xout + off) = v;
                        s8[ai][m] += (v[0] * v[0] + v[1] * v[1]) + (v[2] * v[2] + v[3] * v[3]);
                    }
                asm volatile("" ::: "memory");
            }
#pragma unroll
        for (int ai = 0; ai < 2; ++ai)
#pragma unroll
            for (int m = 0; m < 4; ++m) { float s = s8[ai][m]; s += __shfl_xor(s, 16); s += __shfl_xor(s, 32);
                if (fq == 0) P[(ai * HALF + wr * 64 + m * 16 + fr) * 4 + wc] = s; }
        asm volatile("s_waitcnt lgkmcnt(0)" ::: "memory"); __builtin_amdgcn_s_barrier(); asm volatile("" ::: "memory");
        const int row = wid * 32 + (lane & 31);
        if (lane < 32) { const float t = (P[row * 4 + 0] + P[row * 4 + 1]) + (P[row * 4 + 2] + P[row * 4 + 3]);
            __hip_atomic_store(xbuf + (size_t)(u.pm * BM + row) * 8 + u.pn, t, __ATOMIC_RELAXED, __HIP_MEMORY_SCOPE_AGENT); }
        asm volatile("s_waitcnt vmcnt(0)" ::: "memory");
        if (lane == 0) __hip_atomic_fetch_add(cnt + 64 * u.pm, 1u, __ATOMIC_RELAXED, __HIP_MEMORY_SCOPE_AGENT);
        if (wid == 0) {
            unsigned bad = 0u; const unsigned long long t0 = __builtin_amdgcn_s_memrealtime();
            for (;;) {
                if ((unsigned)__builtin_amdgcn_readfirstlane(__hip_atomic_load(cnt + 64 * u.pm, __ATOMIC_RELAXED, __HIP_MEMORY_SCOPE_AGENT)) >= 64u) break;
                if (__builtin_amdgcn_s_memrealtime() - t0 > 2000000ull) { bad = 1u; break; }
                __builtin_amdgcn_s_sleep(2);
            }
            __builtin_amdgcn_fence(__ATOMIC_ACQUIRE, "agent");
            if (lane == 0) flag[0] = bad;
        }
        asm volatile("s_waitcnt vmcnt(0) lgkmcnt(0)" ::: "memory"); __builtin_amdgcn_s_barrier(); asm volatile("" ::: "memory");
        if (lane < 32) { const float* sl = xbuf + (size_t)(u.pm * BM + row) * 8; float q = 0.f;
#pragma unroll
            for (int t = 0; t < 8; ++t) q += __hip_atomic_load(sl + t, __ATOMIC_RELAXED, __HIP_MEMORY_SCOPE_AGENT);
            S[row] = 1.0f / sqrtf(q * (1.0f / 2048.0f) + 1e-6f); }
        asm volatile("s_waitcnt lgkmcnt(0)" ::: "memory"); __builtin_amdgcn_s_barrier(); asm volatile("" ::: "memory");
        typedef unsigned u32x2v __attribute__((ext_vector_type(2)));
#pragma unroll
        for (int bj = 0; bj < 2; ++bj)
#pragma unroll
            for (int n = 0; n < 2; ++n) {
                const f32x4 gwv = *(const f32x4*)(gw + col0 + bj * HALF + n * 16);
                f32x4 shv = (f32x4){0.f, 0.f, 0.f, 0.f}; if (FINAL == 0) shv = *(const f32x4*)(sh + col0 + bj * HALF + n * 16);
#pragma unroll
                for (int ai = 0; ai < 2; ++ai)
#pragma unroll
                    for (int m = 0; m < 4; ++m) {
                        const int rl = ai * HALF + wr * 64 + m * 16 + fr; const size_t off = (size_t)(u.pm * BM + rl) * ldc + col0 + bj * HALF + n * 16;
                        const f32x4 v = *(const f32x4*)(xout + off); const float rs = S[rl];
                        const f32x4 y = v * rs * gwv + shv;
                        if (FINAL) *(f32x4*)(xout + off) = y;
                        else { u32x2v w; w.x = cvt_pk_bf16(y[0], y[1]); w.y = cvt_pk_bf16(y[2], y[3]); *(u32x2v*)(hout + off) = w; }
                    }
            }
    }
};

struct EpiResidG {
    static constexpr bool PERM = false, AFTER_DRAIN = false; static constexpr int ldc = 2048;
    const float* base; float* out; bf16_t* xg; const float* gv; const float* gw; float* rsq;
    __device__ __forceinline__ void operator()(const f32x4 (&acc)[2][2][4][2], const Unit& u, int wr, int wc, int fr, int fq) const {
        typedef unsigned u32x2v __attribute__((ext_vector_type(2)));
        const int col0 = u.pn * BM + wc * 32 + 4 * fq;
        f32x4 gg[2][2], gwv[2][2];
#pragma unroll
        for (int bj = 0; bj < 2; ++bj)
#pragma unroll
            for (int n = 0; n < 2; ++n) { gg[bj][n] = *(const f32x4*)(gv + col0 + bj * HALF + n * 16); gwv[bj][n] = *(const f32x4*)(gw + col0 + bj * HALF + n * 16); }
#pragma unroll
        for (int ai = 0; ai < 2; ++ai)
#pragma unroll
            for (int m = 0; m < 4; ++m) {
                const int row = u.pm * BM + ai * HALF + wr * 64 + m * 16 + fr; const size_t off = (size_t)row * ldc + col0;
                float s = 0.f;
#pragma unroll
                for (int bj = 0; bj < 2; ++bj)
#pragma unroll
                    for (int n = 0; n < 2; ++n) {
                        const f32x4 bs = *(const f32x4*)(base + off + bj * HALF + n * 16); const f32x4 v = bs + gg[bj][n] * acc[ai][bj][m][n];
                        *(f32x4*)(out + off + bj * HALF + n * 16) = v; s += (v[0] * v[0] + v[1] * v[1]) + (v[2] * v[2] + v[3] * v[3]);
                        const f32x4 y = v * gwv[bj][n]; u32x2v w; w.x = cvt_pk_bf16(y[0], y[1]); w.y = cvt_pk_bf16(y[2], y[3]); *(u32x2v*)(xg + off + bj * HALF + n * 16) = w;
                    }
                s += __shfl_xor(s, 16); s += __shfl_xor(s, 32);
                if (fq == 0) atomicAdd(rsq + row, s);
            }
    }
};
struct EpiStoreN {
    static constexpr bool PERM = true, AFTER_DRAIN = false;
    bf16_t* O; int ldc; const float* rsq; const float* cb;
    __device__ __forceinline__ void operator()(const f32x4 (&acc)[2][2][4][2], const Unit& u, int wr, int wc, int fr, int fq) const {
        const int row0 = u.pm * BM + wr * 64 + fr, col0 = u.pn * BM + wc * 32 + 8 * fq;
        f32x4 c0[2], c1[2];
#pragma unroll
        for (int bj = 0; bj < 2; ++bj) { c0[bj] = *(const f32x4*)(cb + col0 + bj * HALF); c1[bj] = *(const f32x4*)(cb + col0 + bj * HALF + 4); }
#pragma unroll
        for (int ai = 0; ai < 2; ++ai)
#pragma unroll
            for (int m = 0; m < 4; ++m) {
                const int row = row0 + ai * HALF + m * 16; const float rs = 1.0f / sqrtf(rsq[row] * (1.0f / 2048.0f) + 1e-6f);
                bf16_t* rowp = O + (size_t)row * ldc + col0;
#pragma unroll
                for (int bj = 0; bj < 2; ++bj) {
                    const f32x4 v0 = acc[ai][bj][m][0] * rs + c0[bj], v1 = acc[ai][bj][m][1] * rs + c1[bj];
                    u32x4 w; w.x = cvt_pk_bf16(v0[0], v0[1]); w.y = cvt_pk_bf16(v0[2], v0[3]); w.z = cvt_pk_bf16(v1[0], v1[1]); w.w = cvt_pk_bf16(v1[2], v1[3]);
                    *(u32x4*)(rowp + bj * HALF) = w;
                }
            }
    }
};
struct EpiSwigluN {
    static constexpr bool PERM = true, AFTER_DRAIN = false;
    bf16_t* O; int ldc; const float* rsq; const float* cb;
    __device__ __forceinline__ void operator()(const f32x4 (&acc)[2][2][4][2], const Unit& u, int wr, int wc, int fr, int fq) const {
        const int row0 = u.pm * BM + wr * 64 + fr + (u.mh > 0 ? HALF : 0), col0 = u.pn * 128 + wc * 32 + 8 * fq, cc0 = u.pn * BM + wc * 32 + 8 * fq;
        const f32x4 cg0 = *(const f32x4*)(cb + cc0), cg1 = *(const f32x4*)(cb + cc0 + 4), cu0 = *(const f32x4*)(cb + cc0 + HALF), cu1 = *(const f32x4*)(cb + cc0 + HALF + 4);
#pragma unroll
        for (int ai = 0; ai < 2; ++ai)
#pragma unroll
            for (int m = 0; m < 4; ++m) {
                if (ai == 1 && u.mh >= 0) continue;
                const int row = row0 + ai * HALF + m * 16; const float rs = 1.0f / sqrtf(rsq[row] * (1.0f / 2048.0f) + 1e-6f);
                bf16_t* rowp = O + (size_t)row * ldc + col0;
                const f32x4 g0 = acc[ai][0][m][0] * rs + cg0, g1 = acc[ai][0][m][1] * rs + cg1, u0 = acc[ai][1][m][0] * rs + cu0, u1 = acc[ai][1][m][1] * rs + cu1;
                u32x4 w;
                w.x = cvt_pk_bf16(silu_f(g0[0]) * u0[0], silu_f(g0[1]) * u0[1]); w.y = cvt_pk_bf16(silu_f(g0[2]) * u0[2], silu_f(g0[3]) * u0[3]);
                w.z = cvt_pk_bf16(silu_f(g1[0]) * u1[0], silu_f(g1[1]) * u1[1]); w.w = cvt_pk_bf16(silu_f(g1[2]) * u1[2], silu_f(g1[3]) * u1[3]);
                *(u32x4*)rowp = w;
            }
    }
};

template <class Epi, class Sched, bool ALIGN_EPI = false, bool SP2 = false, bool SPLITK = false, bool HALF_M = false>
__device__ __forceinline__ void gemm_phase(PG8_LAS unsigned char* lds, const Gemm g, const Sched& S, const Epi& E, int wave_id) {
    int lane_; asm volatile("v_mbcnt_lo_u32_b32 %0, -1, 0\n\tv_mbcnt_hi_u32_b32 %0, -1, %0" : "=v"(lane_));
    const int wid = wave_id, lane = lane_, tid = wid * 64 + lane, wr = wid >> 2, wc = wid & 3, fr = lane & 15, fq = lane >> 4;
    static_assert(!HALF_M || SP2, "HALF_M is implemented on the SP2 loop only");
    const int K = g.K, nt = K / BK;
    unsigned voffA[2], voffB[2];
#pragma unroll
    for (int i = 0; i < 2; ++i) { int R, C; stage_rc(tid * 16 + i * 8192, R, C); const int Rb = Epi::PERM ? ((R & ~31) + perm32(R & 31)) : R;
        voffA[i] = (unsigned)(R * g.lda + C) * 2u; voffB[i] = (unsigned)(Rb * g.ldb + C) * 2u; }
    const size_t kstep = (size_t)(BK * 2);
    const size_t hstepA = (size_t)HALF * g.lda * 2, hstepB = (size_t)HALF * g.ldb * 2;
    const size_t tstepA = 2 * hstepA, tstepB = 2 * hstepB; const size_t kchunk = (size_t)K * 2;
    const unsigned ldsw = (unsigned)wid * 1024u;
    const int aoff = lds_byte(wr * 64 + fr, fq * 8), boff = lds_byte(wc * 32 + fr, fq * 8);
#define PG8_SA(b, h) (((b) * 2 + (h)) * HTB)
#define PG8_SB(b, h) ((4 + (b) * 2 + (h)) * HTB)
#define PG8_STAGE(bufoff, gbase, voff) do { _Pragma("unroll") for (int _i = 0; _i < 2; ++_i) \
        __builtin_amdgcn_global_load_lds((const unsigned*)((const char*)(gbase) + (voff)[_i]), (PG8_LAS unsigned*)(lds + (bufoff) + ldsw + _i * 8192), 16, 0, 0); } while (0)
#define PG8_LDA(dst, b, h) do { _Pragma("unroll") for (int m = 0; m < 4; ++m) _Pragma("unroll") for (int k = 0; k < 2; ++k) dst[m][k] = *(const PG8_LAS bf16x8*)(lds + PG8_SA(b, h) + aoff + m * 2048 + k * 1024); } while (0)
#define PG8_LDB(dst, b, h) do { _Pragma("unroll") for (int n = 0; n < 2; ++n) _Pragma("unroll") for (int k = 0; k < 2; ++k) dst[n][k] = *(const PG8_LAS bf16x8*)(lds + PG8_SB(b, h) + boff + n * 2048 + k * 1024); } while (0)
#define PG8_MMA(ai, bj, At, Bt) do { __builtin_amdgcn_s_setprio(1); _Pragma("unroll") for (int m = 0; m < 4; ++m) _Pragma("unroll") for (int n = 0; n < 2; ++n) _Pragma("unroll") for (int k = 0; k < 2; ++k) \
        acc[ai][bj][m][n] = __builtin_amdgcn_mfma_f32_16x16x32_bf16(Bt[n][k], At[m][k], acc[ai][bj][m][n], 0, 0, 0); __builtin_amdgcn_s_setprio(0); } while (0)
#define PG8_WAIT_V(n) asm volatile("s_waitcnt vmcnt(" #n ")" ::: "memory")
#define PG8_WAIT_L(n) asm volatile("s_waitcnt lgkmcnt(" #n ")" ::: "memory")
#define PG8_BAR __builtin_amdgcn_s_barrier()
#define PG8_SCHED __builtin_amdgcn_sched_barrier(0)
    Unit cur, nxt; int ui = 0;
    if (!S.next(0, cur)) return;
    f32x4 acc[2][2][4][2];
#pragma unroll
    for (int a = 0; a < 2; ++a)
#pragma unroll
        for (int b = 0; b < 2; ++b)
#pragma unroll
            for (int m = 0; m < 4; ++m)
#pragma unroll
                for (int n = 0; n < 2; ++n) acc[a][b][m][n] = (f32x4){0.f, 0.f, 0.f, 0.f};
    bf16x8 At[4][2], B0[2][2], B1[2][2];
    const char* cA = (const char*)g.A + (size_t)cur.pm * tstepA + (SPLITK ? (size_t)cur.pn * kchunk : 0) + ((HALF_M && cur.mh > 0) ? hstepA : 0); const char* cB = (const char*)g.Bt + (SPLITK ? (size_t)cur.pn * kchunk : (size_t)cur.pn * tstepB);
    S.a_ready(cur);
    if constexpr (SP2) {
        PG8_STAGE(PG8_SB(0, 0), cB, voffB); PG8_STAGE(PG8_SB(0, 1), cB + hstepB, voffB); PG8_STAGE(PG8_SA(0, 0), cA, voffA); PG8_STAGE(PG8_SA(0, 1), cA + hstepA, voffA);
        if (wr == 1) PG8_BAR;
        PG8_WAIT_V(2); PG8_BAR;
        PG8_STAGE(PG8_SB(1, 0), cB + kstep, voffB); PG8_STAGE(PG8_SA(1, 0), cA + kstep, voffA); PG8_STAGE(PG8_SB(1, 1), cB + hstepB + kstep, voffB);
        PG8_WAIT_V(6); PG8_BAR;
    } else {
        PG8_STAGE(PG8_SB(0, 0), cB, voffB); PG8_STAGE(PG8_SA(0, 0), cA, voffA); PG8_STAGE(PG8_SB(0, 1), cB + hstepB, voffB); PG8_STAGE(PG8_SA(0, 1), cA + hstepA, voffA);
        if (wr == 1) PG8_BAR;
        PG8_WAIT_V(4); PG8_BAR;
        PG8_STAGE(PG8_SB(1, 0), cB + kstep, voffB); PG8_STAGE(PG8_SA(1, 0), cA + kstep, voffA); PG8_STAGE(PG8_SB(1, 1), cB + hstepB + kstep, voffB);
        PG8_WAIT_V(6); PG8_BAR;
    }
    for (;;) {
        const bool has_next = S.next(ui + 1, nxt);
        const char* nA = has_next ? (const char*)g.A + (size_t)nxt.pm * tstepA + (SPLITK ? (size_t)nxt.pn * kchunk : 0) + ((HALF_M && nxt.mh > 0) ? hstepA : 0) : cA; const char* nB = has_next ? (const char*)g.Bt + (SPLITK ? (size_t)nxt.pn * kchunk : (size_t)nxt.pn * tstepB) : cB;
        for (int t = 0; t < nt; t += 2) {
            const bool last = (t == nt - 2);
            const char* a1 = cA + (size_t)(t + 1) * kstep;
            const char* a2 = last ? nA : cA + (size_t)(t + 2) * kstep; const char* b2 = last ? nB : cB + (size_t)(t + 2) * kstep;
            const char* a3 = a2 + kstep; const char* b3 = b2 + kstep;
            if (last && has_next) S.a_ready(nxt);
            if constexpr (SP2) {
            PG8_LDB(B0, 0, 0); PG8_LDB(B1, 0, 1); PG8_SCHED; PG8_LDA(At, 0, 0); PG8_STAGE(PG8_SA(1, 1), a1 + hstepA, voffA);
            PG8_WAIT_V(8); PG8_WAIT_L(0); PG8_BAR; PG8_MMA(0, 0, At, B0); PG8_MMA(0, 1, At, B1); PG8_BAR; PG8_SCHED;
            if constexpr (!HALF_M) { PG8_LDA(At, 0, 1); } PG8_STAGE(PG8_SB(0, 0), b2, voffB); PG8_STAGE(PG8_SB(0, 1), b2 + hstepB, voffB); PG8_STAGE(PG8_SA(0, 0), a2, voffA);
            PG8_WAIT_V(8); PG8_WAIT_L(0); PG8_BAR; if constexpr (!HALF_M) { PG8_MMA(1, 0, At, B0); PG8_MMA(1, 1, At, B1); } PG8_BAR; PG8_SCHED;
            PG8_LDB(B0, 1, 0); PG8_LDB(B1, 1, 1); PG8_SCHED; PG8_LDA(At, 1, 0); PG8_STAGE(PG8_SA(0, 1), a2 + hstepA, voffA);
            PG8_WAIT_V(8); PG8_WAIT_L(0); PG8_BAR; PG8_MMA(0, 0, At, B0); PG8_MMA(0, 1, At, B1); PG8_BAR; PG8_SCHED;
            if constexpr (!HALF_M) { PG8_LDA(At, 1, 1); } PG8_STAGE(PG8_SB(1, 0), b3, voffB); PG8_STAGE(PG8_SB(1, 1), b3 + hstepB, voffB); PG8_STAGE(PG8_SA(1, 0), a3, voffA);
            PG8_WAIT_V(8); PG8_WAIT_L(0); PG8_BAR; if constexpr (!HALF_M) { PG8_MMA(1, 0, At, B0); PG8_MMA(1, 1, At, B1); } PG8_BAR; PG8_SCHED;
            } else {
            PG8_LDB(B0, 0, 0); PG8_SCHED; PG8_LDA(At, 0, 0); PG8_STAGE(PG8_SA(1, 1), a1 + hstepA, voffA);
            PG8_WAIT_L(8); PG8_BAR; PG8_WAIT_L(0); PG8_MMA(0, 0, At, B0); PG8_BAR; PG8_SCHED;
            PG8_LDB(B1, 0, 1); PG8_STAGE(PG8_SB(0, 0), b2, voffB);
            PG8_BAR; PG8_WAIT_L(0); PG8_MMA(0, 1, At, B1); PG8_BAR;
            PG8_LDA(At, 0, 1); PG8_STAGE(PG8_SA(0, 0), a2, voffA);
            PG8_BAR; PG8_WAIT_L(0); PG8_MMA(1, 0, At, B0); PG8_BAR; PG8_SCHED;
            PG8_STAGE(PG8_SB(0, 1), b2 + hstepB, voffB);
            PG8_WAIT_V(6); PG8_BAR; PG8_MMA(1, 1, At, B1); PG8_BAR;
            PG8_LDB(B0, 1, 0); PG8_SCHED; PG8_LDA(At, 1, 0); PG8_STAGE(PG8_SA(0, 1), a2 + hstepA, voffA);
            PG8_WAIT_L(8); PG8_BAR; PG8_WAIT_L(0); PG8_MMA(0, 0, At, B0); PG8_BAR; PG8_SCHED;
            PG8_LDB(B1, 1, 1); PG8_STAGE(PG8_SB(1, 0), b3, voffB);
            PG8_BAR; PG8_WAIT_L(0); PG8_MMA(0, 1, At, B1); PG8_BAR;
            PG8_LDA(At, 1, 1); PG8_STAGE(PG8_SA(1, 0), a3, voffA);
            PG8_BAR; PG8_WAIT_L(0); PG8_MMA(1, 0, At, B0); PG8_BAR; PG8_SCHED;
            PG8_STAGE(PG8_SB(1, 1), b3 + hstepB, voffB);
            PG8_WAIT_V(6); PG8_BAR; PG8_MMA(1, 1, At, B1); PG8_BAR;
            }
        }
        if constexpr (ALIGN_EPI) { if (wr == 0) PG8_BAR; }
        if constexpr (!Epi::AFTER_DRAIN) { E(acc, cur, wr, wc, fr, fq); S.done(cur); }
        if (!has_next) break;
#pragma unroll
        for (int a = 0; a < 2; ++a)
#pragma unroll
            for (int b = 0; b < 2; ++b)
#pragma unroll
                for (int m = 0; m < 4; ++m)
#pragma unroll
                    for (int n = 0; n < 2; ++n) acc[a][b][m][n] = (f32x4){0.f, 0.f, 0.f, 0.f};
        cur = nxt; cA = nA; cB = nB; ++ui;
        if constexpr (ALIGN_EPI) { if (wr == 1) PG8_BAR; }
    }
    PG8_WAIT_V(0);
    if constexpr (!ALIGN_EPI) { if (wr == 0) PG8_BAR; }
    PG8_BAR;
    if constexpr (Epi::AFTER_DRAIN) { E.fused(acc, cur, wr, wc, fr, fq, lds, wid, lane); S.done(cur); }
#undef PG8_SA
#undef PG8_SB
#undef PG8_STAGE
#undef PG8_LDA
#undef PG8_LDB
#undef PG8_MMA
#undef PG8_WAIT_V
#undef PG8_WAIT_L
#undef PG8_BAR
#undef PG8_SCHED
}
}

constexpr int S_ = 8192, D_ = 2048, FF_ = 5632, DIN = 4824, DINP = 4864;
constexpr int O_CQ = 0, O_CKV = 768, O_KR = 1280, O_QN = 1344, O_KN = 2880, O_VN = 4032, O_GN = 4800;
constexpr int NWAVES = 8, NTHR = 512;
constexpr size_t MiB = 1u << 20;
constexpr size_t WS_CTL = 0;
constexpr size_t WS_MODP = 507 * MiB;
constexpr size_t WS_MOD = 2 * MiB;
constexpr size_t WS_ROPE = 3 * MiB;
constexpr size_t WS_WGU1 = 6 * MiB;
constexpr size_t WS_WD1 = 50 * MiB;
constexpr size_t WS_WIN = 72 * MiB;
constexpr size_t WS_WUQ = 91 * MiB;
constexpr size_t WS_WUKV = 94 * MiB;
constexpr size_t WS_WCK1 = 96 * MiB;
constexpr size_t WS_WCV1 = 99 * MiB;
constexpr size_t WS_WCK2 = 101 * MiB;
constexpr size_t WS_WCV2 = 101 * MiB + 512 * 1024;
constexpr size_t WS_WOUT = 102 * MiB;
constexpr size_t WS_WGU2 = 110 * MiB;
constexpr size_t WS_WD2 = 154 * MiB;
constexpr size_t WS_H = 176 * MiB;
constexpr size_t WS_ACT = 208 * MiB;
constexpr size_t WS_X1 = 296 * MiB;
constexpr size_t WS_Q = 360 * MiB;
constexpr size_t WS_KV = 384 * MiB;
constexpr size_t WS_KR = 416 * MiB;
constexpr size_t WS_CQN = 417 * MiB;
constexpr size_t WS_CKVN = 429 * MiB;
constexpr size_t WS_FLATK = 437 * MiB;
constexpr size_t WS_FLATV = 449 * MiB;
constexpr size_t WS_PARTK = 457 * MiB;
constexpr size_t WS_PARTV = 469 * MiB;
constexpr size_t WS_HIDK = 473 * MiB;
constexpr size_t WS_HIDV = 473 * MiB + 512 * 1024;
constexpr size_t WS_KC = 474 * MiB;
constexpr size_t WS_VC = 474 * MiB + 512 * 1024;
constexpr size_t WS_MIXF = 475 * MiB;
constexpr size_t WS_H2 = 509 * MiB;
constexpr size_t WS_XBUF = 541 * MiB;
constexpr size_t WS_GW = 542 * MiB;
constexpr size_t WS_END = 543 * MiB;
constexpr int KCH_K = 512, NCH_K = 12, KCH_V = 1024, NCH_V = 4;

constexpr int RING_BYTES = 131072, LDSCTL_OFF = RING_BYTES, MISC_OFF = LDSCTL_OFF + 320, LDS_BYTES = 147456;

#define GAS __attribute__((address_space(1)))
#define LAS __attribute__((address_space(3)))
typedef unsigned short bf16;
typedef unsigned v4u __attribute__((ext_vector_type(4)));
typedef unsigned v2u __attribute__((ext_vector_type(2)));
typedef float f32x4 __attribute__((ext_vector_type(4)));
typedef GAS unsigned gu32;
#define RLX_AGENT __ATOMIC_RELAXED, __HIP_MEMORY_SCOPE_AGENT
#define LDS_WAIT() asm volatile("s_waitcnt lgkmcnt(0)" ::: "memory")
#define VM_WAIT() asm volatile("s_waitcnt vmcnt(0)" ::: "memory")
__device__ __forceinline__ unsigned f2bf(float f) { unsigned u = __builtin_bit_cast(unsigned, f); return (u + 0x7fffu + ((u >> 16) & 1u)) >> 16; }
__device__ __forceinline__ unsigned pk2(float lo, float hi) { return f2bf(lo) | (f2bf(hi) << 16); }
__device__ __forceinline__ float bflo(unsigned w) { return __builtin_bit_cast(float, w << 16); }
__device__ __forceinline__ float bfhi(unsigned w) { return __builtin_bit_cast(float, w & 0xffff0000u); }
__device__ __forceinline__ float bf1(bf16 b) { return __builtin_bit_cast(float, (unsigned)b << 16); }
__device__ __forceinline__ float wave_sum(float v) {
#pragma unroll
    for (int o = 1; o < 64; o <<= 1) v += __shfl_xor(v, o);
    return v;
}

#define XB_TMO      128
#define XB_XCNT(j)  (256  + 64 * (j))
#define XB_XSUB(j)  (1280 + 64 * (j))
#define XB_XGEN(j)  (2304 + 64 * (j))
#define XB_TOP      3328
#define XB_TOPGEN   3392
#define XCD_BAR_WORDS 3456
#define XB_SPIN_CAP (1u << 18)

__device__ __forceinline__ unsigned xb_ld(unsigned* p)              { return __hip_atomic_load(p, __ATOMIC_RELAXED, __HIP_MEMORY_SCOPE_AGENT); }
__device__ __forceinline__ unsigned xb_add(unsigned* p, unsigned v) { return __hip_atomic_fetch_add(p, v, __ATOMIC_RELAXED, __HIP_MEMORY_SCOPE_AGENT); }
__device__ __forceinline__ unsigned xb_xcc_id() { return (unsigned)__builtin_amdgcn_s_getreg((3 << 11) | 20) & 0xFu; }
#define XB_SPIN(cond, bar) do { unsigned _sp = 0; while (cond) { __builtin_amdgcn_s_sleep(1); \
    if ((++_sp & 255u) == 0u) { if (xb_ld(&(bar)[XB_TMO])) break; if (_sp > XB_SPIN_CAP) { atomicAdd(&(bar)[XB_TMO], 1u); break; } } } } while (0)

struct XcdBarrier {
    int w0;
    unsigned* bar; unsigned x;
    volatile LAS unsigned* st;
};

__device__ __forceinline__ int xb_lane() { int l; asm volatile("v_mbcnt_lo_u32_b32 %0, -1, 0\n\tv_mbcnt_hi_u32_b32 %0, -1, %0" : "=v"(l)); return l; }
__device__ __forceinline__ XcdBarrier xcd_barrier_post(unsigned* bar, volatile LAS unsigned* st, int w0) {
    XcdBarrier b; b.w0 = w0; b.bar = bar; b.x = xb_xcc_id(); b.st = st;
    if (w0 && xb_lane() == 0) (void)xb_add(&bar[XB_XCNT(b.x)], 1u);
    return b;
}
__device__ __forceinline__ void xcd_barrier_complete(unsigned* bar, unsigned x, unsigned& nloc, unsigned& nx) {
    const unsigned G = gridDim.x * gridDim.y * gridDim.z;
    unsigned sum, cnt, mine, sp = 0u;
    for (;;) {
        sum = 0u; cnt = 0u; mine = 0u;
#pragma unroll
        for (unsigned j = 0; j < 16; ++j) { const unsigned c = xb_ld(&bar[XB_XCNT(j)]); sum += c; cnt += (c > 0u) ? 1u : 0u; mine = (j == x) ? c : mine; }
        if (sum == G) break;
        __builtin_amdgcn_s_sleep(1);
        if ((++sp & 255u) == 0u) { if (xb_ld(&bar[XB_TMO])) break; if (sp > XB_SPIN_CAP) { atomicAdd(&bar[XB_TMO], 1u); break; } }
    }
    nloc = mine > 0u ? mine : 1u; nx = cnt > 0u ? cnt : 1u;
}

__device__ __forceinline__ void xcd_barrier(const XcdBarrier& b) {
    asm volatile("s_waitcnt vmcnt(0)" ::: "memory");
    __syncthreads();
    if (b.w0 && xb_lane() == 0) {
        unsigned* bar = b.bar;
        __builtin_amdgcn_s_waitcnt(0);
        unsigned nloc = b.st[0], nx = b.st[1];
        if (nloc == 0u) { xcd_barrier_complete(bar, b.x, nloc, nx); b.st[0] = nloc; b.st[1] = nx; }
        const unsigned old = xb_add(&bar[XB_XSUB(b.x)], 1u);
        const unsigned gen = old / nloc;
        if (old + 1u == (gen + 1u) * nloc) {
            __builtin_amdgcn_fence(__ATOMIC_RELEASE, "agent");
            asm volatile("s_waitcnt vmcnt(0)" ::: "memory");
            const unsigned og = xb_add(&bar[XB_TOP], 1u);
            const unsigned tg = og / nx;
            if (og + 1u == (tg + 1u) * nx) xb_add(&bar[XB_TOPGEN], 1u);
            else XB_SPIN(xb_ld(&bar[XB_TOPGEN]) == tg, bar);
            __builtin_amdgcn_fence(__ATOMIC_ACQUIRE, "agent");
            xb_add(&bar[XB_XGEN(b.x)], 1u);
            asm volatile("s_waitcnt vmcnt(0)" ::: "memory");
        } else {
            XB_SPIN(xb_ld(&bar[XB_XGEN(b.x)]) == gen, bar);
            __builtin_amdgcn_fence(__ATOMIC_ACQUIRE, "agent");
            asm volatile("s_waitcnt vmcnt(0)" ::: "memory");
        }
    }
    __syncthreads();
}

struct Ctx { LAS unsigned char* lds; int tid, lane, wave, vcu, G; };

struct TD { const float* W; bf16* WT; int K, Nreal, nblk, mode, item; };
__device__ __forceinline__ void tr_load(const TD& d, f32x4 (&v)[8], int lane) {
    const int kb = d.item / d.nblk, nb = d.item % d.nblk, k0 = 64 * kb, n0 = 32 * nb;
    const int n4 = (lane & 7) * 4, kr = lane >> 3; const bool ok = n0 + n4 < d.Nreal;
#pragma unroll
    for (int i = 0; i < 8; ++i) v[i] = ok ? __builtin_nontemporal_load((const f32x4*)(d.W + (size_t)(k0 + kr + 8 * i) * d.Nreal + n0 + n4)) : (f32x4){0.f, 0.f, 0.f, 0.f};
}
__device__ __forceinline__ void tr_store(const TD& d, const f32x4 (&v)[8], LAS float* scr, int lane) {
    const int kb = d.item / d.nblk, nb = d.item % d.nblk, k0 = 64 * kb, n0 = 32 * nb;
    const int n4 = (lane & 7) * 4, kr = lane >> 3;
#pragma unroll
    for (int i = 0; i < 8; ++i) { LAS float* p = scr + (kr + 8 * i) * 33 + n4; p[0] = v[i].x; p[1] = v[i].y; p[2] = v[i].z; p[3] = v[i].w; }
    LDS_WAIT(); asm volatile("" ::: "memory");
    const int c = lane & 7;
    const int drow0 = d.mode == 0 ? n0 : ((n0 >> 7) * 256 + (n0 & 127) + (d.mode == 2 ? 128 : 0));
#pragma unroll
    for (int j = 0; j < 4; ++j) { const int n = (lane >> 3) + 8 * j; const LAS float* s = scr + (8 * c) * 33 + n;
        v4u o; o.x = pk2(s[0 * 33], s[1 * 33]); o.y = pk2(s[2 * 33], s[3 * 33]); o.z = pk2(s[4 * 33], s[5 * 33]); o.w = pk2(s[6 * 33], s[7 * 33]);
        *(GAS v4u*)(d.WT + (size_t)(drow0 + n) * d.K + k0 + 8 * c) = o; }
    LDS_WAIT(); asm volatile("" ::: "memory");
}

struct P0Args { const float *w1g, *w1u, *w1d, *win, *wuq, *wukv, *ck1, *ck2, *cv1, *cv2, *wout, *w2g, *w2u, *w2d, *c, *wada; unsigned char* ws; };
constexpr int I_GU = 32 * 176, I_DN = 88 * 64, I_IN = 32 * 152, I_UQ = 12 * 48, I_UKV = 8 * 64, I_CK1 = 96 * 8, I_CK2 = 4 * 8, I_CV1 = 64 * 8, I_CV2 = 4 * 8, I_OUT = 32 * 64;
constexpr int NIT_A = 2 * I_GU, NIT_B = I_DN + I_IN, NIT_C = I_UQ + I_UKV + I_CK1 + I_CK2 + I_CV1 + I_CV2 + I_OUT + I_DN, NIT_D = 2 * I_GU;
__device__ __forceinline__ TD conv_desc(int grp, int r, const P0Args& a) {
    unsigned char* ws = a.ws;
    if (grp == 0) {
        if (r < I_GU) return TD{a.w1g, (bf16*)(ws + WS_WGU1), 2048, 5632, 176, 1, r}; r -= I_GU;
        return TD{a.w1u, (bf16*)(ws + WS_WGU1), 2048, 5632, 176, 2, r};
    } else if (grp == 1) {
        if (r < I_DN) return TD{a.w1d, (bf16*)(ws + WS_WD1), 5632, 2048, 64, 0, r}; r -= I_DN;
        return TD{a.win, (bf16*)(ws + WS_WIN), 2048, DIN, 152, 0, r};
    } else if (grp == 2) {
        if (r < I_UQ) return TD{a.wuq, (bf16*)(ws + WS_WUQ), 768, 1536, 48, 0, r}; r -= I_UQ;
        if (r < I_UKV) return TD{a.wukv, (bf16*)(ws + WS_WUKV), 512, 2048, 64, 0, r}; r -= I_UKV;
        if (r < I_CK1) return TD{a.ck1, (bf16*)(ws + WS_WCK1), 6144, 256, 8, 0, r}; r -= I_CK1;
        if (r < I_CK2) return TD{a.ck2, (bf16*)(ws + WS_WCK2), 256, 192, 8, 0, r}; r -= I_CK2;
        if (r < I_CV1) return TD{a.cv1, (bf16*)(ws + WS_WCV1), 4096, 256, 8, 0, r}; r -= I_CV1;
        if (r < I_CV2) return TD{a.cv2, (bf16*)(ws + WS_WCV2), 256, 128, 8, 0, r}; r -= I_CV2;
        if (r < I_OUT) return TD{a.wout, (bf16*)(ws + WS_WOUT), 2048, 2048, 64, 0, r}; r -= I_OUT;
        return TD{a.w2d, (bf16*)(ws + WS_WD2), 5632, 2048, 64, 0, r};
    }
    if (r < I_GU) return TD{a.w2g, (bf16*)(ws + WS_WGU2), 2048, 5632, 176, 1, r}; r -= I_GU;
    return TD{a.w2u, (bf16*)(ws + WS_WGU2), 2048, 5632, 176, 2, r};
}
__device__ __forceinline__ void conv_run(int grp, int first, int step, int nitems, const P0Args& a, LAS float* scr, int lane) {
    if (first >= nitems) return;
    f32x4 va[8], vb[8];
    TD da = conv_desc(grp, first, a); tr_load(da, va, lane);
    for (int it = first; it < nitems; it += 2 * step) {
        const bool hb = it + step < nitems; TD db = da;
        if (hb) { db = conv_desc(grp, it + step, a); tr_load(db, vb, lane); }
        tr_store(da, va, scr, lane);
        if (!hb) break;
        const bool ha = it + 2 * step < nitems;
        if (ha) { da = conv_desc(grp, it + 2 * step, a); tr_load(da, va, lane); }
        tr_store(db, vb, scr, lane);
        if (!ha) break;
    }
}
__device__ __forceinline__ void conv_tail(const Ctx& F, const P0Args& a, int grp, int nitems, int nwg) {
    const int G = F.G, rem = nwg % G, c = (int)blockIdx.x;
    int rank, nidle;
    if (rem == 0) { rank = c; nidle = G; } else { if (c < rem) return; rank = c - rem; nidle = G - rem; }
    LAS float* scr = (LAS float*)(F.lds + F.wave * 16384);
    conv_run(grp, rank * NWAVES + F.wave, nidle * NWAVES, nitems, a, scr, F.lane);
}
#ifndef GEMV_NT
#define GEMV_NT 1
#endif
#if GEMV_NT
#define GEMV_LD(p) __builtin_nontemporal_load(p)
#else
#define GEMV_LD(p) (*(p))
#endif
template <int NC>
__device__ __forceinline__ void gemv_block(const Ctx& F, const P0Args& a, int kc, int col0) {
    constexpr int NJ = (NC + 255) / 256;
    float* modp = (float*)(a.ws + WS_MODP);
    const float* wp = a.wada + (size_t)(kc * 128 + F.wave * 16) * 18432 + col0 + F.lane * 4; const float* cp = a.c + kc * 128 + F.wave * 16;
    f32x4 acc[NJ];
#pragma unroll
    for (int j = 0; j < NJ; ++j) acc[j] = (f32x4){0.f, 0.f, 0.f, 0.f};
#pragma unroll 4
    for (int i = 0; i < 16; ++i) { const float ci = cp[i]; const float sl = ci / (1.f + __expf(-ci)); const float* rp = wp + (size_t)i * 18432;
#pragma unroll
        for (int j = 0; j < NJ; ++j) if (256 * j + 256 <= NC || F.lane * 4 < NC - 256 * j) acc[j] += GEMV_LD((const f32x4*)(rp + 256 * j)) * sl; }
    __syncthreads();
    LAS float* red = (LAS float*)F.lds + F.wave * NC;
#pragma unroll
    for (int j = 0; j < NJ; ++j) if (256 * j + 256 <= NC || F.lane * 4 < NC - 256 * j) *(LAS f32x4*)(red + 256 * j + F.lane * 4) = acc[j];
    LDS_WAIT(); __syncthreads();
    for (int c = F.tid; c < NC; c += NTHR) { float s = 0.f;
#pragma unroll
        for (int w = 0; w < 8; ++w) s += ((const LAS float*)F.lds)[w * NC + c];
        modp[kc * 18432 + col0 + c] = s; }
    __syncthreads();
}
template <int NC>
__device__ __forceinline__ void gemv_tail(const Ctx& F, const P0Args& a, int cbase, int nblk, int nwg) {
    const int G = F.G, rem = nwg % G, c = (int)blockIdx.x;
    int rank, nidle;
    if (rem == 0) { rank = c; nidle = G; } else { if (c < rem) return; rank = c - rem; nidle = G - rem; }
    for (int r = rank; r < nblk; r += nidle) gemv_block<NC>(F, a, r & 15, cbase + (r >> 4) * NC);
}
__device__ __forceinline__ void mod_finalize(const Ctx& F, unsigned char* ws, const float* b_ada, int c0, int c1) {
    const float* modp = (const float*)(ws + WS_MODP); float* mod = (float*)(ws + WS_MOD);
    for (int col = c0 + (int)blockIdx.x * NTHR + F.tid; col < c1; col += F.G * NTHR) { float a = b_ada[col];
#pragma unroll
        for (int k = 0; k < 16; ++k) a += modp[k * 18432 + col]; mod[col] = a; }
}
__device__ __forceinline__ void p0_prologue(const Ctx& F, const P0Args& a, int parts = 7) {
    LAS float* scr = (LAS float*)(F.lds + F.wave * 16384);
    const int gw = F.vcu * NWAVES + F.wave, NGW = F.G * NWAVES;
    unsigned char* ws = a.ws;
    if (parts & 1) conv_run(0, gw, NGW, NIT_A, a, scr, F.lane);
    if (parts & 2) for (int b = (int)blockIdx.x; b < 256; b += F.G) gemv_block<1152>(F, a, b & 15, (b >> 4) * 1152);
    float* cs = (float*)(ws + WS_ROPE); float* sn = cs + 8192 * 32;
    if (parts & 4) for (int idx = (F.vcu * NTHR + F.tid); idx < 8192 * 32; idx += F.G * NTHR) {
        const int t = idx >> 5, i = idx & 31;
        const float inv = powf(10000.0f, -(float)(2 * i) / 64.0f); const float ang = (float)t * inv;
        cs[idx] = cosf(ang); sn[idx] = sinf(ang);
    }
}

__device__ __forceinline__ void norm_rows_bf16(const Ctx& F, const float* X, bf16* O, const LAS float* gwt, const LAS float* sht) {
    const int gw = F.vcu * NWAVES + F.wave, NGW = F.G * NWAVES;
    f32x4 v[8], nx[8];
    if (gw < S_) { const GAS f32x4* xr = (const GAS f32x4*)(X + (size_t)gw * D_) + F.lane;
#pragma unroll
        for (int j = 0; j < 8; ++j) v[j] = xr[64 * j]; }
    for (int m = gw; m < S_; m += NGW) {
        if (m + NGW < S_) { const GAS f32x4* xn = (const GAS f32x4*)(X + (size_t)(m + NGW) * D_) + F.lane;
#pragma unroll
            for (int j = 0; j < 8; ++j) nx[j] = xn[64 * j]; }
        float s = 0.f;
#pragma unroll
        for (int j = 0; j < 8; ++j) s += (v[j].x * v[j].x + v[j].y * v[j].y) + (v[j].z * v[j].z + v[j].w * v[j].w);
        const float rstd = 1.f / sqrtf(wave_sum(s) * (1.f / D_) + 1e-6f);
        GAS v2u* o8 = (GAS v2u*)(O + (size_t)m * D_) + F.lane;
#pragma unroll
        for (int j = 0; j < 8; ++j) { const f32x4 g = *(const LAS f32x4*)(gwt + 4 * (F.lane + 64 * j)), sh = *(const LAS f32x4*)(sht + 4 * (F.lane + 64 * j));
            const f32x4 y = v[j] * rstd * g + sh; v2u w; w.x = pk2(y.x, y.y); w.y = pk2(y.z, y.w); o8[64 * j] = w; }
#pragma unroll
        for (int j = 0; j < 8; ++j) v[j] = nx[j];
    }
}
__device__ __forceinline__ void build_mod_tables(const Ctx& F, unsigned char* ws, const float* nw, const float* b_ada, int chunk_sh, bool first, LAS float* gwt, LAS float* sht) {
    const float* modp = (const float*)(ws + WS_MODP); float* mod = (float*)(ws + WS_MOD);
    if (first) {
        for (int col = blockIdx.x * NTHR + F.tid; col < 18432; col += F.G * NTHR) { { float a = b_ada[col];
#pragma unroll
            for (int k = 0; k < 16; ++k) a += modp[k * 18432 + col]; mod[col] = a; } }
    }
    for (int c = F.tid; c < D_; c += NTHR) {
        float sh, sc;
        if (first) { sh = b_ada[chunk_sh * D_ + c]; sc = b_ada[(chunk_sh + 1) * D_ + c];
#pragma unroll
            for (int k = 0; k < 16; ++k) { sh += modp[k * 18432 + chunk_sh * D_ + c]; sc += modp[k * 18432 + (chunk_sh + 1) * D_ + c]; } }
        else { sh = mod[chunk_sh * D_ + c]; sc = mod[(chunk_sh + 1) * D_ + c]; }
        gwt[c] = nw[c] * (1.f + sc); sht[c] = sh;
    }
    LDS_WAIT(); __syncthreads();
}

__device__ __forceinline__ void p6_prep(const Ctx& F, unsigned char* ws, const float* qn_w, const float* kvn_w, const float* pe_k, const float* pe_v) {
    const bf16* U = (const bf16*)(ws + WS_ACT);
    bf16* CQN = (bf16*)(ws + WS_CQN); bf16* CKVN = (bf16*)(ws + WS_CKVN); bf16* KR = (bf16*)(ws + WS_KR);
    const float* cs = (const float*)(ws + WS_ROPE); const float* sn = cs + 8192 * 32;
    const int gw = F.vcu * NWAVES + F.wave, NGW = F.G * NWAVES;
    bf16* FK = (bf16*)(ws + WS_FLATK); bf16* FV = (bf16*)(ws + WS_FLATV);
    const int gt = F.vcu * NTHR + F.tid, NGT = F.G * NTHR;
    for (int t0 = gw; t0 < S_; t0 += 4 * NGW) {
        v2u a[4][3], b[4][2]; bf16 k1[4], k2[4]; float cc[4], ss[4];
        const int i = F.lane & 31;
#pragma unroll
        for (int k = 0; k < 4; ++k) { const int t = t0 + k * NGW; if (t < S_) { const bf16* ur = U + (size_t)t * DINP;
#pragma unroll
            for (int j = 0; j < 3; ++j) a[k][j] = *(const GAS v2u*)(ur + O_CQ + 4 * (F.lane + 64 * j));
#pragma unroll
            for (int j = 0; j < 2; ++j) b[k][j] = *(const GAS v2u*)(ur + O_CKV + 4 * (F.lane + 64 * j));
            k1[k] = ur[O_KR + i]; k2[k] = ur[O_KR + i + 32]; cc[k] = cs[t * 32 + i]; ss[k] = sn[t * 32 + i]; } }
        v4u uk[6];
        if (t0 == gw) {
#pragma unroll
            for (int q = 0; q < 6; ++q) { const int e = gt + q * NGT; const int r = e / 768, c8 = e % 768, l = c8 / 24, d0 = (c8 % 24) * 8, n = r >> 1, g = r & 1;
                uk[q] = (v4u){0u, 0u, 0u, 0u}; if (e < 1024 * 768 && r < 1022) uk[q] = *(const GAS v4u*)(U + (size_t)(16 * n + l) * DINP + O_KN + g * 192 + d0); }
        }
#pragma unroll
        for (int k = 0; k < 4; ++k) { const int t = t0 + k * NGW; if (t < S_) {
            float s = 0.f;
#pragma unroll
            for (int j = 0; j < 3; ++j) { const float x0 = bflo(a[k][j].x), x1 = bfhi(a[k][j].x), x2 = bflo(a[k][j].y), x3 = bfhi(a[k][j].y); s += (x0 * x0 + x1 * x1) + (x2 * x2 + x3 * x3); }
            float rstd = 1.f / sqrtf(wave_sum(s) * (1.f / 768.f) + 1e-6f);
#pragma unroll
            for (int j = 0; j < 3; ++j) { const int c0 = 4 * (F.lane + 64 * j); const f32x4 g = *(const f32x4*)(qn_w + c0);
                v2u w; w.x = pk2(bflo(a[k][j].x) * rstd * g.x, bfhi(a[k][j].x) * rstd * g.y); w.y = pk2(bflo(a[k][j].y) * rstd * g.z, bfhi(a[k][j].y) * rstd * g.w); *(GAS v2u*)(CQN + (size_t)t * 768 + c0) = w; }
            s = 0.f;
#pragma unroll
            for (int j = 0; j < 2; ++j) { const float x0 = bflo(b[k][j].x), x1 = bfhi(b[k][j].x), x2 = bflo(b[k][j].y), x3 = bfhi(b[k][j].y); s += (x0 * x0 + x1 * x1) + (x2 * x2 + x3 * x3); }
            rstd = 1.f / sqrtf(wave_sum(s) * (1.f / 512.f) + 1e-6f);
#pragma unroll
            for (int j = 0; j < 2; ++j) { const int c0 = 4 * (F.lane + 64 * j); const f32x4 g = *(const f32x4*)(kvn_w + c0);
                v2u w; w.x = pk2(bflo(b[k][j].x) * rstd * g.x, bfhi(b[k][j].x) * rstd * g.y); w.y = pk2(bflo(b[k][j].y) * rstd * g.z, bfhi(b[k][j].y) * rstd * g.w); *(GAS v2u*)(CKVN + (size_t)t * 512 + c0) = w; }
            if (F.lane < 32) { const float t1 = bf1(k1[k]), t2 = bf1(k2[k]);
                KR[(size_t)t * 64 + i] = (bf16)f2bf(t1 * cc[k] - t2 * ss[k]); KR[(size_t)t * 64 + i + 32] = (bf16)f2bf(t1 * ss[k] + t2 * cc[k]); } } }
        if (t0 == gw) {
            v4u uv[4];
#pragma unroll
            for (int q = 0; q < 4; ++q) { const int e = gt + q * NGT; const int r = e / 512, c8 = e % 512, l = c8 / 16, d0 = (c8 % 16) * 8, n = r >> 1, g = r & 1;
                uv[q] = (v4u){0u, 0u, 0u, 0u}; if (e < 1024 * 512 && r < 1022) uv[q] = *(const GAS v4u*)(U + (size_t)(16 * n + l) * DINP + O_VN + g * 128 + d0); }
#pragma unroll
            for (int q = 0; q < 6; ++q) { const int e = gt + q * NGT; if (e < 1024 * 768) { const int r = e / 768, c8 = e % 768, l = c8 / 24, d0 = (c8 % 24) * 8;
                v4u o = (v4u){0u, 0u, 0u, 0u}; const v4u u = uk[q];
                if (r < 1022) { const f32x4 p0 = *(const f32x4*)(pe_k + l * 192 + d0), p1 = *(const f32x4*)(pe_k + l * 192 + d0 + 4);
                    o.x = pk2(bflo(u.x) + p0.x, bfhi(u.x) + p0.y); o.y = pk2(bflo(u.y) + p0.z, bfhi(u.y) + p0.w); o.z = pk2(bflo(u.z) + p1.x, bfhi(u.z) + p1.y); o.w = pk2(bflo(u.w) + p1.z, bfhi(u.w) + p1.w); }
                *(GAS v4u*)(FK + (size_t)r * 6144 + c8 * 8) = o; } }
#pragma unroll
            for (int q = 0; q < 4; ++q) { const int e = gt + q * NGT; if (e < 1024 * 512) { const int r = e / 512, c8 = e % 512, l = c8 / 16, d0 = (c8 % 16) * 8;
                v4u o = (v4u){0u, 0u, 0u, 0u}; const v4u u = uv[q];
                if (r < 1022) { const f32x4 p0 = *(const f32x4*)(pe_v + l * 128 + d0), p1 = *(const f32x4*)(pe_v + l * 128 + d0 + 4);
                    o.x = pk2(bflo(u.x) + p0.x, bfhi(u.x) + p0.y); o.y = pk2(bflo(u.y) + p0.z, bfhi(u.y) + p0.w); o.z = pk2(bflo(u.z) + p1.x, bfhi(u.z) + p1.y); o.w = pk2(bflo(u.w) + p1.z, bfhi(u.w) + p1.w); }
                *(GAS v4u*)(FV + (size_t)r * 4096 + c8 * 8) = o; } }
        }
    }
    for (int e = gt + 6 * NGT; e < 1024 * 768; e += NGT) {
        const int r = e / 768, c8 = e % 768, l = c8 / 24, d0 = (c8 % 24) * 8, n = r >> 1, g = r & 1;
        v4u o = (v4u){0u, 0u, 0u, 0u};
        if (r < 1022) { const v4u u = *(const GAS v4u*)(U + (size_t)(16 * n + l) * DINP + O_KN + g * 192 + d0); const f32x4 p0 = *(const f32x4*)(pe_k + l * 192 + d0), p1 = *(const f32x4*)(pe_k + l * 192 + d0 + 4);
            o.x = pk2(bflo(u.x) + p0.x, bfhi(u.x) + p0.y); o.y = pk2(bflo(u.y) + p0.z, bfhi(u.y) + p0.w); o.z = pk2(bflo(u.z) + p1.x, bfhi(u.z) + p1.y); o.w = pk2(bflo(u.w) + p1.z, bfhi(u.w) + p1.w); }
        *(GAS v4u*)(FK + (size_t)r * 6144 + c8 * 8) = o;
    }
    for (int e = gt + 4 * NGT; e < 1024 * 512; e += NGT) {
        const int r = e / 512, c8 = e % 512, l = c8 / 16, d0 = (c8 % 16) * 8, n = r >> 1, g = r & 1;
        v4u o = (v4u){0u, 0u, 0u, 0u};
        if (r < 1022) { const v4u u = *(const GAS v4u*)(U + (size_t)(16 * n + l) * DINP + O_VN + g * 128 + d0); const f32x4 p0 = *(const f32x4*)(pe_v + l * 128 + d0), p1 = *(const f32x4*)(pe_v + l * 128 + d0 + 4);
            o.x = pk2(bflo(u.x) + p0.x, bfhi(u.x) + p0.y); o.y = pk2(bflo(u.y) + p0.z, bfhi(u.y) + p0.w); o.z = pk2(bflo(u.z) + p1.x, bfhi(u.z) + p1.y); o.w = pk2(bflo(u.w) + p1.z, bfhi(u.w) + p1.w); }
        *(GAS v4u*)(FV + (size_t)r * 4096 + c8 * 8) = o;
    }
}

__device__ __forceinline__ void p8_prep2(const Ctx& F, unsigned char* ws) {
    const int gt = F.vcu * NTHR + F.tid, NGT = F.G * NTHR;
    const float* PK = (const float*)(ws + WS_PARTK); const float* PV = (const float*)(ws + WS_PARTV);
    bf16* HK = (bf16*)(ws + WS_HIDK); bf16* HV = (bf16*)(ws + WS_HIDV);
    for (int e = gt; e < 2 * 65536; e += NGT) {
        const int which = e >> 16, q4 = e & 65535; const float* P = which ? PV : PK; const int nch = which ? NCH_V : NCH_K;
        f32x4 pv[12];
#pragma unroll
        for (int s = 0; s < 12; ++s) { pv[s] = (f32x4){0.f, 0.f, 0.f, 0.f}; if (s < nch) pv[s] = *(const f32x4*)(P + (size_t)s * 262144 + q4 * 4); }
        f32x4 a = pv[0];
#pragma unroll
        for (int s = 1; s < 12; ++s) a += pv[s];
        v2u w; w.x = pk2(a.x / (1.f + __expf(-a.x)), a.y / (1.f + __expf(-a.y))); w.y = pk2(a.z / (1.f + __expf(-a.z)), a.w / (1.f + __expf(-a.w)));
        *(GAS v2u*)((which ? HV : HK) + q4 * 4) = w;
    }
}

__device__ __forceinline__ void bias_gemv(const Ctx& F, const bf16* WT, int N, const float* sh, float* cb) {
    const int gw = F.vcu * NWAVES + F.wave, NGW = F.G * NWAVES;
    f32x4 s[8];
#pragma unroll
    for (int j = 0; j < 8; ++j) s[j] = *(const f32x4*)(sh + 4 * (F.lane + 64 * j));
    for (int n = gw; n < N; n += NGW) {
        const GAS v2u* wr_ = (const GAS v2u*)(WT + (size_t)n * 2048) + F.lane; float a = 0.f;
#pragma unroll
        for (int j = 0; j < 8; ++j) { const v2u w = wr_[64 * j]; a += (bflo(w.x) * s[j].x + bfhi(w.x) * s[j].y) + (bflo(w.y) * s[j].z + bfhi(w.y) * s[j].w); }
        a = wave_sum(a);
        if (F.lane == 0) cb[n] = a;
    }
}

__device__ __forceinline__ void final_norm_b(const Ctx& F, const bf16* X3, float* out, const float* nw) {
    const int gw = F.vcu * NWAVES + F.wave, NGW = F.G * NWAVES;
    v4u v[4], nx[4];
    if (gw < S_) { const GAS v4u* xr = (const GAS v4u*)(X3 + (size_t)gw * D_) + F.lane;
#pragma unroll
        for (int j = 0; j < 4; ++j) v[j] = xr[64 * j]; }
    for (int m = gw; m < S_; m += NGW) {
        if (m + NGW < S_) { const GAS v4u* xn = (const GAS v4u*)(X3 + (size_t)(m + NGW) * D_) + F.lane;
#pragma unroll
            for (int j = 0; j < 4; ++j) nx[j] = xn[64 * j]; }
        float s = 0.f;
#pragma unroll
        for (int j = 0; j < 4; ++j) { const float x0 = bflo(v[j].x), x1 = bfhi(v[j].x), x2 = bflo(v[j].y), x3 = bfhi(v[j].y), x4 = bflo(v[j].z), x5 = bfhi(v[j].z), x6 = bflo(v[j].w), x7 = bfhi(v[j].w);
            s += ((x0 * x0 + x1 * x1) + (x2 * x2 + x3 * x3)) + ((x4 * x4 + x5 * x5) + (x6 * x6 + x7 * x7)); }
        const float rstd = 1.f / sqrtf(wave_sum(s) * (1.f / D_) + 1e-6f);
        float* orow = out + (size_t)m * D_;
#pragma unroll
        for (int j = 0; j < 4; ++j) { const int c0 = 8 * (F.lane + 64 * j); const f32x4 g0 = *(const f32x4*)(nw + c0), g1 = *(const f32x4*)(nw + c0 + 4);
            f32x4 y0, y1; y0.x = bflo(v[j].x) * rstd * g0.x; y0.y = bfhi(v[j].x) * rstd * g0.y; y0.z = bflo(v[j].y) * rstd * g0.z; y0.w = bfhi(v[j].y) * rstd * g0.w;
            y1.x = bflo(v[j].z) * rstd * g1.x; y1.y = bfhi(v[j].z) * rstd * g1.y; y1.z = bflo(v[j].w) * rstd * g1.z; y1.w = bfhi(v[j].w) * rstd * g1.w;
            *(GAS f32x4*)(orow + c0) = y0; *(GAS f32x4*)(orow + c0 + 4) = y1; }
#pragma unroll
        for (int j = 0; j < 4; ++j) v[j] = nx[j];
    }
}
__device__ __forceinline__ void final_norm(const Ctx& F, float* out, const float* nw) {
    const int gw = F.vcu * NWAVES + F.wave, NGW = F.G * NWAVES;
    f32x4 v[8], nx[8];
    if (gw < S_) { const GAS f32x4* xr = (const GAS f32x4*)(out + (size_t)gw * D_) + F.lane;
#pragma unroll
        for (int j = 0; j < 8; ++j) v[j] = xr[64 * j]; }
    for (int m = gw; m < S_; m += NGW) {
        if (m + NGW < S_) { const GAS f32x4* xn = (const GAS f32x4*)(out + (size_t)(m + NGW) * D_) + F.lane;
#pragma unroll
            for (int j = 0; j < 8; ++j) nx[j] = xn[64 * j]; }
        GAS f32x4* xr = (GAS f32x4*)(out + (size_t)m * D_) + F.lane;
        float s = 0.f;
#pragma unroll
        for (int j = 0; j < 8; ++j) s += (v[j].x * v[j].x + v[j].y * v[j].y) + (v[j].z * v[j].z + v[j].w * v[j].w);
        const float rstd = 1.f / sqrtf(wave_sum(s) * (1.f / D_) + 1e-6f);
#pragma unroll
        for (int j = 0; j < 8; ++j) { const f32x4 g = *(const f32x4*)(nw + 4 * (F.lane + 64 * j)); xr[64 * j] = v[j] * rstd * g; }
#pragma unroll
        for (int j = 0; j < 8; ++j) v[j] = nx[j];
    }
}

#ifndef PROBE_A1
#define PROBE_A1 0.f
#endif
#ifndef PROBE_A2
#define PROBE_A2 0.f
#endif
#ifndef PROBE_A3
#define PROBE_A3 0.f
#endif
namespace att {
typedef short bf16x8 __attribute__((ext_vector_type(8)));
typedef short s16x4 __attribute__((ext_vector_type(4)));
typedef short v4i16_t __attribute__((ext_vector_type(4)));
typedef float f32x16 __attribute__((ext_vector_type(16)));
typedef LAS const char* lds_cptr;
typedef unsigned u32x4 __attribute__((ext_vector_type(4)));
constexpr int KSLOT = 24576, VSLOT = 16384;
constexpr int L_K = 0, L_V = 2 * KSLOT, L_WSF = L_V + 2 * VSLOT, L_BT = L_WSF + 2048, L_IMP = L_BT + 2048, L_SEL = L_IMP + 32768, L_LIST = L_SEL + 1024, L_MISC = L_LIST + 512, L_END = L_MISC + 256;
static_assert(L_END <= RING_BYTES, "attention LDS map");
constexpr float LOG2E = 1.4426950408889634f;
constexpr float C2 = 0.07216878364870322f * LOG2E;
constexpr float THR = 8.0f;
#ifndef ATT_RESCALE
#define ATT_RESCALE 0
#endif
#ifndef ATT_STAGGER
#define ATT_STAGGER 0
#endif
__device__ __forceinline__ int lane_id() { int l; asm volatile("v_mbcnt_lo_u32_b32 %0, -1, 0\n\tv_mbcnt_hi_u32_b32 %0, -1, %0" : "=v"(l)); return l; }
__device__ __forceinline__ int crow(int r, int hi) { return (r & 3) + 8 * (r >> 2) + 4 * hi; }
__device__ __forceinline__ void glds16(const void* gsrc, unsigned lds_dst) { unsigned keep;
    asm volatile("s_mov_b32 %0, m0\n\ts_mov_b32 m0, %2\n\ts_nop 0\n\tglobal_load_lds_dwordx4 %1, off\n\ts_mov_b32 m0, %0" : "=&s"(keep) : "v"(gsrc), "s"(lds_dst) : "memory"); }
#define ATT_WAIT_BAR() asm volatile("s_waitcnt vmcnt(0) lgkmcnt(0)\n\ts_barrier" ::: "memory")
__device__ __forceinline__ unsigned cvtpk(float lo, float hi) { typedef float f2 __attribute__((ext_vector_type(2))); typedef __bf16 b2 __attribute__((ext_vector_type(2))); f2 v = {lo, hi}; b2 b = __builtin_convertvector(v, b2); return __builtin_bit_cast(unsigned, b); }
__device__ __forceinline__ s16x4 vtr(lds_cptr p) { return __builtin_bit_cast(s16x4, __builtin_amdgcn_ds_read_tr16_b64_v4i16((LAS v4i16_t*)p)); }
__device__ __forceinline__ float xhalf_max(float m) { auto rr = __builtin_amdgcn_permlane32_swap(__float_as_uint(m), __float_as_uint(m), false, false); return fmaxf(__uint_as_float(rr[0]), __uint_as_float(rr[1])); }
__device__ __forceinline__ float xhalf_sum(float m) { auto rr = __builtin_amdgcn_permlane32_swap(__float_as_uint(m), __float_as_uint(m), false, false); return __uint_as_float(rr[0]) + __uint_as_float(rr[1]); }

template <int NKS, bool NOMMA = false>
__device__ __forceinline__ void qk_tile(f32x16& p0, f32x16& p1, lds_cptr kslot, const bf16x8* qf, int r32, int hi) {
    const lds_cptr kb = kslot + hi * 1024 + r32 * 16;
    p0 = f32x16{}; p1 = f32x16{};
    bf16x8 fa[3], fb[3];
#define QK_LD(ks) do { fa[(ks) % 3] = *(const LAS bf16x8*)(kb + (ks) * 2048); fb[(ks) % 3] = *(const LAS bf16x8*)(kb + (ks) * 2048 + 512); } while (0)
    QK_LD(0); QK_LD(1);
#pragma unroll
    for (int ks = 0; ks < NKS; ++ks) {
        if (ks + 2 < NKS) QK_LD(ks + 2);
        if (NOMMA) { asm volatile("" :: "v"(fa[ks % 3]), "v"(fb[ks % 3])); }
        else { p0 = __builtin_amdgcn_mfma_f32_32x32x16_bf16(fa[ks % 3], qf[ks], p0, 0, 0, 0);
        p1 = __builtin_amdgcn_mfma_f32_32x32x16_bf16(fb[ks % 3], qf[ks], p1, 0, 0, 0); }
        __builtin_amdgcn_sched_barrier(0);
    }
#undef QK_LD
}
struct Soft { float mhat, l; };
template <bool SCALED>
__device__ __forceinline__ void softmax_tile(f32x16& p0, f32x16& p1, Soft& st, f32x16 (&o)[4], bool first, LAS float* wsf, int r32, int hi, float cb = 0.f) {
#if !ATT_RESCALE
    if (first) {
#endif
    float a = fmaxf(p0[0], p1[0]), b = fmaxf(p0[1], p1[1]);
#pragma unroll
    for (int r = 2; r < 16; r += 2) { a = fmaxf(a, fmaxf(p0[r], p1[r])); b = fmaxf(b, fmaxf(p0[r + 1], p1[r + 1])); }
    float rm = xhalf_max(fmaxf(a, b));
    if (!SCALED) rm = fmaf(rm, C2, cb);
    if (first) { st.mhat = rm > -1e30f ? rm : 0.f; }
#if !ATT_RESCALE
    }
#endif
#if ATT_RESCALE
    else if (__any(rm > st.mhat + THR)) {
        const float nm = fmaxf(st.mhat, rm); const float f = __builtin_amdgcn_exp2f(st.mhat - nm); st.l *= f; st.mhat = nm;
        if (hi == 0) wsf[r32] = f;
        LDS_WAIT();
        LAS float* wb = wsf + 4 * hi; asm volatile("" : "+v"(wb));
#pragma unroll
        for (int r = 0; r < 16; ++r) { const float fr = wb[(r & 3) + 8 * (r >> 2)];
#pragma unroll
            for (int d = 0; d < 4; ++d) o[d][r] *= fr;
            asm volatile("" ::: "memory"); }
    }
#endif
    float s = 0.f; const float nb = SCALED ? -st.mhat : cb - st.mhat;
#pragma unroll
    for (int r = 0; r < 16; ++r) {
        if (SCALED) { p0[r] = __builtin_amdgcn_exp2f(p0[r] + nb); p1[r] = __builtin_amdgcn_exp2f(p1[r] + nb); }
        else { p0[r] = __builtin_amdgcn_exp2f(fmaf(p0[r], C2, nb)); p1[r] = __builtin_amdgcn_exp2f(fmaf(p1[r], C2, nb)); }
        s += p0[r] + p1[r]; }
    st.l += s;
}
__device__ __forceinline__ float rowmax32(const f32x16& p0, const f32x16& p1) {
    float a = fmaxf(p0[0], p1[0]), b = fmaxf(p0[1], p1[1]);
#pragma unroll
    for (int r = 2; r < 16; r += 2) { a = fmaxf(a, fmaxf(p0[r], p1[r])); b = fmaxf(b, fmaxf(p0[r + 1], p1[r + 1])); }
    return xhalf_max(fmaxf(a, b));
}
template <int NKS, bool NOMMA, int MODE = 0, bool NOEXP = false, bool NOLDS = false>
__device__ __forceinline__ float qk_tile_x(f32x16& p0, f32x16& p1, lds_cptr kslot, const bf16x8* qf, int r32, int hi, float nb, int kd = 0) {
    const lds_cptr kb = kslot + hi * 1024 + r32 * 16;
    p0 = f32x16{}; p1 = f32x16{};
    bf16x8 fr[6]; float ls = 0.f;
#define QX_LD(s_) do { if (NOLDS) { fr[(s_) % 6] = qf[(s_) % NKS]; } else fr[(s_) % 6] = *(const LAS bf16x8*)(kb + ((s_) % NKS) * 2048 + ((s_) / NKS) * 512); } while (0)
#define QX_EXP(e_) do { if (NOEXP) break; const float nb_ = (MODE == 1 && (((e_) & 3) + 8 * ((e_) >> 2)) > kd) ? -INFINITY : nb; p0[e_] = __builtin_amdgcn_exp2f(fmaf(p0[e_], C2, nb_)); ls += p0[e_]; } while (0)
    QX_LD(0); QX_LD(1); QX_LD(2); QX_LD(3); QX_LD(4);
#pragma unroll
    for (int s_ = 0; s_ < 2 * NKS; ++s_) {
        if (s_ + 5 < 2 * NKS) QX_LD(s_ + 5);
        if (s_ < NKS) { if (!NOMMA) p0 = __builtin_amdgcn_mfma_f32_32x32x16_bf16(fr[s_ % 6], qf[s_], p0, 0, 0, 0); else asm volatile("" :: "v"(fr[s_ % 6])); }
        else {
            if (!NOMMA) p1 = __builtin_amdgcn_mfma_f32_32x32x16_bf16(fr[s_ % 6], qf[s_ - NKS], p1, 0, 0, 0); else asm volatile("" :: "v"(fr[s_ % 6]));
            const int g_ = s_ - NKS - 2;
            if (g_ >= 0 && g_ < 6) { QX_EXP(2 * g_); QX_EXP(2 * g_ + 1); }
            else if (g_ >= 6) { QX_EXP(6 + g_); }
        }
        __builtin_amdgcn_sched_barrier(0);
    }
#undef QX_LD
#undef QX_EXP
    return ls;
}
template <bool NOMMA, int MODE = 0, bool NOEXP = false, bool NOLDS = false>
__device__ __forceinline__ float pv_tile_x(f32x16 (&o)[4], const f32x16& p0, f32x16& p1, float nb, lds_cptr vslot, int lane, int hi, int kd = 0) {
    const lds_cptr vp = vslot + ((lane >> 4) & 1) * 32 + (lane & 3) * 8 + (4 * hi + ((lane & 15) >> 2)) * 64;
    u32x4 pw[4]; float ls = 0.f;
    pw[0] = (u32x4){cvtpk(p0[0], p0[1]), cvtpk(p0[2], p0[3]), cvtpk(p0[4], p0[5]), cvtpk(p0[6], p0[7])};
    pw[1] = (u32x4){cvtpk(p0[8], p0[9]), cvtpk(p0[10], p0[11]), cvtpk(p0[12], p0[13]), cvtpk(p0[14], p0[15])};
    s16x4 vlo[5], vhi[5];
#define PX_LD(st_) do { if (NOLDS) { vlo[(st_) % 5] = __builtin_bit_cast(s16x4, (unsigned long long)(st_) * 0x0101010101010101ull + (unsigned long long)lane); vhi[(st_) % 5] = vlo[(st_) % 5]; } else { vlo[(st_) % 5] = vtr(vp + ((st_) & 3) * 4096 + ((st_) >> 2) * 1024); vhi[(st_) % 5] = vtr(vp + ((st_) & 3) * 4096 + ((st_) >> 2) * 1024 + 512); } } while (0)
    PX_LD(0); PX_LD(1); PX_LD(2); PX_LD(3);
#pragma unroll
    for (int st_ = 0; st_ < 16; ++st_) {
        if (st_ + 4 < 16) PX_LD(st_ + 4);
        if (st_ == 8) { pw[2] = (u32x4){cvtpk(p1[0], p1[1]), cvtpk(p1[2], p1[3]), cvtpk(p1[4], p1[5]), cvtpk(p1[6], p1[7])};
                        pw[3] = (u32x4){cvtpk(p1[8], p1[9]), cvtpk(p1[10], p1[11]), cvtpk(p1[12], p1[13]), cvtpk(p1[14], p1[15])}; }
        const s16x4 lo = vlo[st_ % 5], hh = vhi[st_ % 5];
        const bf16x8 vf = (bf16x8){lo[0], lo[1], lo[2], lo[3], hh[0], hh[1], hh[2], hh[3]};
        if (!NOMMA) o[st_ & 3] = __builtin_amdgcn_mfma_f32_32x32x16_bf16(__builtin_bit_cast(bf16x8, pw[st_ >> 2]), vf, o[st_ & 3], 0, 0, 0); else asm volatile("" :: "v"(vf), "v"(pw[st_ >> 2]));
        if (NOEXP) { } else if (st_ < 8) {
#define PX_NB(e_) ((MODE == 1 && (((e_) & 3) + 8 * ((e_) >> 2) + 32) > kd) ? -INFINITY : nb)
            p1[2 * st_] = __builtin_amdgcn_exp2f(fmaf(p1[2 * st_], C2, PX_NB(2 * st_))); p1[2 * st_ + 1] = __builtin_amdgcn_exp2f(fmaf(p1[2 * st_ + 1], C2, PX_NB(2 * st_ + 1)));
#undef PX_NB
        }
        else { ls += p1[2 * (st_ - 8)] + p1[2 * (st_ - 8) + 1]; }
        __builtin_amdgcn_sched_barrier(0);
    }
#undef PX_LD
    return ls;
}
template <bool NOBAR = false>
__device__ __forceinline__ void wait_bar_n(int n) {
    if (NOBAR) { asm volatile("s_waitcnt vmcnt(0) lgkmcnt(0)" ::: "memory"); return; }
    if (n == 3) asm volatile("s_waitcnt vmcnt(3) lgkmcnt(0)\n\ts_barrier" ::: "memory");
    else if (n == 2) asm volatile("s_waitcnt vmcnt(2) lgkmcnt(0)\n\ts_barrier" ::: "memory");
    else asm volatile("s_waitcnt vmcnt(0) lgkmcnt(0)\n\ts_barrier" ::: "memory");
}
template <bool G1, int NKP, int NVP, bool NOBAR, class SK, class SV, class FA, class FB>
__device__ __forceinline__ void tile_stream_g(int nt, SK stageK, SV stageV, FA fa, FB fb) {
    if (nt <= 0) return;
    stageK(0, 0); stageV(0, 0);
    if (nt > 1) { stageK(1, 1); stageV(1, 1); }
    int pend = 0;
    if (G1) { wait_bar_n<NOBAR>(0); }
    for (int t = 0; t < nt; ++t) {
        f32x16 p0 = f32x16{}, p1 = f32x16{};
        wait_bar_n<NOBAR>(pend); pend = 0;
        if (G1) { if (t >= 1 && t + 1 < nt) { stageV(t + 1, (t + 1) & 1); pend = NVP; } } else { if (t >= 1 && t + 1 < nt) { stageK(t + 1, (t + 1) & 1); pend = NKP; } }
        fa(t, t & 1, p0, p1);
        wait_bar_n<NOBAR>(pend); pend = 0;
        if (G1) { if (t + 2 < nt) { stageK(t + 2, t & 1); pend = NKP; } } else { if (t >= 1 && t + 1 < nt) { stageV(t + 1, (t + 1) & 1); pend = NVP; } }
        fb(t, t & 1, p0, p1);
    }
    if (!G1) { wait_bar_n<NOBAR>(pend); }
}
template <bool NOBAR, class SK, class SV, class FA, class FB>
__device__ __forceinline__ void tile_stream_1(int nt, SK stageK, SV stageV, FA fa, FB fb) {
    if (nt <= 0) return;
    stageK(0, 0); stageV(0, 0);
    for (int t = 0; t < nt; ++t) {
        f32x16 p0 = f32x16{}, p1 = f32x16{};
        wait_bar_n<NOBAR>(0);
        if (t + 1 < nt) { stageK(t + 1, (t + 1) & 1); stageV(t + 1, (t + 1) & 1); }
        fa(t, t & 1, p0, p1);
        fb(t, t & 1, p0, p1);
    }
    wait_bar_n<NOBAR>(0);
}
template <bool NOBAR, class GI, class SK, class SV, class FA, class FB>
__device__ __forceinline__ void tile_stream_id(int nt, GI getid, SK stageK, SV stageV, FA fa, FB fb) {
    if (nt <= 0) return;
    int idn = getid(0);
    stageK(0, 0, idn); stageV(0, 0, idn);
    for (int t = 0; t < nt; ++t) {
        const int idc = idn;
        if (t + 1 < nt) idn = getid(t + 1);
        f32x16 p0 = f32x16{}, p1 = f32x16{};
        wait_bar_n<NOBAR>(0);
        if (t + 1 < nt) { stageK(t + 1, (t + 1) & 1, idn); stageV(t + 1, (t + 1) & 1, idn); }
        fa(t, t & 1, idc, p0, p1);
        fb(t, t & 1, idc, p0, p1);
    }
    wait_bar_n<NOBAR>(0);
}
template <int NKP, int NVP, bool NOBAR = false, class SK, class SV, class FA, class FB>
__device__ __forceinline__ void tile_stream(int nt, bool g1, SK stageK, SV stageV, FA fa, FB fb) {
#if ATT_STAGGER
    if (g1) tile_stream_g<true, NKP, NVP, NOBAR>(nt, stageK, stageV, fa, fb); else tile_stream_g<false, NKP, NVP, NOBAR>(nt, stageK, stageV, fa, fb);
#else
    tile_stream_1<NOBAR>(nt, stageK, stageV, fa, fb);
#endif
}
template <bool NOMMA = false>
__device__ __forceinline__ void pv_tile(f32x16 (&o)[4], const f32x16& p0, const f32x16& p1, lds_cptr vslot, int lane, int hi) {
    const lds_cptr vp = vslot + ((lane >> 4) & 1) * 32 + (lane & 3) * 8 + (4 * hi + ((lane & 15) >> 2)) * 64;
    u32x4 pw[4];
    pw[0] = (u32x4){cvtpk(p0[0], p0[1]), cvtpk(p0[2], p0[3]), cvtpk(p0[4], p0[5]), cvtpk(p0[6], p0[7])};
    pw[1] = (u32x4){cvtpk(p0[8], p0[9]), cvtpk(p0[10], p0[11]), cvtpk(p0[12], p0[13]), cvtpk(p0[14], p0[15])};
    pw[2] = (u32x4){cvtpk(p1[0], p1[1]), cvtpk(p1[2], p1[3]), cvtpk(p1[4], p1[5]), cvtpk(p1[6], p1[7])};
    pw[3] = (u32x4){cvtpk(p1[8], p1[9]), cvtpk(p1[10], p1[11]), cvtpk(p1[12], p1[13]), cvtpk(p1[14], p1[15])};
    s16x4 vlo[5], vhi[5];
#define PV_LD(st_) do { vlo[(st_) % 5] = vtr(vp + ((st_) >> 2) * 4096 + ((st_) & 3) * 1024); vhi[(st_) % 5] = vtr(vp + ((st_) >> 2) * 4096 + ((st_) & 3) * 1024 + 512); } while (0)
    PV_LD(0); PV_LD(1); PV_LD(2); PV_LD(3);
#pragma unroll
    for (int st_ = 0; st_ < 16; ++st_) {
        if (st_ + 4 < 16) PV_LD(st_ + 4);
        const s16x4 lo = vlo[st_ % 5], hh = vhi[st_ % 5];
        const bf16x8 vf = (bf16x8){lo[0], lo[1], lo[2], lo[3], hh[0], hh[1], hh[2], hh[3]};
        if (NOMMA) { asm volatile("" :: "v"(vf), "v"(pw[st_ & 3])); } else
        o[st_ >> 2] = __builtin_amdgcn_mfma_f32_32x32x16_bf16(__builtin_bit_cast(bf16x8, pw[st_ & 3]), vf, o[st_ >> 2], 0, 0, 0);
        __builtin_amdgcn_sched_barrier(0);
    }
#undef PV_LD
}
__device__ __forceinline__ void mla_stage_k(int tl, int h, const bf16* KV, const bf16* KR, unsigned kdst, int wid) {
    const int lane = lane_id();
    const size_t row = (size_t)(64 * tl + lane);
    glds16(KV + row * 2048 + h * 256 + wid * 8, (unsigned)__builtin_amdgcn_readfirstlane(kdst + wid * 1024));
    glds16(KV + row * 2048 + h * 256 + (wid + 8) * 8, (unsigned)__builtin_amdgcn_readfirstlane(kdst + (wid + 8) * 1024));
    glds16(KR + row * 64 + wid * 8, (unsigned)__builtin_amdgcn_readfirstlane(kdst + (wid + 16) * 1024));
}
__device__ __forceinline__ void mla_stage_v(int tl, int h, const bf16* KV, unsigned vdst, int wid) {
    const int lane = lane_id();
#pragma unroll
    for (int i = 0; i < 2; ++i) { const int p = wid + 8 * i, d0 = p >> 2, ks = p & 3;
        glds16(KV + (size_t)(64 * tl + 16 * ks + (lane >> 2)) * 2048 + h * 256 + 128 + d0 * 32 + (lane & 3) * 8, (unsigned)__builtin_amdgcn_readfirstlane(vdst + p * 1024)); }
}
template <int probe>
__device__ __forceinline__ void mla_unit(int h, int qb, const bf16* Q, const bf16* KV, const bf16* KR, const float* rope_cs, bf16* MIX, LAS unsigned char* shm, int wid) {
    const unsigned lds0 = (unsigned)(uintptr_t)shm;
    const lds_cptr shc = (lds_cptr)shm; LAS float* wsf = (LAS float*)(shm + L_WSF) + wid * 64;
    const int q0w = qb * 256 + wid * 32;
    bf16x8 qf[12];
    { const int lane = lane_id(); const int r32 = lane & 31, hi = lane >> 5; const bf16* qp = Q + (size_t)(q0w + r32) * 1536 + h * 192 + hi * 8;
#pragma unroll
      for (int ks = 0; ks < 12; ++ks) qf[ks] = *(const bf16x8*)(qp + ks * 16);
      const float* cp = rope_cs + (size_t)(q0w + r32) * 32 + hi * 8; const float* sp = cp + 8192 * 32;
#pragma unroll
      for (int kk = 0; kk < 2; ++kk) {
          const f32x4 c0 = *(const f32x4*)(cp + 16 * kk), c1 = *(const f32x4*)(cp + 16 * kk + 4), s0 = *(const f32x4*)(sp + 16 * kk), s1 = *(const f32x4*)(sp + 16 * kk + 4);
          const float cc[8] = {c0[0], c0[1], c0[2], c0[3], c1[0], c1[1], c1[2], c1[3]}, ss[8] = {s0[0], s0[1], s0[2], s0[3], s1[0], s1[1], s1[2], s1[3]};
          bf16x8 a = qf[8 + kk], b = qf[10 + kk];
#pragma unroll
          for (int j = 0; j < 8; ++j) { const float x1 = bf1((bf16)a[j]), x2 = bf1((bf16)b[j]);
              a[j] = (short)f2bf(x1 * cc[j] - x2 * ss[j]); b[j] = (short)f2bf(x1 * ss[j] + x2 * cc[j]); }
          qf[8 + kk] = a; qf[10 + kk] = b;
      } }
    const int NT = 4 * qb + 4, myNT = (q0w + 31) / 64 + 1, NF = 4 * qb;
    Soft st; st.mhat = 0.f; st.l = 0.f; f32x16 o[4]; o[0] = f32x16{}; o[1] = f32x16{}; o[2] = f32x16{}; o[3] = f32x16{};
    {
        const int lane = lane_id(); const int r32 = lane & 31, hi = lane >> 5;
        f32x16 p0, p1;
        if (!(probe & 1)) mla_stage_k(0, h, KV, KR, lds0 + L_K, wid);
        ATT_WAIT_BAR();
        if (!(probe & 2)) {
            qk_tile<12, (probe & 8) != 0>(p0, p1, shc + L_K, qf, r32, hi);
            if (qb == 0) { const int q = q0w + r32, kb = 4 * hi;
#pragma unroll
                for (int r = 0; r < 16; ++r) { const int kv = kb + (r & 3) + 8 * (r >> 2); p0[r] = kv > q ? -INFINITY : p0[r]; p1[r] = kv + 32 > q ? -INFINITY : p1[r]; } }
            st.mhat = rowmax32(p0, p1) * C2;
        }
        ATT_WAIT_BAR();
    }
    {
        const int lane = lane_id(); const int r32 = lane & 31, hi = lane >> 5;
        tile_stream<3, 2, (probe & 4) != 0>(NF, wid >= 4,
            [&](int t, int sl) { if (probe & 1) return; mla_stage_k(t, h, KV, KR, lds0 + L_K + sl * KSLOT, wid); },
            [&](int t, int sl) { if (probe & 1) return; mla_stage_v(t, h, KV, lds0 + L_V + sl * VSLOT, wid); },
            [&](int t, int sl, f32x16& p0, f32x16& p1) {
                if (probe & 2) return;
                st.l += qk_tile_x<12, (probe & 8) != 0, 0, (probe & 16) != 0, (probe & 32) != 0>(p0, p1, shc + L_K + sl * KSLOT, qf, r32, hi, -st.mhat); },
            [&](int t, int sl, f32x16& p0, f32x16& p1) {
                if (probe & 2) return;
                st.l += pv_tile_x<(probe & 8) != 0, 0, (probe & 16) != 0, (probe & 32) != 0>(o, p0, p1, -st.mhat, shc + L_V + sl * VSLOT, lane, hi); });
    }
    {
        const int lane = lane_id(); const int r32 = lane & 31, hi = lane >> 5;
        tile_stream<3, 2, (probe & 4) != 0>(4, wid >= 4,
            [&](int t, int sl) { if (probe & 1) return; mla_stage_k(NF + t, h, KV, KR, lds0 + L_K + sl * KSLOT, wid); },
            [&](int t, int sl) { if (probe & 1) return; mla_stage_v(NF + t, h, KV, lds0 + L_V + sl * VSLOT, wid); },
            [&](int t, int sl, f32x16& p0, f32x16& p1) {
                if (NF + t >= myNT || (probe & 2)) return;
                st.l += qk_tile_x<12, (probe & 8) != 0, 1>(p0, p1, shc + L_K + sl * KSLOT, qf, r32, hi, -st.mhat, q0w + r32 - 64 * (NF + t) - 4 * hi); },
            [&](int t, int sl, f32x16& p0, f32x16& p1) {
                if (NF + t >= myNT || (probe & 2)) return;
                st.l += pv_tile_x<(probe & 8) != 0, 1>(o, p0, p1, -st.mhat, shc + L_V + sl * VSLOT, lane, hi, q0w + r32 - 64 * (NF + t) - 4 * hi); });
    }
    const int lane = lane_id(); const int r32 = lane & 31, hi = lane >> 5;
    const float lt = xhalf_sum(st.l);
    if (hi == 0) wsf[32 + r32] = lt;
    LDS_WAIT();
    const int le = lane_id(); const int r32e = le & 31, hie = le >> 5;
    bf16* op = MIX + (size_t)q0w * 2048 + h * 128 + r32e;
#pragma unroll
    for (int r = 0; r < 16; ++r) { const float rl = __builtin_amdgcn_rcpf(wsf[32 + crow(r, hie)]); bf16* orow = op + (size_t)crow(r, hie) * 2048;
#pragma unroll
        for (int d0 = 0; d0 < 4; ++d0) orow[d0 * 32] = (bf16)f2bf(o[d0][r] * rl * (1.f + PROBE_A2)); }
    ATT_WAIT_BAR();
}
}

namespace att {
__device__ __forceinline__ float dpp_xor1(float v) { return __builtin_bit_cast(float, __builtin_amdgcn_update_dpp(0, __builtin_bit_cast(int, v), 0xB1, 0xF, 0xF, true)); }
__device__ __forceinline__ float dpp_xor2(float v) { return __builtin_bit_cast(float, __builtin_amdgcn_update_dpp(0, __builtin_bit_cast(int, v), 0x4E, 0xF, 0xF, true)); }
__device__ __forceinline__ int t5b(int d) {
    if (d < 16) return d;
    int b = 16;
    b += d >= 19; b += d >= 21; b += d >= 24; b += d >= 27; b += d >= 31; b += d >= 35; b += d >= 40; b += d >= 46; b += d >= 52; b += d >= 59; b += d >= 67; b += d >= 77; b += d >= 87; b += d >= 99; b += d >= 113;
    return b;
}
__device__ __forceinline__ void stage_kv(const bf16* krow0, size_t kpitch, const bf16* vrow0, size_t vpitch, unsigned kdst, unsigned vdst, bool withV, int wid, int lane) {
    lane = lane_id();
    const bf16* kp = krow0 + (size_t)lane * kpitch + wid * 8;
    glds16(kp, (unsigned)__builtin_amdgcn_readfirstlane(kdst + wid * 1024));
    glds16(kp + 64, (unsigned)__builtin_amdgcn_readfirstlane(kdst + (wid + 8) * 1024));
    glds16(kp + 128, (unsigned)__builtin_amdgcn_readfirstlane(kdst + (wid + 16) * 1024));
    if (withV) {
#pragma unroll
        for (int i = 0; i < 2; ++i) { const int p = wid + 8 * i, d0 = p >> 2, ks = p & 3;
            glds16(vrow0 + (size_t)(16 * ks + (lane >> 2)) * vpitch + d0 * 32 + (lane & 3) * 8, (unsigned)__builtin_amdgcn_readfirstlane(vdst + p * 1024)); }
    }
}
__device__ __forceinline__ void stage_k(const bf16* krow0, size_t kpitch, unsigned kdst, int wid) {
    const int lane = lane_id();
    const bf16* kp = krow0 + (size_t)lane * kpitch + wid * 8;
    glds16(kp, (unsigned)__builtin_amdgcn_readfirstlane(kdst + wid * 1024));
    glds16(kp + 64, (unsigned)__builtin_amdgcn_readfirstlane(kdst + (wid + 8) * 1024));
    glds16(kp + 128, (unsigned)__builtin_amdgcn_readfirstlane(kdst + (wid + 16) * 1024));
}
__device__ __forceinline__ void stage_v(const bf16* vrow0, size_t vpitch, unsigned vdst, int wid) {
    const int lane = lane_id();
#pragma unroll
    for (int i = 0; i < 2; ++i) { const int p = wid + 8 * i, d0 = p >> 2, ks = p & 3;
        glds16(vrow0 + (size_t)(16 * ks + (lane >> 2)) * vpitch + d0 * 32 + (lane & 3) * 8, (unsigned)__builtin_amdgcn_readfirstlane(vdst + p * 1024)); }
}
struct TileP { int pbase, pstride, dmax; bool lookup, mask; };
__device__ __forceinline__ void logits(f32x16& p0, f32x16& p1, int tq, bool rowsel, const TileP tp, float cbias, const LAS float* bt, int hi) {
    if (tp.lookup || tp.mask) {
        const int dq = tq - tp.pbase - tp.pstride * 4 * hi;
#pragma unroll
        for (int r = 0; r < 16; ++r) {
            const int d0 = dq - tp.pstride * ((r & 3) + 8 * (r >> 2)), d1 = d0 - 32 * tp.pstride;
            const bool v0 = rowsel && d0 >= 0 && d0 <= tp.dmax, v1 = rowsel && d1 >= 0 && d1 <= tp.dmax;
            float b0 = cbias, b1 = cbias;
            if (tp.lookup) { b0 = bt[min(max(d0, 0), 127)]; b1 = bt[min(max(d1, 0), 127)]; }
            p0[r] = v0 ? fmaf(p0[r], C2, b0) : -INFINITY; p1[r] = v1 ? fmaf(p1[r], C2, b1) : -INFINITY;
            if ((r & 3) == 3) __builtin_amdgcn_sched_barrier(0);
        }
    } else {
#pragma unroll
        for (int r = 0; r < 16; ++r) { p0[r] = rowsel ? fmaf(p0[r], C2, cbias) : -INFINITY; p1[r] = rowsel ? fmaf(p1[r], C2, cbias) : -INFINITY; }
    }
}
__device__ __forceinline__ void nsa_out(const f32x16 (&o)[4], const LAS float* wsf, int mode, float* MIXF, float* MIXF1, bf16* MIX, int trow0, int g, int lane) {
    const int le = lane_id(); const int r32e = le & 31, hie = le >> 5;
#pragma unroll
    for (int rb = 0; rb < 16; rb += 4) {
        float pa[4][4], pb[4][4];
        if (mode == 2) {
#pragma unroll
            for (int r = rb; r < rb + 4; ++r) { const int q = crow(r, hie); const size_t off = (size_t)(trow0 + (q >> 2)) * 1024 + (size_t)((4 * g + (q & 3)) * 128 + r32e);
#pragma unroll
                for (int d0 = 0; d0 < 4; ++d0) { pa[r - rb][d0] = __builtin_nontemporal_load(MIXF + off + d0 * 32); pb[r - rb][d0] = __builtin_nontemporal_load(MIXF1 + off + d0 * 32); } }
        }
#pragma unroll
        for (int r = rb; r < rb + 4; ++r) {
            const int q = crow(r, hie); const float sc = wsf[q];
            const size_t off = (size_t)(trow0 + (q >> 2)) * 1024 + (size_t)((4 * g + (q & 3)) * 128 + r32e);
#pragma unroll
            for (int d0 = 0; d0 < 4; ++d0) {
                const float v = o[d0][r] * sc;
                if (mode == 0) MIXF[off + d0 * 32] = v;
                else if (mode == 1) MIXF1[off + d0 * 32] = v;
                else MIX[(size_t)(trow0 + (q >> 2)) * 2048 + 1024 + (4 * g + (q & 3)) * 128 + r32e + d0 * 32] = (bf16)f2bf(((pa[r - rb][d0] + pb[r - rb][d0]) + v) * (1.f + PROBE_A3));
            }
        }
    }
}

template <int probe>
__device__ __forceinline__ void nsa_unit(int i, int g, const bf16* U, const bf16* KC, const bf16* VC, const float* rel_bias, float* MIXF, float* MIXF1, bf16* MIX, LAS unsigned char* shm, int wid) {
    const unsigned lds0 = (unsigned)(uintptr_t)shm; const lds_cptr shc = (lds_cptr)shm;
    LAS float* wsf = (LAS float*)(shm + L_WSF) + wid * 64; LAS float* btab = (LAS float*)(shm + L_BT); LAS float* imp = (LAS float*)(shm + L_IMP);
    LAS unsigned* selw = (LAS unsigned*)(shm + L_SEL); LAS unsigned* uni = (LAS unsigned*)(shm + L_MISC); LAS unsigned char* blist = (LAS unsigned char*)(shm + L_LIST);
    const int t0 = 64 * i, trow0 = t0 + 8 * wid; const bool g1 = wid >= 4;
    auto nsa_gate = [&](int b) -> float { const int r_ = lane_id() & 31, tq_ = trow0 + (r_ >> 2), hd_ = 4 * g + (r_ & 3);
        return 1.f / (1.f + __expf(-bf1(U[(size_t)tq_ * DINP + O_GN + hd_ * 3 + b]))); };
#define NSA_DERIVE() const int lane = lane_id(); const int r32 = lane & 31, hi = lane >> 5; const int tq = trow0 + (r32 >> 2), hd = r32 & 3, head = 4 * g + hd; \
    const LAS float* bt = btab + hd * 128; const float c31 = bt[127]; (void)tq; (void)c31; (void)bt; (void)hi; (void)head
    bf16x8 qf[12];
    f32x16 o[4];
    { const int tid = wid * 64 + lane_id();
      for (int k = tid; k < 8192; k += NTHR) imp[k] = 0.f;
      { const int hh = tid >> 7, d = tid & 127; btab[tid] = rel_bias[t5b(d) * 8 + 4 * g + hh] * LOG2E; }
      if (tid < 4) uni[tid] = 0u; }
    { NSA_DERIVE();
      const bf16* qp = U + (size_t)tq * DINP + O_QN + head * 192 + hi * 8;
#pragma unroll
      for (int ks = 0; ks < 12; ++ks) qf[ks] = *(const bf16x8*)(qp + ks * 16); }
    const int nct = (4 * i + 3 + 63) >> 6;
    const bf16* kc0 = KC + g * 256; const bf16* vc0 = VC + g * 256;
    float m = 0.f, inv_lc = 0.f;
    ATT_WAIT_BAR();
    { NSA_DERIVE();
      float l = 0.f;
      tile_stream<3, 0, (probe & 4) != 0>(nct, g1,
        [&](int ct, int sl) { if (probe & 1) return; stage_k(kc0 + (size_t)(64 * ct) * 512, 512, lds0 + L_K + sl * KSLOT, wid); },
        [&](int ct, int sl) {},
        [&](int ct, int sl, f32x16& p0, f32x16& p1) {
            if (probe & 2) return;
            qk_tile<12, (probe & 8) != 0>(p0, p1, shc + L_K + sl * KSLOT, qf, r32, hi);
            const TileP tp{16 * 64 * ct + 31, 16, 1 << 30, ct >= nct - 2, true};
            logits(p0, p1, tq, true, tp, c31, bt, hi); },
        [&](int ct, int sl, f32x16& p0, f32x16& p1) {
            if (probe & 2) return;
            const float rm = rowmax32(p0, p1);
            if (ct == 0) m = rm > -1e30f ? rm : 0.f;
            else { const float nm = fmaxf(m, rm); l *= __builtin_amdgcn_exp2f(m - nm); m = nm; }
            float s = 0.f;
#pragma unroll
            for (int r = 0; r < 16; ++r) s += __builtin_amdgcn_exp2f(p0[r] - m) + __builtin_amdgcn_exp2f(p1[r] - m);
            l += s; });
      const float lc = xhalf_sum(l); inv_lc = lc > 0.f ? 1.f / lc : 0.f; }
    { NSA_DERIVE();
      o[0] = f32x16{}; o[1] = f32x16{}; o[2] = f32x16{}; o[3] = f32x16{};
      tile_stream<3, 2, (probe & 4) != 0>(nct, g1,
        [&](int ct, int sl) { if (probe & 1) return; stage_k(kc0 + (size_t)(64 * ct) * 512, 512, lds0 + L_K + sl * KSLOT, wid); },
        [&](int ct, int sl) { if (probe & 1) return; stage_v(vc0 + (size_t)(64 * ct) * 512, 512, lds0 + L_V + sl * VSLOT, wid); },
        [&](int ct, int sl, f32x16& p0, f32x16& p1) {
            if (probe & 2) return;
            qk_tile<12, (probe & 8) != 0>(p0, p1, shc + L_K + sl * KSLOT, qf, r32, hi);
            const TileP tp{16 * 64 * ct + 31, 16, 1 << 30, ct >= nct - 2, true};
            logits(p0, p1, tq, true, tp, c31, bt, hi); },
        [&](int ct, int sl, f32x16& p0, f32x16& p1) {
            if (probe & 2) return;
#pragma unroll
            for (int r = 0; r < 16; ++r) { p0[r] = __builtin_amdgcn_exp2f(p0[r] - m) * inv_lc; p1[r] = __builtin_amdgcn_exp2f(p1[r] - m) * inv_lc; }
            LAS float* iq = imp + (8 * wid + (r32 >> 2)) * 128 + 16 * ct + hi;
#pragma unroll
            for (int a = 0; a < 4; ++a) {
#pragma unroll
                for (int kh = 0; kh < 2; ++kh) {
                    const f32x16& pp = kh ? p1 : p0;
                    float s3 = pp[4 * a + 3], s4 = (pp[4 * a] + pp[4 * a + 1]) + (pp[4 * a + 2] + s3);
                    s4 += dpp_xor1(s4); s4 += dpp_xor2(s4); s3 += dpp_xor1(s3); s3 += dpp_xor2(s3);
                    const int jj = 8 * kh + 2 * a;
                    if (hd == 0) { __hip_atomic_fetch_add(iq + jj, s4, __ATOMIC_RELAXED, __HIP_MEMORY_SCOPE_WORKGROUP);
                        if (16 * ct + hi + jj + 1 < 128) __hip_atomic_fetch_add(iq + jj + 1, s3, __ATOMIC_RELAXED, __HIP_MEMORY_SCOPE_WORKGROUP); }
                }
            }
            pv_tile<(probe & 8) != 0>(o, p0, p1, shc + L_V + sl * VSLOT, lane, hi); });
      if (hi == 0) wsf[r32] = nsa_gate(0);
      LDS_WAIT();
      nsa_out(o, wsf, 0, MIXF, MIXF1, MIX, trow0, g, lane); }
    unsigned long long wm_lo = 0ull, wm_hi = 0ull;
    {
        const int lane = lane_id();
        const unsigned long long all_lo = (i >= 63) ? ~0ull : ((1ull << (i + 1)) - 1ull), all_hi = (i >= 64) ? ((i >= 127) ? ~0ull : ((1ull << (i - 63)) - 1ull)) : 0ull;
        unsigned long long s_lo[8], s_hi[8];
#pragma unroll
        for (int ql = 0; ql < 8; ++ql) { s_lo[ql] = all_lo; s_hi[ql] = all_hi; }
        if (i >= 16) {
            unsigned b0[8], b1[8], T[8];
            const int j0 = lane, j1 = lane + 64;
#pragma unroll
            for (int ql = 0; ql < 8; ++ql) { const LAS float* iq = imp + (8 * wid + ql) * 128;
                b0[ql] = (j0 >= 1 && j0 <= i - 2) ? __float_as_uint(iq[j0]) + 1u : 0u;
                b1[ql] = (j1 <= i - 2) ? __float_as_uint(iq[j1]) + 1u : 0u; T[ql] = 0u; }
            for (int bit = 30; bit >= 0; --bit) {
#pragma unroll
                for (int ql = 0; ql < 8; ++ql) { const unsigned c = T[ql] | (1u << bit);
                    const int cnt = __popcll(__ballot(b0[ql] >= c)) + __popcll(__ballot(b1[ql] >= c));
                    T[ql] = cnt >= 13 ? c : T[ql]; }
            }
#pragma unroll
            for (int ql = 0; ql < 8; ++ql) {
                const unsigned long long gt0 = __ballot(b0[ql] > T[ql]), gt1 = __ballot(b1[ql] > T[ql]), eq0 = __ballot(b0[ql] == T[ql]), eq1 = __ballot(b1[ql] == T[ql]);
                int rem = 13 - (__popcll(gt0) + __popcll(gt1));
                unsigned long long e0 = eq0, e1 = eq1, k0 = 0ull, k1 = 0ull;
                while (rem > 0 && e0) { const unsigned long long low = e0 & (~e0 + 1ull); k0 |= low; e0 ^= low; --rem; }
                while (rem > 0 && e1) { const unsigned long long low = e1 & (~e1 + 1ull); k1 |= low; e1 ^= low; --rem; }
                unsigned long long a_lo = gt0 | k0 | 1ull, a_hi = gt1 | k1;
                if (i < 64) a_lo |= (1ull << i) | (1ull << (i - 1));
                else { a_hi |= (1ull << (i - 64)); if (i == 64) a_lo |= (1ull << 63); else a_hi |= (1ull << (i - 65)); }
                s_lo[ql] = a_lo; s_hi[ql] = a_hi;
            }
        }
#pragma unroll
        for (int ql = 0; ql < 8; ++ql) {
            if (lane == 0) { LAS unsigned* sp = selw + (8 * wid + ql) * 4; sp[0] = (unsigned)s_lo[ql]; sp[1] = (unsigned)(s_lo[ql] >> 32); sp[2] = (unsigned)s_hi[ql]; sp[3] = (unsigned)(s_hi[ql] >> 32); }
            wm_lo |= s_lo[ql]; wm_hi |= s_hi[ql];
        }
        if (lane == 0) { __hip_atomic_fetch_or(uni + 0, (unsigned)wm_lo, __ATOMIC_RELAXED, __HIP_MEMORY_SCOPE_WORKGROUP); __hip_atomic_fetch_or(uni + 1, (unsigned)(wm_lo >> 32), __ATOMIC_RELAXED, __HIP_MEMORY_SCOPE_WORKGROUP);
                         __hip_atomic_fetch_or(uni + 2, (unsigned)wm_hi, __ATOMIC_RELAXED, __HIP_MEMORY_SCOPE_WORKGROUP); __hip_atomic_fetch_or(uni + 3, (unsigned)(wm_hi >> 32), __ATOMIC_RELAXED, __HIP_MEMORY_SCOPE_WORKGROUP); }
    }
    ATT_WAIT_BAR();
    if (wid == 0) {
        const int l = lane_id();
        const unsigned long long ulo = ((unsigned long long)uni[1] << 32) | uni[0], uhi = ((unsigned long long)uni[3] << 32) | uni[2];
        const unsigned long long below = (1ull << l) - 1ull;
        const int nlo = __popcll(ulo);
        if ((ulo >> l) & 1ull) blist[__popcll(ulo & below)] = (unsigned char)l;
        if ((uhi >> l) & 1ull) blist[nlo + __popcll(uhi & below)] = (unsigned char)(64 + l);
        if (l == 0) { const int im3 = i - 2;
            const unsigned long long flo = im3 <= 0 ? 0ull : (im3 >= 64 ? ~0ull : ((1ull << im3) - 1ull)), fhi = im3 <= 64 ? 0ull : (im3 >= 128 ? ~0ull : ((1ull << (im3 - 64)) - 1ull));
            uni[4] = (unsigned)(nlo + __popcll(uhi)); uni[5] = (unsigned)(__popcll(ulo & flo) + __popcll(uhi & fhi)); }
    }
    ATT_WAIT_BAR();
    {
        const int nsl = __builtin_amdgcn_readfirstlane((int)uni[4]); const int nfar = i >= 3 ? __builtin_amdgcn_readfirstlane((int)uni[5]) : 0;
        const bf16* ks0 = U + O_KN + 384 + g * 192; const bf16* vs0 = U + O_VN + 256 + g * 128;
        Soft st; st.mhat = 0.f; st.l = 0.f;
        o[0] = f32x16{}; o[1] = f32x16{}; o[2] = f32x16{}; o[3] = f32x16{};
        auto blk = [&](int t) -> int { return __builtin_amdgcn_readfirstlane((int)blist[t]); };
        auto wsel = [&](int j) -> bool { return j < 64 ? ((wm_lo >> j) & 1ull) : ((wm_hi >> (j - 64)) & 1ull); };
        auto getj = [&](int t) -> int { return (int)blist[t]; };
        if (nfar > 0) {
            {
                NSA_DERIVE();
                f32x16 p0, p1;
                if (!(probe & 1)) stage_k(ks0, DINP, lds0 + L_K, wid);
                ATT_WAIT_BAR();
                if (!(probe & 2)) { qk_tile<12, (probe & 8) != 0>(p0, p1, shc + L_K, qf, r32, hi); st.mhat = fmaf(rowmax32(p0, p1), C2, c31); }
                ATT_WAIT_BAR();
            }
            {
                NSA_DERIVE();
                const LAS unsigned* sp = selw + (8 * wid + (r32 >> 2)) * 4;
                const unsigned long long my_lo = ((unsigned long long)sp[1] << 32) | sp[0], my_hi = ((unsigned long long)sp[3] << 32) | sp[2];
                tile_stream_id<(probe & 4) != 0>(nfar, getj,
                    [&](int t, int sl, int jv) { if (probe & 1) return; const int j = __builtin_amdgcn_readfirstlane(jv); stage_k(ks0 + (size_t)(64 * j) * DINP, DINP, lds0 + L_K + sl * KSLOT, wid); },
                    [&](int t, int sl, int jv) { if (probe & 1) return; const int j = __builtin_amdgcn_readfirstlane(jv); stage_v(vs0 + (size_t)(64 * j) * DINP, DINP, lds0 + L_V + sl * VSLOT, wid); },
                    [&](int t, int sl, int jv, f32x16& p0, f32x16& p1) {
                        if (probe & 2) return;
                        const int j = __builtin_amdgcn_readfirstlane(jv); if (!wsel(j)) return;
                        const bool rowsel = ((j < 64 ? my_lo : my_hi) >> (j & 63)) & 1ull;
                        st.l += qk_tile_x<12, (probe & 8) != 0, 0, (probe & 16) != 0, (probe & 32) != 0>(p0, p1, shc + L_K + sl * KSLOT, qf, r32, hi, rowsel ? c31 - st.mhat : -INFINITY); },
                    [&](int t, int sl, int jv, f32x16& p0, f32x16& p1) {
                        if (probe & 2) return;
                        const int j = __builtin_amdgcn_readfirstlane(jv); if (!wsel(j)) return;
                        const bool rowsel = ((j < 64 ? my_lo : my_hi) >> (j & 63)) & 1ull;
                        st.l += pv_tile_x<(probe & 8) != 0, 0, (probe & 16) != 0, (probe & 32) != 0>(o, p0, p1, rowsel ? c31 - st.mhat : -INFINITY, shc + L_V + sl * VSLOT, lane, hi); });
            }
        }
        {
            NSA_DERIVE();
            const LAS unsigned* sp = selw + (8 * wid + (r32 >> 2)) * 4;
            ATT_WAIT_BAR();
            tile_stream<3, 2, (probe & 4) != 0>(nsl - nfar, g1,
                [&](int t, int sl) { if (probe & 1) return; const int j = blk(nfar + t); stage_k(ks0 + (size_t)(64 * j) * DINP, DINP, lds0 + L_K + sl * KSLOT, wid); },
                [&](int t, int sl) { if (probe & 1) return; const int j = blk(nfar + t); stage_v(vs0 + (size_t)(64 * j) * DINP, DINP, lds0 + L_V + sl * VSLOT, wid); },
                [&](int t, int sl, f32x16& p0, f32x16& p1) {
                    if (probe & 2) return;
                    const int j = blk(nfar + t); if (!wsel(j)) return;
                    qk_tile<12, (probe & 8) != 0>(p0, p1, shc + L_K + sl * KSLOT, qf, r32, hi);
                    const bool rowsel = (sp[j >> 5] >> (j & 31)) & 1u;
                    const TileP tp{64 * j, 1, 1 << 30, true, j == i}; logits(p0, p1, tq, rowsel, tp, c31, bt, hi); },
                [&](int t, int sl, f32x16& p0, f32x16& p1) {
                    if (probe & 2) return;
                    const int j = blk(nfar + t); if (!wsel(j)) return;
                    softmax_tile<true>(p0, p1, st, o, nfar == 0 && t == 0, wsf, r32, hi);
                    pv_tile<(probe & 8) != 0>(o, p0, p1, shc + L_V + sl * VSLOT, lane, hi); });
        }
        {
            NSA_DERIVE();
            const float ls = xhalf_sum(st.l);
            if (hi == 0) wsf[r32] = ls > 0.f ? nsa_gate(1) / ls : 0.f;
            LDS_WAIT();
            nsa_out(o, wsf, 1, MIXF, MIXF1, MIX, trow0, g, lane);
        }
    }
    {
        NSA_DERIVE();
        const bf16* kw0 = U + O_KN + 768 + g * 192; const bf16* vw0 = U + O_VN + 512 + g * 128;
        Soft st; st.mhat = 0.f; st.l = 0.f;
        o[0] = f32x16{}; o[1] = f32x16{}; o[2] = f32x16{}; o[3] = f32x16{};
        const int nw = (i >= 8 ? 8 : i) + 1;
        ATT_WAIT_BAR();
        tile_stream<3, 2, (probe & 4) != 0>(nw, g1,
            [&](int t, int sl) { if (probe & 1) return; stage_k(kw0 + (size_t)(64 * (i - t)) * DINP, DINP, lds0 + L_K + sl * KSLOT, wid); },
            [&](int t, int sl) { if (probe & 1) return; stage_v(vw0 + (size_t)(64 * (i - t)) * DINP, DINP, lds0 + L_V + sl * VSLOT, wid); },
            [&](int t, int sl, f32x16& p0, f32x16& p1) {
            if (probe & 2) return;
                qk_tile<12, (probe & 8) != 0>(p0, p1, shc + L_K + sl * KSLOT, qf, r32, hi);
                if (t <= 2 || t == 8) { const TileP tp{64 * (i - t), 1, 511, t <= 2, t == 0 || t == 8}; logits(p0, p1, tq, true, tp, c31, bt, hi); } },
            [&](int t, int sl, f32x16& p0, f32x16& p1) {
            if (probe & 2) return;
                if (t <= 2 || t == 8) softmax_tile<true>(p0, p1, st, o, t == 0, wsf, r32, hi);
                else softmax_tile<false>(p0, p1, st, o, false, wsf, r32, hi, c31);
                pv_tile<(probe & 8) != 0>(o, p0, p1, shc + L_V + sl * VSLOT, lane, hi); });
        const float lw = xhalf_sum(st.l);
        if (hi == 0) wsf[r32] = lw > 0.f ? nsa_gate(2) / lw : 0.f;
        LDS_WAIT();
        nsa_out(o, wsf, 2, MIXF, MIXF1, MIX, trow0, g, lane);
    }
    ATT_WAIT_BAR();
#undef NSA_DERIVE
}
}

__device__ __forceinline__ int att_lane_id() { int l; asm volatile("v_mbcnt_lo_u32_b32 %0, -1, 0\n\tv_mbcnt_hi_u32_b32 %0, -1, %0" : "=v"(l)); return l; }
struct Args { const float* in[27]; float* out; unsigned char* ws; int ph_lo, ph_hi, nbar, pad; };
constexpr int NPHASE = 16;
#ifndef PG8_SP2
#define PG8_SP2 true
#endif
#ifndef PG8_ALIGN
#define PG8_ALIGN true
#endif
#ifndef PROBE_MODE
#define PROBE_MODE 0
#endif
#ifndef PROBE_A1
#define PROBE_A1 0.f
#endif
#ifndef PROBE_A2
#define PROBE_A2 0.f
#endif
#ifndef PROBE_A3
#define PROBE_A3 0.f
#endif
#ifndef PROBE_CLOCK
#define PROBE_CLOCK -1
#endif
#ifndef HALF_TAIL
#define HALF_TAIL 0
#endif
#ifndef DEFER_NORM
#define DEFER_NORM 0
#endif
#ifndef FUSE_NORM
#define FUSE_NORM 0
#endif
#ifndef FUSE_FINAL
#define FUSE_FINAL 0
#endif
#ifndef REPA
#define REPA 1
#endif
#ifndef REPB
#define REPB 1
#endif
#ifndef REPC
#define REPC 1
#endif
#ifndef REP0
#define REP0 1
#endif
#ifndef REP2
#define REP2 1
#endif
#ifndef P0_PARTS
#define P0_PARTS 7
#endif
#ifndef REP3
#define REP3 1
#endif
#ifndef RESID_PERM
#define RESID_PERM 1
#endif
#ifndef FINAL_BF16
#define FINAL_BF16 1
#endif
#ifndef PROBE_STAMP
#define PROBE_STAMP -1
#endif
#ifndef STAMP_END
#define STAMP_END PROBE_STAMP
#endif
#ifndef STAMP_MULT
#define STAMP_MULT 8
#endif
#ifndef REP10
#define REP10 1
#endif
__global__ void __launch_bounds__(NTHR, 2) mega(Args args) {
    extern __shared__ __attribute__((aligned(16))) unsigned char lds[];
    Ctx F;
    F.lds = (LAS unsigned char*)lds;
    F.wave = __builtin_amdgcn_readfirstlane((int)threadIdx.x >> 6);
#define REFRESH_CTX() do { const int l_ = att_lane_id(); F.lane = l_; F.tid = F.wave * 64 + l_; } while (0)
    REFRESH_CTX();
    F.G = gridDim.x; { const int bx = blockIdx.x; F.vcu = (F.G % 8 == 0) ? (bx % 8) * (F.G / 8) + bx / 8 : bx; }
    unsigned char* ws = args.ws;
    volatile LAS unsigned* MISC = (volatile LAS unsigned*)(F.lds + MISC_OFF);
    for (int u = F.tid; u < (LDS_BYTES - LDSCTL_OFF) / 4; u += NTHR) ((LAS unsigned*)(F.lds + LDSCTL_OFF))[u] = 0u;
    __syncthreads();
    XcdBarrier bar; bar.w0 = 0; bar.bar = (unsigned*)(ws + WS_CTL) + 4096; bar.x = 0; bar.st = nullptr;
    const int lo = args.ph_lo, hi = args.ph_hi;
    if (hi - lo > 1) bar = xcd_barrier_post((unsigned*)(ws + WS_CTL) + 4096 + args.nbar * XCD_BAR_WORDS, MISC + 8, F.wave == 0 ? 1 : 0);
#define IN(k) (lo <= (k) && (k) < hi)
#if PROBE_STAMP >= 0
    unsigned long long ts_a = __builtin_amdgcn_s_memrealtime(), ts_b = 0;
#define STAMP_AT(k) do { if ((k) + 1 == PROBE_STAMP) ts_a = __builtin_amdgcn_s_memrealtime(); if ((k) == STAMP_END) ts_b = __builtin_amdgcn_s_memrealtime(); } while (0)
#else
#define STAMP_AT(k) do {} while (0)
#endif
#define SEAM(k) do { if (IN(k) && IN((k) + 1)) xcd_barrier(bar); STAMP_AT(k); } while (0)
    const P0Args pa{args.in[5], args.in[6], args.in[7], args.in[9], args.in[11], args.in[13], args.in[15], args.in[16], args.in[18], args.in[19], args.in[21], args.in[23], args.in[24], args.in[25], args.in[1], args.in[2], ws};
#define CLK_BEGIN(ph) unsigned long long ct0_ = 0, cr0_ = 0; if (PROBE_CLOCK == (ph) && blockIdx.x == 0) { ct0_ = __builtin_amdgcn_s_memtime(); cr0_ = __builtin_amdgcn_s_memrealtime(); }
#define CLK_END(ph) if (PROBE_CLOCK == (ph) && blockIdx.x == 0) { const unsigned long long ct1_ = __builtin_amdgcn_s_memtime(), cr1_ = __builtin_amdgcn_s_memrealtime(); \
        const unsigned long long ticks_ = 1000ull * (ct1_ - ct0_) / (cr1_ - cr0_ + 1ull);     \
        while (__builtin_amdgcn_s_memrealtime() - cr1_ < ticks_) __builtin_amdgcn_s_sleep(8); }
    LAS float* gwt = (LAS float*)(F.lds); LAS float* sht = (LAS float*)(F.lds + 8192);
    const float* x = args.in[0];
    float* X1 = (float*)(ws + WS_X1);
    const float* MOD = (const float*)(ws + WS_MOD);
    bf16* H = (bf16*)(ws + WS_H); bf16* ACT = (bf16*)(ws + WS_ACT); bf16* H2 = (bf16*)(ws + WS_H2); float* X2 = (float*)(ws + WS_Q);
    float* const GWT = (float*)(ws + WS_GW); float* const RSQ = (float*)(ws + WS_CTL) + 32768;
    const bool fuse_final = (F.G == 256) && FUSE_FINAL;
    const bool fuse_norm = (F.G == 256) && FUSE_NORM;

    for (int rep = 0; rep < REP0; ++rep) { if (rep) xcd_barrier(bar);
    if (IN(0)) { REFRESH_CTX();
        p0_prologue(F, pa, rep == 0 ? 7 : P0_PARTS);
        if (blockIdx.x == 0) {
            LAS int* cst = (LAS int*)(F.lds + 65536);
            __syncthreads();
            { const int me = F.tid; cst[me] = me < 256 ? 400 * ((me >> 3) + 1) : 108 * (((me - 256) >> 1) + 1) + 2700;     }
            __syncthreads();
            { const int me = F.tid, cm = cst[me]; int rank = 0;
              for (int k2 = 0; k2 < 512; ++k2) { const int ck = cst[k2]; rank += (ck > cm || (ck == cm && k2 < me)) ? 1 : 0; }
              ((unsigned*)(ws + WS_CTL) + 8192)[rank] = (unsigned)me; }
        }
    }
    }
    SEAM(0);
    if (IN(1)) { REFRESH_CTX(); build_mod_tables(F, ws, args.in[4], args.in[3], 0, true, gwt, sht);
        if (FUSE_NORM || DEFER_NORM || FUSE_FINAL) { const float* modp = (const float*)(ws + WS_MODP); float* gwo = (float*)(ws + WS_GW);
          for (int c = (int)blockIdx.x * NTHR + F.tid; c < 7 * D_; c += F.G * NTHR) { const int which = c / D_, cc = c % D_;
              const int chunk = which == 0 ? 4 : which == 1 ? 3 : which == 2 ? 7 : which == 3 ? 6 : which == 4 ? 2 : which == 5 ? 5 : 8;
              float v = args.in[3][chunk * D_ + cc];
              for (int k2 = 0; k2 < 16; ++k2) v += modp[k2 * 18432 + chunk * D_ + cc];
              if (which == 0) v = args.in[8][cc] * (1.f + v); else if (which == 2) v = args.in[22][cc] * (1.f + v); else if (which == 4) v *= 0.5f * (1.f + PROBE_A1); else if (which == 6) v *= 0.5f;
              gwo[c] = v; } }
        norm_rows_bf16(F, x, H, gwt, sht); __syncthreads(); }
    SEAM(1);
    for (int rep = 0; rep < REP2; ++rep) { if (rep) xcd_barrier(bar);
    if (IN(2)) { REFRESH_CTX(); CLK_BEGIN(2); pg8::Gemm g{H, (const bf16*)(ws + WS_WGU1), S_, 2 * FF_, D_, D_, D_}; pg8::StaticOrder S; S.init(S_, 2 * FF_, F.G, (int)blockIdx.x);
        pg8::EpiSwiglu E{ACT, FF_}; pg8::gemm_phase<pg8::EpiSwiglu, pg8::StaticOrder, PG8_ALIGN, PG8_SP2>(F.lds, g, S, E, F.wave);
        CLK_END(2);
        if (rep == 0) { REFRESH_CTX(); conv_tail(F, pa, 1, NIT_B, (S_ / 256) * (2 * FF_ / 256)); } }
    }
    SEAM(2);
    for (int rep = 0; rep < REP3; ++rep) { if (rep) xcd_barrier(bar);
    if (IN(3)) { REFRESH_CTX(); pg8::Gemm g{ACT, (const bf16*)(ws + WS_WD1), S_, D_, FF_, FF_, FF_}; pg8::StaticOrder S; S.init(S_, D_, F.G, (int)blockIdx.x);
        if (fuse_norm) { pg8::EpiResidNorm<0> E{x, X1, H, (const float*)(ws + WS_GW) + 8192, (const float*)(ws + WS_GW), (float*)(ws + WS_XBUF), (unsigned*)(ws + WS_CTL) + 16384};
            pg8::gemm_phase<pg8::EpiResidNorm<0>, pg8::StaticOrder, false, PG8_SP2>(F.lds, g, S, E, F.wave); }
        else if (DEFER_NORM) { bias_gemv(F, (const bf16*)(ws + WS_WIN), DINP, GWT + 2048, GWT + 14336);
            pg8::EpiResidG E{x, X1, H, GWT + 8192, GWT, RSQ}; pg8::gemm_phase<pg8::EpiResidG, pg8::StaticOrder, PG8_ALIGN, PG8_SP2>(F.lds, g, S, E, F.wave); }
        else if (RESID_PERM) { pg8::EpiResidP<false> E{x, X1, D_, MOD + 2 * D_, 0.5f * (1.f + PROBE_A1)}; pg8::gemm_phase<pg8::EpiResidP<false>, pg8::StaticOrder, PG8_ALIGN, PG8_SP2>(F.lds, g, S, E, F.wave); }
        else { pg8::EpiResid E{x, X1, D_, MOD + 2 * D_, 0.5f * (1.f + PROBE_A1)}; pg8::gemm_phase<pg8::EpiResid, pg8::StaticOrder, PG8_ALIGN, PG8_SP2>(F.lds, g, S, E, F.wave); } }
    }
    SEAM(3);
    for (int rp_ = 0; rp_ < REPA; ++rp_) { if (rp_) xcd_barrier(bar);
    if (IN(4) && !fuse_norm && !DEFER_NORM) { REFRESH_CTX(); build_mod_tables(F, ws, args.in[8], args.in[3], 3, false, gwt, sht); norm_rows_bf16(F, X1, H, gwt, sht); __syncthreads(); }
    }
    if (!fuse_norm && !DEFER_NORM) SEAM(4);
    for (int rp_ = 0; rp_ < REPB; ++rp_) { if (rp_) xcd_barrier(bar);
    if (IN(5)) { REFRESH_CTX(); pg8::Gemm g{H, (const bf16*)(ws + WS_WIN), S_, DINP, D_, D_, D_}; pg8::StaticOrder S; S.init(S_, DINP, F.G, (int)blockIdx.x);
        if (DEFER_NORM && !fuse_norm) { pg8::EpiStoreN E{ACT, DINP, RSQ, GWT + 14336}; pg8::gemm_phase<pg8::EpiStoreN, pg8::StaticOrder, PG8_ALIGN, PG8_SP2>(F.lds, g, S, E, F.wave); }
        else { pg8::EpiStore E{ACT, DINP}; pg8::gemm_phase<pg8::EpiStore, pg8::StaticOrder, PG8_ALIGN, PG8_SP2>(F.lds, g, S, E, F.wave); }
        REFRESH_CTX(); conv_tail(F, pa, 2, NIT_C, (S_ / 256) * (DINP / 256)); }
    }
    SEAM(5);
    for (int rp_ = 0; rp_ < REPC; ++rp_) { if (rp_) xcd_barrier(bar);
    if (IN(6)) { REFRESH_CTX(); p6_prep(F, ws, args.in[10], args.in[12], args.in[14], args.in[17]); }
    }
    SEAM(6);
    for (int rp_ = 0; rp_ < REPC; ++rp_) { if (rp_) xcd_barrier(bar);
    if (IN(7)) { REFRESH_CTX();
        const int c = (int)blockIdx.x, G = F.G;
        { pg8::Gemm g{(const bf16*)(ws + WS_CQN), (const bf16*)(ws + WS_WUQ), S_, 1536, 768, 768, 768}; pg8::StaticOrder S; S.init(S_, 1536, G, c);
          pg8::EpiStore E{(bf16*)(ws + WS_Q), 1536}; pg8::gemm_phase<pg8::EpiStore, pg8::StaticOrder, PG8_ALIGN, PG8_SP2>(F.lds, g, S, E, F.wave); }
        { pg8::Gemm g{(const bf16*)(ws + WS_CKVN), (const bf16*)(ws + WS_WUKV), S_, 2048, 512, 512, 512}; pg8::StaticOrder S; S.init(S_, 2048, G, c);
          pg8::EpiStore E{(bf16*)(ws + WS_KV), 2048}; pg8::gemm_phase<pg8::EpiStore, pg8::StaticOrder, PG8_ALIGN, PG8_SP2>(F.lds, g, S, E, F.wave); }
        { pg8::Gemm g{(const bf16*)(ws + WS_FLATK), (const bf16*)(ws + WS_WCK1), 1024, 256, KCH_K, 6144, 6144}; pg8::StaticOrder S; S.init_units(4, NCH_K, G, (c + G - 192 % G) % G);
          pg8::EpiPart E{(float*)(ws + WS_PARTK), 1024}; pg8::gemm_phase<pg8::EpiPart, pg8::StaticOrder, false, PG8_SP2, true>(F.lds, g, S, E, F.wave); }
        { pg8::Gemm g{(const bf16*)(ws + WS_FLATV), (const bf16*)(ws + WS_WCV1), 1024, 256, KCH_V, 4096, 4096}; pg8::StaticOrder S; S.init_units(4, NCH_V, G, (c + G - 240 % G) % G);
          pg8::EpiPart E{(float*)(ws + WS_PARTV), 1024}; pg8::gemm_phase<pg8::EpiPart, pg8::StaticOrder, false, PG8_SP2, true>(F.lds, g, S, E, F.wave); }
    }
    }
    SEAM(7);
    if (IN(8)) { REFRESH_CTX(); p8_prep2(F, ws); }
    SEAM(8);
    for (int rp_ = 0; rp_ < REPC; ++rp_) { if (rp_) xcd_barrier(bar);
    if (IN(9)) { REFRESH_CTX();
        const int c = (int)blockIdx.x, G = F.G;
        { pg8::Gemm g{(const bf16*)(ws + WS_HIDK), (const bf16*)(ws + WS_WCK2), 1024, 256, 256, 256, 256}; pg8::StaticOrder S; S.init(1024, 256, G, c);
          pg8::EpiStore E{(bf16*)(ws + WS_KC), 256}; pg8::gemm_phase<pg8::EpiStore, pg8::StaticOrder, false, PG8_SP2>(F.lds, g, S, E, F.wave); }
        { pg8::Gemm g{(const bf16*)(ws + WS_HIDV), (const bf16*)(ws + WS_WCV2), 1024, 256, 256, 256, 256}; pg8::StaticOrder S; S.init(1024, 256, G, (c + G - 8 % G) % G);
          pg8::EpiStore E{(bf16*)(ws + WS_VC), 256}; pg8::gemm_phase<pg8::EpiStore, pg8::StaticOrder, false, PG8_SP2>(F.lds, g, S, E, F.wave); }
    }
    }
    SEAM(9);
    for (int rep = 0; rep < REP10; ++rep) { if (rep) xcd_barrier(bar);
    if (IN(10)) { REFRESH_CTX(); CLK_BEGIN(10);
        gu32* ctr = (gu32*)(ws + WS_CTL) + 2048 + 64 * rep; const unsigned* order = (const unsigned*)(ws + WS_CTL) + 8192;
        for (;;) {
            int moff = MISC_OFF + 64; asm volatile("" : "+s"(moff));
            volatile LAS unsigned* mq = (volatile LAS unsigned*)(F.lds + moff);
            if (att::lane_id() == 0 && F.wave == 0) mq[0] = __hip_atomic_fetch_add(ctr, 1u, RLX_AGENT);
            __syncthreads(); const int n = __builtin_amdgcn_readfirstlane((int)mq[0]); __syncthreads();
            if (n >= 512) {
                if (rep == 0) { gu32* cc = (gu32*)(ws + WS_CTL) + 3072; LAS float* scr = (LAS float*)(F.lds + F.wave * 16384);
                    for (;;) { int it = 0; if (att::lane_id() == 0) it = (int)__hip_atomic_fetch_add(cc, 4u, RLX_AGENT); it = __builtin_amdgcn_readfirstlane(it); if (it >= NIT_D) break;
                        conv_run(3, it, 1, it + 4 < NIT_D ? it + 4 : NIT_D, pa, scr, att::lane_id()); } }
                break; }
            const int id = __builtin_amdgcn_readfirstlane((int)order[n]);
#ifdef PROBE_MLA_ONLY
            if (rep > 0 && id >= 256) continue;
#endif
#ifdef PROBE_NSA_ONLY
            if (rep > 0 && id < 256) continue;
#endif
            if (rep == 0 && PROBE_MODE != 0) {
                if (id < 256) att::mla_unit<PROBE_MODE>(id & 7, id >> 3, (const bf16*)(ws + WS_Q), (const bf16*)(ws + WS_KV), (const bf16*)(ws + WS_KR), (const float*)(ws + WS_ROPE), H, F.lds, F.wave);
                else att::nsa_unit<PROBE_MODE>((id - 256) >> 1, (id - 256) & 1, (const bf16*)(ws + WS_ACT), (const bf16*)(ws + WS_KC), (const bf16*)(ws + WS_VC), args.in[20], (float*)(ws + WS_MIXF), (float*)(ws + WS_CQN), H, F.lds, F.wave);
            } else {
                if (id < 256) att::mla_unit<0>(id & 7, id >> 3, (const bf16*)(ws + WS_Q), (const bf16*)(ws + WS_KV), (const bf16*)(ws + WS_KR), (const float*)(ws + WS_ROPE), H, F.lds, F.wave);
                else att::nsa_unit<0>((id - 256) >> 1, (id - 256) & 1, (const bf16*)(ws + WS_ACT), (const bf16*)(ws + WS_KC), (const bf16*)(ws + WS_VC), args.in[20], (float*)(ws + WS_MIXF), (float*)(ws + WS_CQN), H, F.lds, F.wave);
            }
        }
        CLK_END(10);
    }
    }
    SEAM(10);
    if (IN(11)) { REFRESH_CTX(); pg8::Gemm g{H, (const bf16*)(ws + WS_WOUT), S_, D_, D_, D_, D_}; pg8::StaticOrder S; S.init(S_, D_, F.G, (int)blockIdx.x);
        if (fuse_norm) { pg8::EpiResidNorm<0> E{X1, X2, H2, (const float*)(ws + WS_GW) + 10240, (const float*)(ws + WS_GW) + 4096, (float*)(ws + WS_XBUF) + 65536, (unsigned*)(ws + WS_CTL) + 16384 + 2048};
            pg8::gemm_phase<pg8::EpiResidNorm<0>, pg8::StaticOrder, false, PG8_SP2>(F.lds, g, S, E, F.wave); }
        else if (DEFER_NORM) { bias_gemv(F, (const bf16*)(ws + WS_WGU2), 2 * FF_, GWT + 6144, GWT + 20480);
            pg8::EpiResidG E{X1, X1, H2, GWT + 10240, GWT + 4096, RSQ + 8192}; pg8::gemm_phase<pg8::EpiResidG, pg8::StaticOrder, PG8_ALIGN, PG8_SP2>(F.lds, g, S, E, F.wave); }
        else if (RESID_PERM) { pg8::EpiResidP<false> E{X1, X1, D_, MOD + 5 * D_, 1.0f}; pg8::gemm_phase<pg8::EpiResidP<false>, pg8::StaticOrder, PG8_ALIGN, PG8_SP2>(F.lds, g, S, E, F.wave); }
        else { pg8::EpiResid E{X1, X1, D_, MOD + 5 * D_, 1.0f}; pg8::gemm_phase<pg8::EpiResid, pg8::StaticOrder, PG8_ALIGN, PG8_SP2>(F.lds, g, S, E, F.wave); } }
    SEAM(11);
    if (IN(12) && !fuse_norm && !DEFER_NORM) { REFRESH_CTX(); build_mod_tables(F, ws, args.in[22], args.in[3], 6, false, gwt, sht); norm_rows_bf16(F, X1, H2, gwt, sht); __syncthreads(); }
    if (!fuse_norm && !DEFER_NORM) SEAM(12);
    if (IN(13)) { REFRESH_CTX(); pg8::Gemm g{H2, (const bf16*)(ws + WS_WGU2), S_, 2 * FF_, D_, D_, D_}; pg8::StaticOrder S; S.init(S_, 2 * FF_, F.G, (int)blockIdx.x);
        const bool half_tail = HALF_TAIL && ((S.nwg % F.G) * 2 == F.G);
        if (half_tail) S.r1 = S.nwg / F.G;
        if (DEFER_NORM && !fuse_norm) { pg8::EpiSwigluN E{ACT, FF_, RSQ + 8192, GWT + 20480}; pg8::gemm_phase<pg8::EpiSwigluN, pg8::StaticOrder, PG8_ALIGN, PG8_SP2>(F.lds, g, S, E, F.wave);
            if (half_tail) { S.r0 = S.r1; S.r1 = S.r0 + 1; S.half = 1; pg8::gemm_phase<pg8::EpiSwigluN, pg8::StaticOrder, false, true, false, true>(F.lds, g, S, E, F.wave); } }
        else { pg8::EpiSwiglu E{ACT, FF_}; pg8::gemm_phase<pg8::EpiSwiglu, pg8::StaticOrder, PG8_ALIGN, PG8_SP2>(F.lds, g, S, E, F.wave);
            if (half_tail) { S.r0 = S.r1; S.r1 = S.r0 + 1; S.half = 1; pg8::gemm_phase<pg8::EpiSwiglu, pg8::StaticOrder, false, true, false, true>(F.lds, g, S, E, F.wave); } } }
    SEAM(13);
    if (IN(14)) { REFRESH_CTX(); pg8::Gemm g{ACT, (const bf16*)(ws + WS_WD2), S_, D_, FF_, FF_, FF_}; pg8::StaticOrder S; S.init(S_, D_, F.G, (int)blockIdx.x);
        if (fuse_final) { pg8::EpiResidNorm<1> E{fuse_norm ? X2 : X1, args.out, nullptr, (const float*)(ws + WS_GW) + 12288, args.in[26], (float*)(ws + WS_XBUF) + 2 * 65536, (unsigned*)(ws + WS_CTL) + 16384 + 4096};
            pg8::gemm_phase<pg8::EpiResidNorm<1>, pg8::StaticOrder, false, PG8_SP2>(F.lds, g, S, E, F.wave); }
        else if (FINAL_BF16) { pg8::EpiResidP<true> E{X1, (void*)H, D_, MOD + 8 * D_, 0.5f};
            pg8::gemm_phase<pg8::EpiResidP<true>, pg8::StaticOrder, PG8_ALIGN, PG8_SP2>(F.lds, g, S, E, F.wave); }
        else if (RESID_PERM) { pg8::EpiResidP<false> E{X1, args.out, D_, MOD + 8 * D_, 0.5f}; pg8::gemm_phase<pg8::EpiResidP<false>, pg8::StaticOrder, PG8_ALIGN, PG8_SP2>(F.lds, g, S, E, F.wave); }
        else { pg8::EpiResid E{X1, args.out, D_, MOD + 8 * D_, 0.5f}; pg8::gemm_phase<pg8::EpiResid, pg8::StaticOrder, PG8_ALIGN, PG8_SP2>(F.lds, g, S, E, F.wave); } }
    if (!fuse_final) SEAM(14);
    if (IN(15) && !fuse_final) { REFRESH_CTX(); if (FINAL_BF16) final_norm_b(F, H, args.out, args.in[26]); else final_norm(F, args.out, args.in[26]); }
#if PROBE_STAMP >= 0
    if (blockIdx.x == 0) { __syncthreads(); unsigned long long now = __builtin_amdgcn_s_memrealtime(); if (STAMP_END == 15) ts_b = now;
        const unsigned long long until = now + (unsigned long long)STAMP_MULT * (ts_b - ts_a);
        while (__builtin_amdgcn_s_memrealtime() < until) __builtin_amdgcn_s_sleep(8); }
#endif
#undef IN
#undef SEAM
}

extern "C" void kernel_launch(void* const* d_in, const int* in_sizes, int n_in, void* d_out, int out_size, void* d_ws, size_t ws_size, hipStream_t stream) {
    static int grid = 0;
    if (grid == 0) {
        if (n_in != 27 || out_size != S_ * D_ || ws_size < WS_END) { fprintf(stderr, "kernel_launch: unexpected shapes (n_in %d out %d ws %zu)\n", n_in, out_size, ws_size); grid = -1; return; }
        int dev = 0, cus = 0;
        if (hipGetDevice(&dev) != hipSuccess || hipDeviceGetAttribute(&cus, hipDeviceAttributeMultiprocessorCount, dev) != hipSuccess) { grid = -1; return; }
        if (hipFuncSetAttribute((const void*)mega, hipFuncAttributeMaxDynamicSharedMemorySize, LDS_BYTES) != hipSuccess) { fprintf(stderr, "hipFuncSetAttribute failed\n"); grid = -1; return; }
        grid = cus;
    }
    if (grid < 0) return;
    (void)hipMemsetAsync((char*)d_ws + WS_CTL, 0, 1 * MiB, stream);
    Args a{};
    for (int i = 0; i < 27; ++i) a.in[i] = (const float*)d_in[i];
    a.out = (float*)d_out; a.ws = (unsigned char*)d_ws;
    unsigned char* ws = (unsigned char*)d_ws;
    auto run = [&](int lo, int hi, int nbar) { a.ph_lo = lo; a.ph_hi = hi; a.nbar = nbar; hipLaunchKernelGGL(mega, dim3(grid), dim3(NTHR), LDS_BYTES, stream, a); };
    run(0, 16, 0);
}
```
